# Optimizing an MI355X kernel written in HIP

```python
import jax, jax.numpy as jnp
from jax import lax
import numpy as np

D_MODEL = 1024
BATCH = 32
SEQ = 2048
DEPTH = 2

EPS = 1e-6
N_BRANCH = 3
BRANCH_WIDTH = 512

ATTN_HEADS = 8
ATTN_KV_HEADS = 2
ATTN_HEAD_DIM = 64
ATTN_WIDTH = ATTN_HEADS * ATTN_HEAD_DIM
ATTN_KV_WIDTH = ATTN_KV_HEADS * ATTN_HEAD_DIM
WINDOW = 128
ATTN_BLOCK = 128
ROPE_THETA = 10000.0

GLA_HEADS = 4
GLA_KEY_WIDTH = 256
GLA_VALUE_WIDTH = 512
GLA_DK = GLA_KEY_WIDTH // GLA_HEADS
GLA_DV = GLA_VALUE_WIDTH // GLA_HEADS
GLA_GATE_RANK = 16
GLA_GATE_NORMALIZER = 16.0
GLA_CHUNK = 64

SSD_D_INNER = 512
SSD_HEAD_DIM = 64
SSD_HEADS = SSD_D_INNER // SSD_HEAD_DIM
SSD_GROUPS = 2
SSD_D_STATE = 128
SSD_CONV = 4
SSD_CONV_DIM = SSD_D_INNER + 2 * SSD_GROUPS * SSD_D_STATE
SSD_CHUNK = 64

IN_PROJ_SIZES = (
    ATTN_WIDTH, ATTN_KV_WIDTH, ATTN_KV_WIDTH, ATTN_WIDTH,
    GLA_KEY_WIDTH, GLA_KEY_WIDTH, GLA_VALUE_WIDTH, GLA_VALUE_WIDTH,
    GLA_GATE_RANK,
    SSD_CONV_DIM, SSD_HEADS, SSD_D_INNER,
    N_BRANCH * D_MODEL,
)
IN_PROJ_DIM = sum(IN_PROJ_SIZES)

kernel_name = "hybrid_swa_gla_ssd_gated_merge"


def rms_norm(x, g):
    xf = x.astype(jnp.float32)
    y = xf * lax.rsqrt(jnp.mean(xf * xf, axis=-1, keepdims=True) + EPS)
    return (y * g.astype(jnp.float32)).astype(x.dtype)


def rope_tables(positions):
    inv_freq = ROPE_THETA ** (-jnp.arange(0, ATTN_HEAD_DIM, 2, dtype=jnp.float32) / ATTN_HEAD_DIM)
    ang = positions.astype(jnp.float32)[..., None] * inv_freq
    return jnp.cos(ang)[:, :, None, :], jnp.sin(ang)[:, :, None, :]


def apply_rope(t, cos, sin):
    tf = t.astype(jnp.float32)
    t1, t2 = jnp.split(tf, 2, axis=-1)
    return jnp.concatenate([t1 * cos - t2 * sin, t2 * cos + t1 * sin], axis=-1).astype(t.dtype)


def sliding_window_attention(q, k, v, sinks):
    b, s = q.shape[0], q.shape[1]
    nb = s // ATTN_BLOCK
    grp = ATTN_HEADS // ATTN_KV_HEADS
    qb = q.reshape(b, nb, ATTN_BLOCK, ATTN_KV_HEADS, grp, ATTN_HEAD_DIM)

    def band(t):
        tp = jnp.pad(t, ((0, 0), (ATTN_BLOCK, 0), (0, 0), (0, 0)))
        prev = tp[:, :s].reshape(b, nb, ATTN_BLOCK, ATTN_KV_HEADS, ATTN_HEAD_DIM)
        cur = t.reshape(b, nb, ATTN_BLOCK, ATTN_KV_HEADS, ATTN_HEAD_DIM)
        return jnp.concatenate([prev, cur], axis=2)

    kb, vb = band(k), band(v)
    scale = ATTN_HEAD_DIM ** -0.5
    scores = jnp.einsum("bnqhgd,bnkhd->bnhgqk", qb, kb).astype(jnp.float32) * scale
    qi = jnp.arange(ATTN_BLOCK)[:, None]
    ki = jnp.arange(2 * ATTN_BLOCK)[None, :]
    rel = qi + ATTN_BLOCK - ki
    key_pos = jnp.arange(nb)[:, None, None] * ATTN_BLOCK - ATTN_BLOCK + ki
    mask = (rel >= 0) & (rel < WINDOW) & (key_pos >= 0)
    scores = jnp.where(mask[None, :, None, None], scores, jnp.finfo(jnp.float32).min)
    sink = jnp.broadcast_to(sinks.astype(jnp.float32).reshape(1, 1, ATTN_KV_HEADS, grp, 1, 1),
                            scores.shape[:-1] + (1,))
    probs = jax.nn.softmax(jnp.concatenate([scores, sink], axis=-1), axis=-1)[..., :-1]
    out = jnp.einsum("bnhgqk,bnkhd->bnqhgd", probs.astype(v.dtype), vb)
    return out.reshape(b, s, ATTN_WIDTH)


def gated_linear_attention(q, k, v, log_alpha):
    b, s, nh, dk = q.shape
    dv = v.shape[-1]
    c = GLA_CHUNK
    nc = s // c
    f32 = jnp.float32
    qc = (q.astype(f32) * dk ** -0.5).reshape(b, nc, c, nh, dk)
    kc = k.astype(f32).reshape(b, nc, c, nh, dk)
    vc = v.astype(f32).reshape(b, nc, c, nh, dv)
    bcum = jnp.cumsum(log_alpha.astype(f32).reshape(b, nc, c, nh, dk), axis=2)
    q_dec = qc * jnp.exp(bcum)
    k_inv = kc * jnp.exp(-bcum)
    causal = jnp.tril(jnp.ones((c, c), bool))
    attn = jnp.where(causal, jnp.einsum("bnihd,bnjhd->bnhij", q_dec, k_inv), 0.0)
    o_intra = jnp.einsum("bnhij,bnjhv->bnihv", attn, vc)
    b_last = bcum[:, :, -1]
    k_end = kc * jnp.exp(b_last[:, :, None] - bcum)
    chunk_states = jnp.einsum("bnjhd,bnjhv->bnhdv", k_end, vc)
    chunk_decay = jnp.exp(b_last)

    def step(state, inp):
        dec, upd = inp
        return dec[..., None] * state + upd, state

    init = jnp.zeros((b, nh, dk, dv), f32)
    _, prev = lax.scan(step, init, (jnp.moveaxis(chunk_decay, 1, 0), jnp.moveaxis(chunk_states, 1, 0)))
    prev = jnp.moveaxis(prev, 0, 1)
    o_inter = jnp.einsum("bnihd,bnhdv->bnihv", q_dec, prev)
    return (o_intra + o_inter).reshape(b, s, nh, dv)


def causal_depthwise_conv(u, w, bias):
    kw = w.shape[0]
    s = u.shape[1]
    up = jnp.pad(u, ((0, 0), (kw - 1, 0), (0, 0)))
    out = bias
    for i in range(kw):
        out = out + up[:, i:i + s] * w[i]
    return out


def ssd_scan(x, dt, a_head, bmat, cmat):
    b, s, nh, p = x.shape
    g, n = bmat.shape[2], bmat.shape[3]
    hpg = nh // g
    l = SSD_CHUNK
    nc = s // l
    f32 = jnp.float32
    dtf = dt.astype(f32)
    xc = (x.astype(f32) * dtf[..., None]).reshape(b, nc, l, g, hpg, p)
    a_cs = jnp.cumsum((dtf * a_head.astype(f32)).reshape(b, nc, l, g, hpg), axis=2)
    bc = bmat.astype(f32).reshape(b, nc, l, g, n)
    cc = cmat.astype(f32).reshape(b, nc, l, g, n)
    tril = jnp.tril(jnp.ones((l, l), bool))
    seg = a_cs[:, :, :, None] - a_cs[:, :, None, :]
    decay_ls = jnp.exp(jnp.where(tril[:, :, None, None], seg, -jnp.inf))
    cb = jnp.einsum("bclgn,bcsgn->bclsg", cc, bc)
    y_diag = jnp.einsum("bclsgh,bcsghp->bclghp", cb[..., None] * decay_ls, xc)
    decay_to_end = jnp.exp(a_cs[:, :, -1:] - a_cs)
    chunk_states = jnp.einsum("bclgn,bclghp->bcghpn", bc, xc * decay_to_end[..., None])
    chunk_decay = jnp.exp(a_cs[:, :, -1])

    def step(state, inp):
        dec, upd = inp
        return dec[..., None, None] * state + upd, state

    init = jnp.zeros((b, g, hpg, p, n), f32)
    _, prev = lax.scan(step, init, (jnp.moveaxis(chunk_decay, 1, 0), jnp.moveaxis(chunk_states, 1, 0)))
    prev = jnp.moveaxis(prev, 0, 1)
    y_off = jnp.einsum("bclgn,bcghpn->bclghp", cc, prev) * jnp.exp(a_cs)[..., None]
    return (y_diag + y_off).reshape(b, s, nh, p)


def gated_group_rms_norm(y, z, g, groups):
    shp = y.shape
    u = (y.astype(jnp.float32) * jax.nn.silu(z.astype(jnp.float32)))
    u = u.reshape(shp[:-1] + (groups, shp[-1] // groups))
    u = u * lax.rsqrt(jnp.mean(u * u, axis=-1, keepdims=True) + EPS)
    return (u.reshape(shp) * g.astype(jnp.float32)).astype(y.dtype)


def hybrid_layer(x, cos, sin, norm_g, w_in, attn_q_norm, attn_k_norm, attn_sinks,
                 gla_w_gate_up, gla_b_gate, gla_out_norm, ssd_conv_w, ssd_conv_b,
                 ssd_dt_bias, ssd_A_log, ssd_D, ssd_out_norm, w_branch, w_out):
    b, s, _ = x.shape
    h = rms_norm(x, norm_g)
    proj = h @ w_in
    split_points = np.cumsum(IN_PROJ_SIZES)[:-1].tolist()
    (aq, ak, av, ag, gq, gk, gv, gg, gdown, sxbc, sdt, sz, mg) = jnp.split(proj, split_points, axis=-1)

    q = apply_rope(rms_norm(aq.reshape(b, s, ATTN_HEADS, ATTN_HEAD_DIM), attn_q_norm), cos, sin)
    k = apply_rope(rms_norm(ak.reshape(b, s, ATTN_KV_HEADS, ATTN_HEAD_DIM), attn_k_norm), cos, sin)
    v = av.reshape(b, s, ATTN_KV_HEADS, ATTN_HEAD_DIM)
    y_a = sliding_window_attention(q, k, v, attn_sinks) * jax.nn.silu(ag)

    gate_logit = (gdown @ gla_w_gate_up + gla_b_gate).astype(jnp.float32)
    log_alpha = jax.nn.log_sigmoid(gate_logit) / GLA_GATE_NORMALIZER
    o_b = gated_linear_attention(gq.reshape(b, s, GLA_HEADS, GLA_DK),
                                 gk.reshape(b, s, GLA_HEADS, GLA_DK),
                                 gv.reshape(b, s, GLA_HEADS, GLA_DV),
                                 log_alpha.reshape(b, s, GLA_HEADS, GLA_DK)).astype(x.dtype)
    y_b = rms_norm(o_b, gla_out_norm).reshape(b, s, GLA_VALUE_WIDTH) * jax.nn.silu(gg)

    xbc = jax.nn.silu(causal_depthwise_conv(sxbc, ssd_conv_w, ssd_conv_b))
    sx, sb, sc = jnp.split(xbc, [SSD_D_INNER, SSD_D_INNER + SSD_GROUPS * SSD_D_STATE], axis=-1)
    dt = jax.nn.softplus((sdt + ssd_dt_bias).astype(jnp.float32))
    a_head = -jnp.exp(ssd_A_log.astype(jnp.float32))
    xh = sx.reshape(b, s, SSD_HEADS, SSD_HEAD_DIM)
    y_c = ssd_scan(xh, dt, a_head,
                   sb.reshape(b, s, SSD_GROUPS, SSD_D_STATE),
                   sc.reshape(b, s, SSD_GROUPS, SSD_D_STATE))
    y_c = (y_c + xh.astype(jnp.float32) * ssd_D.astype(jnp.float32)[:, None]).astype(x.dtype)
    y_c = gated_group_rms_norm(y_c.reshape(b, s, SSD_D_INNER), sz, ssd_out_norm, SSD_GROUPS)

    branches = jnp.stack([y_a, y_b, y_c], axis=2)
    u = jnp.einsum("bsnw,nwd->bsnd", branches, w_branch)
    gates = jax.nn.sigmoid(mg.reshape(b, s, N_BRANCH, D_MODEL))
    merged = jnp.sum(gates * u, axis=2)
    return x + merged @ w_out


def setup_inputs(seed: int = 0) -> dict:
    key = jax.random.key(seed)
    ks = jax.random.split(key, 20)
    f32 = jnp.float32
    nrm = lambda k, shp: jax.random.normal(k, shp, f32)
    x = nrm(ks[0], (BATCH, SEQ, D_MODEL))
    offset = jax.random.randint(ks[1], (BATCH, 1), 0, 4096, dtype=jnp.int32)
    positions = (jnp.arange(SEQ, dtype=jnp.int32)[None, :] + offset).astype(jnp.int32)
    norm_g = 1.0 + 0.02 * nrm(ks[2], (DEPTH, D_MODEL))
    w_in = nrm(ks[3], (DEPTH, D_MODEL, IN_PROJ_DIM)) * D_MODEL ** -0.5
    attn_q_norm = 1.0 + 0.02 * nrm(ks[4], (DEPTH, ATTN_HEAD_DIM))
    attn_k_norm = 1.0 + 0.02 * nrm(ks[5], (DEPTH, ATTN_HEAD_DIM))
    attn_sinks = 0.5 * nrm(ks[6], (DEPTH, ATTN_HEADS))
    gla_w_gate_up = nrm(ks[7], (DEPTH, GLA_GATE_RANK, GLA_KEY_WIDTH)) * GLA_GATE_RANK ** -0.5
    gla_b_gate = 0.02 * nrm(ks[8], (DEPTH, GLA_KEY_WIDTH))
    gla_out_norm = 1.0 + 0.02 * nrm(ks[9], (DEPTH, GLA_DV))
    ssd_conv_w = nrm(ks[10], (DEPTH, SSD_CONV, SSD_CONV_DIM)) * SSD_CONV ** -0.5
    ssd_conv_b = 0.02 * nrm(ks[11], (DEPTH, SSD_CONV_DIM))
    dt0 = jnp.exp(jax.random.uniform(ks[12], (DEPTH, SSD_HEADS), f32, np.log(1e-3), np.log(1e-1)))
    ssd_dt_bias = dt0 + jnp.log(-jnp.expm1(-dt0))
    ssd_A_log = jnp.log(jax.random.uniform(ks[13], (DEPTH, SSD_HEADS), f32, 1.0, 16.0))
    ssd_D = 1.0 + 0.02 * nrm(ks[14], (DEPTH, SSD_HEADS))
    ssd_out_norm = 1.0 + 0.02 * nrm(ks[15], (DEPTH, SSD_D_INNER))
    w_branch = nrm(ks[16], (DEPTH, N_BRANCH, BRANCH_WIDTH, D_MODEL)) * BRANCH_WIDTH ** -0.5
    w_out = nrm(ks[17], (DEPTH, D_MODEL, D_MODEL)) * D_MODEL ** -0.5
    return {"x": x, "positions": positions, "norm_g": norm_g, "w_in": w_in,
            "attn_q_norm": attn_q_norm, "attn_k_norm": attn_k_norm, "attn_sinks": attn_sinks,
            "gla_w_gate_up": gla_w_gate_up, "gla_b_gate": gla_b_gate, "gla_out_norm": gla_out_norm,
            "ssd_conv_w": ssd_conv_w, "ssd_conv_b": ssd_conv_b, "ssd_dt_bias": ssd_dt_bias,
            "ssd_A_log": ssd_A_log, "ssd_D": ssd_D, "ssd_out_norm": ssd_out_norm,
            "w_branch": w_branch, "w_out": w_out}


def reference(x, positions, norm_g, w_in, attn_q_norm, attn_k_norm, attn_sinks,
              gla_w_gate_up, gla_b_gate, gla_out_norm, ssd_conv_w, ssd_conv_b,
              ssd_dt_bias, ssd_A_log, ssd_D, ssd_out_norm, w_branch, w_out):
    cos, sin = rope_tables(positions)
    for i in range(DEPTH):
        x = hybrid_layer(x, cos, sin, norm_g[i], w_in[i], attn_q_norm[i], attn_k_norm[i],
                         attn_sinks[i], gla_w_gate_up[i], gla_b_gate[i], gla_out_norm[i],
                         ssd_conv_w[i], ssd_conv_b[i], ssd_dt_bias[i], ssd_A_log[i], ssd_D[i],
                         ssd_out_norm[i], w_branch[i], w_out[i])
    return x
```

```cpp
#define MK_SPLIT 0
#include <hip/hip_runtime.h>
#include <cstdio>
#include <cstdint>
namespace pg8 {
#define PG8_LAS __attribute__((address_space(3)))
typedef unsigned short bf16_t;
typedef short bf16x8 __attribute__((ext_vector_type(8)));
typedef float f32x4 __attribute__((ext_vector_type(4)));
typedef unsigned u32x4 __attribute__((ext_vector_type(4)));
constexpr int BM = 256, BK = 64, HALF = 128, HTB = HALF * BK * 2  , STAGE_BYTES = 8 * HTB, NXCD = 8, WGM = 8;

__host__ __device__ __forceinline__ int lds_byte(int r, int c) { const int st = (r >> 4) * 2 + (c >> 5), rr = r & 15, cc = c & 31, ob = rr * 64 + cc * 2; return st * 1024 + (ob ^ (((ob >> 9) & 1) << 5)); }
__host__ __device__ __forceinline__ void stage_rc(int b, int& R, int& C) { const int st = b / 1024, sb = b % 1024, swz = sb ^ (((sb >> 9) & 1) << 5); R = (st >> 1) * 16 + swz / 64; C = (st & 1) * 32 + (swz % 64) / 2; }
__host__ __device__ __forceinline__ int perm32(int rho) { const int n = rho >> 4, i = rho & 15; return 8 * (i >> 2) + 4 * n + (i & 3); }

struct Unit { int pm, pn; };
struct Gemm { const bf16_t* A; const bf16_t* Bt; int M, N, K; };

struct StaticOrder {
    int nM, nN, nwg, G, c;
    __host__ __device__ void init(int M, int N, int G_, int c_) { nM = M / BM; nN = N / BM; nwg = nM * nN; G = G_; c = c_; }
    __host__ __device__ bool next(int i, Unit& u) const {
        const long L = (long)i * G + c; if (L >= nwg) return false;
        int wgid = (int)L; { const int q = nwg / NXCD, r = nwg % NXCD, xcd = wgid % NXCD, off = wgid / NXCD; wgid = (xcd < r ? xcd * (q + 1) : r * (q + 1) + (xcd - r) * q) + off; }
        const int nig = WGM * nN, gid = wgid / nig, fm = gid * WGM, gsz = (nM - fm) < WGM ? (nM - fm) : WGM;
        u.pm = fm + ((wgid % nig) % gsz); u.pn = (wgid % nig) / gsz; return true;
    }
    __device__ __forceinline__ void a_ready(const Unit&) const {}
    __device__ __forceinline__ void done(const Unit&) const {}
};

typedef float f32x2c __attribute__((ext_vector_type(2))); typedef __bf16 bf16x2c __attribute__((ext_vector_type(2)));
__device__ __forceinline__ unsigned cvt_pk_bf16(float lo, float hi) { const f32x2c v = {lo, hi}; const bf16x2c b = __builtin_convertvector(v, bf16x2c); return __builtin_bit_cast(unsigned, b); }
typedef float f32x2 __attribute__((ext_vector_type(2)));

__device__ __forceinline__ float sigmoid_fast(float x) { return __builtin_amdgcn_rcpf(1.f + __builtin_amdgcn_exp2f(-1.44269504f * x)); }
__device__ __forceinline__ float bf_lo(unsigned w) { return __builtin_bit_cast(float, w << 16); }
__device__ __forceinline__ float bf_hi(unsigned w) { return __builtin_bit_cast(float, w & 0xffff0000u); }

template <int ACT> struct EpiBf16 {
    static constexpr bool PERM = true, AFTER_DRAIN = false;
    bf16_t* O; int ldc;
    __device__ __forceinline__ void operator()(const f32x4 (&acc)[2][2][4][2], const Unit& u, int wr, int wc, int fr, int fq) const {
        const int row0 = u.pm * BM + wr * 64 + fr; const int col0 = u.pn * BM + wc * 32 + 8 * fq;
#pragma unroll
        for (int ai = 0; ai < 2; ++ai)
#pragma unroll
            for (int m = 0; m < 4; ++m) { bf16_t* rowp = O + (size_t)(row0 + ai * HALF + m * 16) * ldc + col0;
#pragma unroll
                for (int bj = 0; bj < 2; ++bj) { f32x4 v0 = acc[ai][bj][m][0], v1 = acc[ai][bj][m][1];
                    if (ACT == 1) {
#pragma unroll
                        for (int j = 0; j < 4; ++j) { v0[j] = sigmoid_fast(v0[j]); v1[j] = sigmoid_fast(v1[j]); } }
                    u32x4 w; w.x = cvt_pk_bf16(v0[0], v0[1]); w.y = cvt_pk_bf16(v0[2], v0[3]); w.z = cvt_pk_bf16(v1[0], v1[1]); w.w = cvt_pk_bf16(v1[2], v1[3]);
                    *(u32x4*)(rowp + bj * HALF) = w; } }
    }
};
struct EpiMerge {
    static constexpr bool PERM = true, AFTER_DRAIN = false;
    const bf16_t* Gt; int ldg; bf16_t* Mg; int ldm; int first;
    __device__ __forceinline__ void operator()(const f32x4 (&acc)[2][2][4][2], const Unit& u, int wr, int wc, int fr, int fq) const {
        const int row0 = u.pm * BM + wr * 64 + fr; const int col0 = u.pn * BM + wc * 32 + 8 * fq;
#pragma unroll
        for (int ai = 0; ai < 2; ++ai)
#pragma unroll
            for (int m = 0; m < 4; ++m) { const size_t row = (size_t)(row0 + ai * HALF + m * 16);
                const bf16_t* gp = Gt + row * ldg + col0; bf16_t* mp = Mg + row * ldm + col0;
#pragma unroll
                for (int bj = 0; bj < 2; ++bj) { const f32x4 a0 = acc[ai][bj][m][0], a1 = acc[ai][bj][m][1];
                    const u32x4 g = *(const u32x4*)(gp + bj * HALF);
                    u32x4 p = (u32x4){0u, 0u, 0u, 0u}; if (!first) p = *(const u32x4*)(mp + bj * HALF);
                    u32x4 w;
                    w.x = cvt_pk_bf16(bf_lo(p.x) + bf_lo(g.x) * a0[0], bf_hi(p.x) + bf_hi(g.x) * a0[1]);
                    w.y = cvt_pk_bf16(bf_lo(p.y) + bf_lo(g.y) * a0[2], bf_hi(p.y) + bf_hi(g.y) * a0[3]);
                    w.z = cvt_pk_bf16(bf_lo(p.z) + bf_lo(g.z) * a1[0], bf_hi(p.z) + bf_hi(g.z) * a1[1]);
                    w.w = cvt_pk_bf16(bf_lo(p.w) + bf_lo(g.w) * a1[2], bf_hi(p.w) + bf_hi(g.w) * a1[3]);
                    *(u32x4*)(mp + bj * HALF) = w; } }
    }
};
struct EpiResid {
    static constexpr bool PERM = false, AFTER_DRAIN = false;
    const float* base; float* out; int ldc;
    __device__ __forceinline__ void operator()(const f32x4 (&acc)[2][2][4][2], const Unit& u, int wr, int wc, int fr, int fq) const {
        const int row0 = u.pm * BM + wr * 64 + fr, col0 = u.pn * BM + wc * 32 + 4 * fq;
#pragma unroll
        for (int ai = 0; ai < 2; ++ai)
#pragma unroll
            for (int m = 0; m < 4; ++m) { const size_t off = (size_t)(row0 + ai * HALF + m * 16) * ldc + col0;
#pragma unroll
                for (int bj = 0; bj < 2; ++bj)
#pragma unroll
                    for (int n = 0; n < 2; ++n) { const f32x4 bs = *(const f32x4*)(base + off + bj * HALF + n * 16); *(f32x4*)(out + off + bj * HALF + n * 16) = bs + acc[ai][bj][m][n]; } }
    }
};


template <class Epi, class Sched, bool ALIGN_EPI = false, bool SP2 = false>
__device__ __forceinline__ void gemm_phase(PG8_LAS unsigned char* lds, const Gemm g, const Sched& S, const Epi& E, const int tid) {
    const int wid = __builtin_amdgcn_readfirstlane(tid >> 6), lane = tid & 63, wr = wid >> 2, wc = wid & 3, fr = lane & 15, fq = lane >> 4;
    const int K = g.K, nt = K / BK;
    unsigned voffA[2], voffB[2];
#pragma unroll
    for (int i = 0; i < 2; ++i) { int R, C; stage_rc(tid * 16 + i * 8192, R, C); const int Rb = Epi::PERM ? ((R & ~31) + perm32(R & 31)) : R;
        voffA[i] = (unsigned)(R * K + C) * 2u; voffB[i] = (unsigned)(Rb * K + C) * 2u; }
    const size_t kstep = (size_t)(BK * 2);
    const size_t hstep = (size_t)HALF * K * 2;
    const size_t tstep = 2 * hstep;
    const unsigned ldsw = (unsigned)wid * 1024u;
    const int aoff = lds_byte(wr * 64 + fr, fq * 8), boff = lds_byte(wc * 32 + fr, fq * 8);
#define PG8_SA(b, h) (((b) * 2 + (h)) * HTB)
#define PG8_SB(b, h) ((4 + (b) * 2 + (h)) * HTB)
#define PG8_STAGE(bufoff, gbase, voff) do { _Pragma("unroll") for (int _i = 0; _i < 2; ++_i) \
        __builtin_amdgcn_global_load_lds((const unsigned*)((const char*)(gbase) + (voff)[_i]), (PG8_LAS unsigned*)(lds + (bufoff) + ldsw + _i * 8192), 16, 0, 0); } while (0)
#define PG8_LDA(dst, b, h) do { _Pragma("unroll") for (int m = 0; m < 4; ++m) _Pragma("unroll") for (int k = 0; k < 2; ++k) dst[m][k] = *(const PG8_LAS bf16x8*)(lds + PG8_SA(b, h) + aoff + m * 2048 + k * 1024); } while (0)
#define PG8_LDB(dst, b, h) do { _Pragma("unroll") for (int n = 0; n < 2; ++n) _Pragma("unroll") for (int k = 0; k < 2; ++k) dst[n][k] = *(const PG8_LAS bf16x8*)(lds + PG8_SB(b, h) + boff + n * 2048 + k * 1024); } while (0)
#define PG8_MMA(ai, bj, At, Bt) do { __builtin_amdgcn_s_setprio(1); _Pragma("unroll") for (int m = 0; m < 4; ++m) _Pragma("unroll") for (int n = 0; n < 2; ++n) _Pragma("unroll") for (int k = 0; k < 2; ++k) \
        acc[ai][bj][m][n] = __builtin_amdgcn_mfma_f32_16x16x32_bf16(Bt[n][k], At[m][k], acc[ai][bj][m][n], 0, 0, 0); __builtin_amdgcn_s_setprio(0); } while (0)
#define PG8_WAIT_V(n) asm volatile("s_waitcnt vmcnt(" #n ")" ::: "memory")
#define PG8_WAIT_L(n) asm volatile("s_waitcnt lgkmcnt(" #n ")" ::: "memory")
#define PG8_BAR __builtin_amdgcn_s_barrier()
#define PG8_SCHED __builtin_amdgcn_sched_barrier(0)
    Unit cur, nxt; int ui = 0;
    if (!S.next(0, cur)) return;
    f32x4 acc[2][2][4][2];
#pragma unroll
    for (int a = 0; a < 2; ++a)
#pragma unroll
        for (int b = 0; b < 2; ++b)
#pragma unroll
            for (int m = 0; m < 4; ++m)
#pragma unroll
                for (int n = 0; n < 2; ++n) acc[a][b][m][n] = (f32x4){0.f, 0.f, 0.f, 0.f};
    bf16x8 At[4][2], B0[2][2], B1[2][2];
    const char* cA = (const char*)g.A + (size_t)cur.pm * tstep; const char* cB = (const char*)g.Bt + (size_t)cur.pn * tstep;
    S.a_ready(cur);
    if constexpr (SP2) {
        PG8_STAGE(PG8_SB(0, 0), cB, voffB); PG8_STAGE(PG8_SB(0, 1), cB + hstep, voffB); PG8_STAGE(PG8_SA(0, 0), cA, voffA); PG8_STAGE(PG8_SA(0, 1), cA + hstep, voffA);
        if (wr == 1) PG8_BAR;
        PG8_WAIT_V(2); PG8_BAR;
        PG8_STAGE(PG8_SB(1, 0), cB + kstep, voffB); PG8_STAGE(PG8_SA(1, 0), cA + kstep, voffA); PG8_STAGE(PG8_SB(1, 1), cB + hstep + kstep, voffB);
        PG8_WAIT_V(6); PG8_BAR;
    } else {
        PG8_STAGE(PG8_SB(0, 0), cB, voffB); PG8_STAGE(PG8_SA(0, 0), cA, voffA); PG8_STAGE(PG8_SB(0, 1), cB + hstep, voffB); PG8_STAGE(PG8_SA(0, 1), cA + hstep, voffA);
        if (wr == 1) PG8_BAR;
        PG8_WAIT_V(4); PG8_BAR;
        PG8_STAGE(PG8_SB(1, 0), cB + kstep, voffB); PG8_STAGE(PG8_SA(1, 0), cA + kstep, voffA); PG8_STAGE(PG8_SB(1, 1), cB + hstep + kstep, voffB);
        PG8_WAIT_V(6); PG8_BAR;
    }
    for (;;) {
        const bool has_next = S.next(ui + 1, nxt);
        const char* nA = has_next ? (const char*)g.A + (size_t)nxt.pm * tstep : cA; const char* nB = has_next ? (const char*)g.Bt + (size_t)nxt.pn * tstep : cB;
        for (int t = 0; t < nt; t += 2) {
            const bool last = (t == nt - 2);
            const char* a1 = cA + (size_t)(t + 1) * kstep;
            const char* a2 = last ? nA : cA + (size_t)(t + 2) * kstep; const char* b2 = last ? nB : cB + (size_t)(t + 2) * kstep;
            const char* a3 = a2 + kstep; const char* b3 = b2 + kstep;
            if (last && has_next) S.a_ready(nxt);
            if constexpr (SP2) {
            PG8_LDB(B0, 0, 0); PG8_LDB(B1, 0, 1); PG8_SCHED; PG8_LDA(At, 0, 0); PG8_STAGE(PG8_SA(1, 1), a1 + hstep, voffA);
            PG8_WAIT_V(8); PG8_WAIT_L(0); PG8_BAR; PG8_MMA(0, 0, At, B0); PG8_MMA(0, 1, At, B1); PG8_BAR; PG8_SCHED;
            PG8_LDA(At, 0, 1); PG8_STAGE(PG8_SB(0, 0), b2, voffB); PG8_STAGE(PG8_SB(0, 1), b2 + hstep, voffB); PG8_STAGE(PG8_SA(0, 0), a2, voffA);
            PG8_WAIT_V(8); PG8_WAIT_L(0); PG8_BAR; PG8_MMA(1, 0, At, B0); PG8_MMA(1, 1, At, B1); PG8_BAR; PG8_SCHED;
            PG8_LDB(B0, 1, 0); PG8_LDB(B1, 1, 1); PG8_SCHED; PG8_LDA(At, 1, 0); PG8_STAGE(PG8_SA(0, 1), a2 + hstep, voffA);
            PG8_WAIT_V(8); PG8_WAIT_L(0); PG8_BAR; PG8_MMA(0, 0, At, B0); PG8_MMA(0, 1, At, B1); PG8_BAR; PG8_SCHED;
            PG8_LDA(At, 1, 1); PG8_STAGE(PG8_SB(1, 0), b3, voffB); PG8_STAGE(PG8_SB(1, 1), b3 + hstep, voffB); PG8_STAGE(PG8_SA(1, 0), a3, voffA);
            PG8_WAIT_V(8); PG8_WAIT_L(0); PG8_BAR; PG8_MMA(1, 0, At, B0); PG8_MMA(1, 1, At, B1); PG8_BAR; PG8_SCHED;
            } else {
            PG8_LDB(B0, 0, 0); PG8_SCHED; PG8_LDA(At, 0, 0); PG8_STAGE(PG8_SA(1, 1), a1 + hstep, voffA);
            PG8_WAIT_L(8); PG8_BAR; PG8_WAIT_L(0); PG8_MMA(0, 0, At, B0); PG8_BAR; PG8_SCHED;
            PG8_LDB(B1, 0, 1); PG8_STAGE(PG8_SB(0, 0), b2, voffB);
            PG8_BAR; PG8_WAIT_L(0); PG8_MMA(0, 1, At, B1); PG8_BAR;
            PG8_LDA(At, 0, 1); PG8_STAGE(PG8_SA(0, 0), a2, voffA);
            PG8_BAR; PG8_WAIT_L(0); PG8_MMA(1, 0, At, B0); PG8_BAR; PG8_SCHED;
            PG8_STAGE(PG8_SB(0, 1), b2 + hstep, voffB);
            PG8_WAIT_V(6); PG8_BAR; PG8_MMA(1, 1, At, B1); PG8_BAR;
            PG8_LDB(B0, 1, 0); PG8_SCHED; PG8_LDA(At, 1, 0); PG8_STAGE(PG8_SA(0, 1), a2 + hstep, voffA);
            PG8_WAIT_L(8); PG8_BAR; PG8_WAIT_L(0); PG8_MMA(0, 0, At, B0); PG8_BAR; PG8_SCHED;
            PG8_LDB(B1, 1, 1); PG8_STAGE(PG8_SB(1, 0), b3, voffB);
            PG8_BAR; PG8_WAIT_L(0); PG8_MMA(0, 1, At, B1); PG8_BAR;
            PG8_LDA(At, 1, 1); PG8_STAGE(PG8_SA(1, 0), a3, voffA);
            PG8_BAR; PG8_WAIT_L(0); PG8_MMA(1, 0, At, B0); PG8_BAR; PG8_SCHED;
            PG8_STAGE(PG8_SB(1, 1), b3 + hstep, voffB);
            PG8_WAIT_V(6); PG8_BAR; PG8_MMA(1, 1, At, B1); PG8_BAR;
            }
        }
        if constexpr (ALIGN_EPI) { if (wr == 0) PG8_BAR; }
        if constexpr (!Epi::AFTER_DRAIN) { E(acc, cur, wr, wc, fr, fq); S.done(cur); }
        if (!has_next) break;
#pragma unroll
        for (int a = 0; a < 2; ++a)
#pragma unroll
            for (int b = 0; b < 2; ++b)
#pragma unroll
                for (int m = 0; m < 4; ++m)
#pragma unroll
                    for (int n = 0; n < 2; ++n) acc[a][b][m][n] = (f32x4){0.f, 0.f, 0.f, 0.f};
        cur = nxt; cA = nA; cB = nB; ++ui;
        if constexpr (ALIGN_EPI) { if (wr == 1) PG8_BAR; }
    }
    PG8_WAIT_V(0);
    if constexpr (!ALIGN_EPI) { if (wr == 0) PG8_BAR; }
    PG8_BAR;
    if constexpr (Epi::AFTER_DRAIN) { E.fused(acc, cur, wr, wc, fr, fq, lds, wid, lane); S.done(cur); }
#undef PG8_SA
#undef PG8_SB
#undef PG8_STAGE
#undef PG8_LDA
#undef PG8_LDB
#undef PG8_MMA
#undef PG8_WAIT_V
#undef PG8_WAIT_L
#undef PG8_BAR
#undef PG8_SCHED
}
}
#define GAS __attribute__((address_space(1)))
#define LAS __attribute__((address_space(3)))
typedef unsigned short bf16;
typedef unsigned v4u __attribute__((ext_vector_type(4)));
typedef float f32x4 __attribute__((ext_vector_type(4)));
typedef short bf16x8 __attribute__((ext_vector_type(8)));
typedef GAS unsigned gu32;
typedef GAS unsigned long long gu64;
#define RLX_AGENT __ATOMIC_RELAXED, __HIP_MEMORY_SCOPE_AGENT
#define LDS_WAIT() asm volatile("s_waitcnt lgkmcnt(0)" ::: "memory")
#define VM_WAIT() asm volatile("s_waitcnt vmcnt(0)" ::: "memory")
__device__ __forceinline__ unsigned long long rt() { return __builtin_amdgcn_s_memrealtime(); }
__device__ __forceinline__ unsigned f2bf(float f) { unsigned u = __builtin_bit_cast(unsigned, f); return (u + 0x7fffu + ((u >> 16) & 1u)) >> 16; }
__device__ __forceinline__ unsigned pk2(float lo, float hi) { return f2bf(lo) | (f2bf(hi) << 16); }

#define XB_TMO      128
#define XB_XCNT(j)  (256  + 64 * (j))
#define XB_XSUB(j)  (1280 + 64 * (j))
#define XB_XGEN(j)  (2304 + 64 * (j))
#define XB_TOP      3328
#define XB_TOPGEN   3392
#define XCD_BAR_WORDS 3456
#define XB_SPIN_CAP (1u << 18)

__device__ __forceinline__ unsigned xb_ld(unsigned* p)              { return __hip_atomic_load(p, __ATOMIC_RELAXED, __HIP_MEMORY_SCOPE_AGENT); }
__device__ __forceinline__ unsigned xb_add(unsigned* p, unsigned v) { return __hip_atomic_fetch_add(p, v, __ATOMIC_RELAXED, __HIP_MEMORY_SCOPE_AGENT); }
__device__ __forceinline__ unsigned xb_xcc_id() { return (unsigned)__builtin_amdgcn_s_getreg((3 << 11) | 20) & 0xFu; }
#define XB_SPIN(cond, bar) do { unsigned _sp = 0; while (cond) { __builtin_amdgcn_s_sleep(1); \
    if ((++_sp & 255u) == 0u) { if (xb_ld(&(bar)[XB_TMO])) break; if (_sp > XB_SPIN_CAP) { atomicAdd(&(bar)[XB_TMO], 1u); break; } } } } while (0)

struct XcdBarrier {
    unsigned* bar; unsigned x;
    volatile LAS unsigned* st;
};

__device__ __forceinline__ XcdBarrier xcd_barrier_post(unsigned* bar, volatile LAS unsigned* st) {
    XcdBarrier b; b.bar = bar; b.x = xb_xcc_id(); b.st = st;
    if (threadIdx.x == 0) (void)xb_add(&bar[XB_XCNT(b.x)], 1u);
    return b;
}
__device__ __forceinline__ void xcd_barrier_complete(unsigned* bar, unsigned x, unsigned& nloc, unsigned& nx) {
    const unsigned G = gridDim.x * gridDim.y * gridDim.z;
    unsigned sum, cnt, mine, sp = 0u;
    for (;;) {
        sum = 0u; cnt = 0u; mine = 0u;
#pragma unroll
        for (unsigned j = 0; j < 16; ++j) { const unsigned c = xb_ld(&bar[XB_XCNT(j)]); sum += c; cnt += (c > 0u) ? 1u : 0u; mine = (j == x) ? c : mine; }
        if (sum == G) break;
        __builtin_amdgcn_s_sleep(1);
        if ((++sp & 255u) == 0u) { if (xb_ld(&bar[XB_TMO])) break; if (sp > XB_SPIN_CAP) { atomicAdd(&bar[XB_TMO], 1u); break; } }
    }
    nloc = mine > 0u ? mine : 1u; nx = cnt > 0u ? cnt : 1u;
}

__device__ __forceinline__ void xcd_barrier(const XcdBarrier& b) {
    asm volatile("s_waitcnt vmcnt(0)" ::: "memory");
    __syncthreads();
    if (threadIdx.x == 0) {
        unsigned* bar = b.bar;
        __builtin_amdgcn_s_waitcnt(0);
        unsigned nloc = b.st[0], nx = b.st[1];
        if (nloc == 0u) { xcd_barrier_complete(bar, b.x, nloc, nx); b.st[0] = nloc; b.st[1] = nx; }
        const unsigned old = xb_add(&bar[XB_XSUB(b.x)], 1u);
        const unsigned gen = old / nloc;
        if (old + 1u == (gen + 1u) * nloc) {
            __builtin_amdgcn_fence(__ATOMIC_RELEASE, "agent");
            asm volatile("s_waitcnt vmcnt(0)" ::: "memory");
            const unsigned og = xb_add(&bar[XB_TOP], 1u);
            const unsigned tg = og / nx;
            if (og + 1u == (tg + 1u) * nx) xb_add(&bar[XB_TOPGEN], 1u);
            else XB_SPIN(xb_ld(&bar[XB_TOPGEN]) == tg, bar);
            __builtin_amdgcn_fence(__ATOMIC_ACQUIRE, "agent");
            xb_add(&bar[XB_XGEN(b.x)], 1u);
            asm volatile("s_waitcnt vmcnt(0)" ::: "memory");
        } else {
            XB_SPIN(xb_ld(&bar[XB_XGEN(b.x)]) == gen, bar);
            __builtin_amdgcn_fence(__ATOMIC_ACQUIRE, "agent");
            asm volatile("s_waitcnt vmcnt(0)" ::: "memory");
        }
    }
    __syncthreads();
}


constexpr int BATCH = 32, SEQ = 2048, D = 1024, M = BATCH * SEQ, DEPTH = 2;
constexpr int NIN = 7448, NMAIN = 4608, NMG = 3072, NINP = NMAIN + NMG;
constexpr float EPS = 1e-6f;
constexpr int PC_AQ = 0, PC_AK = 512, PC_AV = 640, PC_AG = 768, PC_GQ = 1280, PC_GK = 1536, PC_GV = 1792, PC_GG = 2304, PC_XBC = 2816, PC_SZ = 3840, PC_GD = 4352, PC_DT = 4368;
__host__ __device__ __forceinline__ int src_col(int d) {
    if (d < 2816) return d;
    if (d < 3840) return d + 16;
    if (d < 4352) return d + 24;
    if (d < 4368) return 2816 + (d - 4352);
    if (d < 4376) return 3856 + (d - 4368);
    if (d < NMAIN) return -1;
    return 4376 + (d - NMAIN);
}
constexpr size_t MiB = 1u << 20;
constexpr size_t WS_CTL = 0, CTL_ZERO_BYTES = 1 * MiB;
constexpr size_t WS_WIN = 1 * MiB;
constexpr size_t WS_WB = 31 * MiB;
constexpr size_t WS_WO = 37 * MiB;
constexpr size_t WS_PAR = 41 * MiB;
constexpr int PG_NORM = 0, PG_QN = 1024, PG_KN = 1088, PG_SINK = 1152, PG_GWG = 1160, PG_GBG = 5256, PG_GON = 5512, PG_CW = 5640, PG_CB = 9736, PG_DTB = 10760, PG_ALOG = 10768, PG_DSK = 10776, PG_SON = 10784, PSTRIDE = 11296;
constexpr size_t WS_XN = 48 * MiB;
constexpr size_t WS_Y = 176 * MiB;
constexpr size_t WS_PROJ = 368 * MiB;
constexpr size_t WS_MG = 368 * MiB;
constexpr size_t WS_MERGED = 752 * MiB;
constexpr size_t WS_CS = 944 * MiB;
constexpr size_t WS_KR = 960 * MiB;
constexpr size_t WS_END = 1024 * MiB;
static_assert(WS_PROJ + (size_t)M * NMAIN * 2 <= WS_CS && WS_MG + (size_t)M * NMG * 2 <= WS_MERGED && WS_MERGED + (size_t)M * D * 2 <= WS_CS, "ws map");
constexpr int CW_TMO = 0, CW_CODE = 1;
constexpr int CW_Q = 64;
constexpr int CW_BAR = 4096;
constexpr int NPHASE = 14, MAX_LAUNCH = 16;
constexpr int RING_OFF = 0, RING_BYTES = 131072;
constexpr int LDSCTL_OFF = RING_BYTES, MISC_OFF = LDSCTL_OFF + 320;
constexpr int LDS_BYTES = 147456;
constexpr int NWAVES = 8, NTHR = 512;

struct Args { const void* in[18]; float* out; unsigned char* ws; int ph_lo, ph_hi, li, pad; };

__device__ __forceinline__ float wave_sum(float v) {
#pragma unroll
    for (int o = 1; o < 64; o <<= 1) v += __shfl_xor(v, o);
    return v;
}
__device__ __forceinline__ float bf2f(bf16 b) { return __builtin_bit_cast(float, ((unsigned)b) << 16); }
__device__ __forceinline__ float siluf(float x) { return x / (1.f + __expf(-x)); }
__device__ __forceinline__ float softplusf(float x) { return x > 20.f ? x : log1pf(__expf(x)); }
__device__ __forceinline__ float logsigmoidf(float x) { return fminf(x, 0.f) - log1pf(__expf(-fabsf(x))); }

template <bool MAPPED>
__device__ __forceinline__ void transpose_item(const float* W, int K, int N, bf16* WT, LAS float* scr, int item, int nblk, int lane) {
    const int kb = item / nblk, nb = item % nblk, k0 = 64 * kb, n0 = 32 * nb;
    const int nd = n0 + (lane & 31); const int sc = MAPPED ? src_col(nd) : nd;
#pragma unroll 8
    for (int i = 0; i < 32; ++i) { const int kk = 2 * i + (lane >> 5); scr[kk * 33 + (lane & 31)] = sc >= 0 ? W[(size_t)(k0 + kk) * N + sc] : 0.f; }
    LDS_WAIT(); asm volatile("" ::: "memory");
    const int c = lane & 7;
#pragma unroll
    for (int j = 0; j < 4; ++j) { const int n = (lane >> 3) + 8 * j; const LAS float* s = scr + (8 * c) * 33 + n;
        v4u o; o.x = pk2(s[0 * 33], s[1 * 33]); o.y = pk2(s[2 * 33], s[3 * 33]); o.z = pk2(s[4 * 33], s[5 * 33]); o.w = pk2(s[6 * 33], s[7 * 33]);
        *(GAS v4u*)(WT + (size_t)(n0 + n) * K + k0 + 8 * c) = o; }
    LDS_WAIT(); asm volatile("" ::: "memory");
}
__device__ __forceinline__ void rms_row_to_bf16(const float* xrow, const float* g, bf16* orow, int lane) {
    const GAS f32x4* xr = (const GAS f32x4*)xrow + lane; const GAS f32x4* gr = (const GAS f32x4*)g + lane;
    f32x4 v[4]; float s = 0.f;
#pragma unroll
    for (int j = 0; j < 4; ++j) { v[j] = xr[64 * j]; s += (v[j].x * v[j].x + v[j].y * v[j].y) + (v[j].z * v[j].z + v[j].w * v[j].w); }
    const float r = 1.f / sqrtf(wave_sum(s) * (1.f / D) + EPS);
    GAS unsigned long long* o8 = (GAS unsigned long long*)orow + lane;
#pragma unroll
    for (int j = 0; j < 4; ++j) { const f32x4 gg = gr[64 * j];
        o8[64 * j] = (unsigned long long)pk2(v[j].x * r * gg.x, v[j].y * r * gg.y) | ((unsigned long long)pk2(v[j].z * r * gg.z, v[j].w * r * gg.w) << 32); }
}

__device__ __forceinline__ void naive_kprep(const bf16* PROJ, const float* knorm, const float2* CS, float* KR, int gw, int NGW, int lane) {
    for (int it = gw; it < M * 2; it += NGW) {
        const int m = it >> 1, kvh = it & 1;
        const float v = bf2f(PROJ[(size_t)m * NMAIN + PC_AK + kvh * 64 + lane]);
        const float r = 1.f / sqrtf(wave_sum(v * v) * (1.f / 64.f) + EPS);
        const float y = v * r * knorm[lane];
        const float o = __shfl_xor(y, 32);
        const float2 cs = CS[(size_t)m * 32 + (lane & 31)];
        KR[(size_t)m * 128 + kvh * 64 + lane] = lane < 32 ? y * cs.x - o * cs.y : y * cs.x + o * cs.y;
    }
}
__device__ __forceinline__ void naive_attn_item(int item, const bf16* PROJ, const float* KR, const float2* CS, const float* qnorm, const float* sinks, bf16* YA, int wave, int lane) {
    const int hq = wave, kvh = hq >> 2; const float sink = sinks[hq]; const float qn = qnorm[lane];
    for (int tt = 0; tt < 64; ++tt) {
        const int m = item * 64 + tt, t = m & (SEQ - 1), mb = m - t;
        const float v = bf2f(PROJ[(size_t)m * NMAIN + PC_AQ + hq * 64 + lane]);
        const float r = 1.f / sqrtf(wave_sum(v * v) * (1.f / 64.f) + EPS);
        const float y = v * r * qn; const float o = __shfl_xor(y, 32);
        const float2 cs = CS[(size_t)m * 32 + (lane & 31)];
        const float q = (lane < 32 ? y * cs.x - o * cs.y : y * cs.x + o * cs.y) * 0.125f;
        float mx = sink, l = 1.f, acc = 0.f;
        const int j0 = t - 127 > 0 ? t - 127 : 0;
        for (int j = j0; j <= t; ++j) {
            const size_t mj = (size_t)(mb + j);
            const float s = wave_sum(q * KR[mj * 128 + kvh * 64 + lane]);
            const float vv = bf2f(PROJ[mj * NMAIN + PC_AV + kvh * 64 + lane]);
            const float mn = fmaxf(mx, s); const float c = __expf(mx - mn), p = __expf(s - mn);
            l = l * c + p; acc = acc * c + p * vv; mx = mn;
        }
        const float g = bf2f(PROJ[(size_t)m * NMAIN + PC_AG + hq * 64 + lane]);
        YA[(size_t)m * 512 + hq * 64 + lane] = (bf16)f2bf(acc / l * siluf(g));
    }
}
__device__ __forceinline__ void naive_gla_unit(int unit, const bf16* PROJ, const float* Wg, const float* bg, const float* onorm, bf16* YB, LAS unsigned char* lds, int tid) {
    const int b = unit >> 2, h = unit & 3; const int lane = tid & 63, wave = tid >> 6;
    LAS float* sA = (LAS float*)lds; LAS float* sQ = sA + 4096; LAS float* sK = sQ + 4096; LAS float* sV = sK + 4096; LAS float* sO = sV + 8192;
    const int v = tid >> 2, dq = tid & 3;
    float S[16];
#pragma unroll
    for (int i = 0; i < 16; ++i) S[i] = 0.f;
    for (int blk = 0; blk < SEQ / 64; ++blk) {
        const size_t m0 = (size_t)b * SEQ + blk * 64;
        for (int e = tid; e < 4096; e += NTHR) { const int t = e >> 6, d = e & 63; const bf16* row = PROJ + (m0 + t) * NMAIN;
            float lg = bg[64 * h + d];
#pragma unroll
            for (int r = 0; r < 16; ++r) lg += bf2f(row[PC_GD + r]) * Wg[r * 256 + 64 * h + d];
            sA[e] = __expf(logsigmoidf(lg) * (1.f / 16.f)); sQ[e] = bf2f(row[PC_GQ + 64 * h + d]) * 0.125f; sK[e] = bf2f(row[PC_GK + 64 * h + d]); }
        for (int e = tid; e < 8192; e += NTHR) { const int t = e >> 7, vv = e & 127; sV[e] = bf2f(PROJ[(m0 + t) * NMAIN + PC_GV + 128 * h + vv]); }
        __syncthreads();
        for (int t = 0; t < 64; ++t) { const float vv = sV[t * 128 + v]; float o = 0.f;
#pragma unroll
            for (int i = 0; i < 16; ++i) { const int d = 16 * dq + i; S[i] = sA[t * 64 + d] * S[i] + sK[t * 64 + d] * vv; o += sQ[t * 64 + d] * S[i]; }
            o += __shfl_xor(o, 1); o += __shfl_xor(o, 2);
            if (dq == 0) sO[t * 128 + v] = o; }
        __syncthreads();
        for (int tt = 0; tt < 8; ++tt) { const int t = wave * 8 + tt; const float o0 = sO[t * 128 + lane], o1 = sO[t * 128 + 64 + lane];
            const float r = 1.f / sqrtf(wave_sum(o0 * o0 + o1 * o1) * (1.f / 128.f) + EPS); const bf16* row = PROJ + (m0 + t) * NMAIN;
            YB[(m0 + t) * 512 + 128 * h + lane] = (bf16)f2bf(o0 * r * onorm[lane] * siluf(bf2f(row[PC_GG + 128 * h + lane])));
            YB[(m0 + t) * 512 + 128 * h + 64 + lane] = (bf16)f2bf(o1 * r * onorm[64 + lane] * siluf(bf2f(row[PC_GG + 128 * h + 64 + lane]))); }
        __syncthreads();
    }
}
__device__ __forceinline__ void naive_ssd_unit(int unit, const bf16* PROJ, const float* convw, const float* convb, const float* dtb, const float* Alog, const float* Dsk, const float* onorm,
                                               bf16* YC, LAS unsigned char* lds, int tid) {
    const int b = unit >> 1, g = unit & 1; const int lane = tid & 63, wave = tid >> 6;
    LAS float* sX = (LAS float*)lds;
    LAS float* sY = sX + 32 * 512;
    LAS float* sDt = sY + 32 * 256;
    LAS float* sDA = sDt + 128;
    const int cidx = tid < 256 ? 256 * g + tid : (tid < 384 ? 512 + 128 * g + (tid - 256) : 768 + 128 * g + (tid - 384));
    const float w0 = convw[0 * 1024 + cidx], w1 = convw[1 * 1024 + cidx], w2 = convw[2 * 1024 + cidx], w3 = convw[3 * 1024 + cidx], cb = convb[cidx];
    float u0 = 0.f, u1 = 0.f, u2 = 0.f;
    const int hl = tid >> 7, p = (tid >> 1) & 63, nh = tid & 1; const float Dk = Dsk[4 * g + hl];
    float hst[64];
#pragma unroll
    for (int i = 0; i < 64; ++i) hst[i] = 0.f;
    for (int blk = 0; blk < SEQ / 32; ++blk) {
        const size_t m0 = (size_t)b * SEQ + blk * 32;
        for (int t = 0; t < 32; ++t) { const float u3 = bf2f(PROJ[(m0 + t) * NMAIN + PC_XBC + cidx]);
            sX[t * 512 + tid] = siluf(cb + w0 * u0 + w1 * u1 + w2 * u2 + w3 * u3); u0 = u1; u1 = u2; u2 = u3; }
        if (tid < 128) { const int t = tid & 31, hh = tid >> 5; const float raw = bf2f(PROJ[(m0 + t) * NMAIN + PC_DT + 4 * g + hh]);
            const float dt = softplusf(raw + dtb[4 * g + hh]); sDt[hh * 32 + t] = dt; sDA[hh * 32 + t] = __expf(-dt * __expf(Alog[4 * g + hh])); }
        __syncthreads();
        for (int t = 0; t < 32; ++t) { const float dt = sDt[hl * 32 + t], da = sDA[hl * 32 + t]; const float xv = sX[t * 512 + 64 * hl + p]; const float xdt = xv * dt; float yp = 0.f;
#pragma unroll
            for (int i = 0; i < 64; ++i) { const int n = 64 * nh + i; hst[i] = da * hst[i] + xdt * sX[t * 512 + 256 + n]; yp += hst[i] * sX[t * 512 + 384 + n]; }
            yp += __shfl_xor(yp, 1);
            if (nh == 0) sY[t * 256 + 64 * hl + p] = yp + Dk * xv; }
        __syncthreads();
        for (int tt = 0; tt < 4; ++tt) { const int t = wave * 4 + tt; const bf16* row = PROJ + (m0 + t) * NMAIN; float u[4]; float ss = 0.f;
#pragma unroll
            for (int i = 0; i < 4; ++i) { const int c = lane + 64 * i; u[i] = sY[t * 256 + c] * siluf(bf2f(row[PC_SZ + 256 * g + c])); ss += u[i] * u[i]; }
            const float r = 1.f / sqrtf(wave_sum(ss) * (1.f / 256.f) + EPS);
#pragma unroll
            for (int i = 0; i < 4; ++i) { const int c = lane + 64 * i; YC[(m0 + t) * 512 + 256 * g + c] = (bf16)f2bf(u[i] * r * onorm[256 * g + c]); } }
        __syncthreads();
    }
}

__global__ void __launch_bounds__(NTHR, 2) mega_fwd(Args args) {
    extern __shared__ __attribute__((aligned(16))) unsigned char lds_raw[];
    LAS unsigned char* lds = (LAS unsigned char*)lds_raw;
    volatile LAS unsigned* MISC = (volatile LAS unsigned*)(lds + MISC_OFF);
    const int tid = threadIdx.x, lane = tid & 63, wave = __builtin_amdgcn_readfirstlane(tid >> 6);
    const int G = gridDim.x, bx = blockIdx.x;
    unsigned char* ws = args.ws;
    gu32* ctl = (gu32*)(ws + WS_CTL);
    const float* x_in = (const float*)args.in[0];
    float* out = args.out;
    bf16* WIN = (bf16*)(ws + WS_WIN); bf16* WB = (bf16*)(ws + WS_WB); bf16* WO = (bf16*)(ws + WS_WO);
    bf16* XN = (bf16*)(ws + WS_XN); bf16* Y = (bf16*)(ws + WS_Y); bf16* PROJ = (bf16*)(ws + WS_PROJ); bf16* MG = (bf16*)(ws + WS_MG); bf16* MERGED = (bf16*)(ws + WS_MERGED);
    float2* CS = (float2*)(ws + WS_CS); float* KR = (float*)(ws + WS_KR); float* PAR = (float*)(ws + WS_PAR);

    for (int u = tid; u < (LDS_BYTES - LDSCTL_OFF) / 4; u += NTHR) ((LAS unsigned*)(lds + LDSCTL_OFF))[u] = 0u;
    __syncthreads();
    XcdBarrier bar = xcd_barrier_post((unsigned*)(ctl + CW_BAR) + args.li * XCD_BAR_WORDS, MISC + 8);
    const int lo = args.ph_lo, hi = args.ph_hi;
#define IN(k) (lo <= (k) && (k) < hi)
#define otid() ({ int t_ = tid; asm volatile("" : "+v"(t_)); t_; })
#define SEAM(k) do { if (IN(k) && IN((k) + 1)) xcd_barrier(bar); } while (0)
    const int gw = bx * NWAVES + wave, NGW = G * NWAVES;

    if (IN(0)) {
        LAS float* scr = (LAS float*)(lds + RING_OFF + wave * 16384);
        constexpr int I_IN = (D / 64) * (NINP / 32), I_B = (512 / 64) * (D / 32), I_O = (D / 64) * (D / 32);
        constexpr int NITEMS = DEPTH * (I_IN + 3 * I_B + I_O);
        for (int it = gw; it < NITEMS; it += NGW) {
            int r = it; const int l = r / (I_IN + 3 * I_B + I_O); r -= l * (I_IN + 3 * I_B + I_O);
            if (r < I_IN) { transpose_item<true>((const float*)args.in[3] + (size_t)l * D * NIN, D, NIN, WIN + (size_t)l * NINP * D, scr, r, NINP / 32, lane); continue; } r -= I_IN;
            if (r < 3 * I_B) { const int n = r / I_B; r -= n * I_B;
                transpose_item<false>((const float*)args.in[16] + (size_t)(l * 3 + n) * 512 * D, 512, D, WB + (size_t)(l * 3 + n) * D * 512, scr, r, D / 32, lane); continue; } r -= 3 * I_B;
            transpose_item<false>((const float*)args.in[17] + (size_t)l * D * D, D, D, WO + (size_t)l * D * D, scr, r, D / 32, lane);
        }
        for (int m = gw; m < M; m += NGW) rms_row_to_bf16(x_in + (size_t)m * D, (const float*)args.in[2], XN + (size_t)m * D, lane);
        for (int e = bx * NTHR + tid; e < M * 32; e += G * NTHR) { const int m = e >> 5, i = e & 31;
            const float inv = exp2f(-(float)(2 * i) * (13.287712379549449f / 64.f)); const float ang = (float)((const int*)args.in[1])[m] * inv; float sn, cn; sincosf(ang, &sn, &cn); CS[e] = make_float2(cn, sn); }
        {
            const int gt = bx * NTHR + tid, GT = G * NTHR;
#define CPY(idx, off, n) for (int e = gt; e < DEPTH * (n); e += GT) PAR[(e / (n)) * PSTRIDE + (off) + e % (n)] = ((const float*)args.in[idx])[e]
            CPY(2, PG_NORM, 1024); CPY(4, PG_QN, 64); CPY(5, PG_KN, 64); CPY(6, PG_SINK, 8); CPY(7, PG_GWG, 4096); CPY(8, PG_GBG, 256); CPY(9, PG_GON, 128);
            CPY(10, PG_CW, 4096); CPY(11, PG_CB, 1024); CPY(12, PG_DTB, 8); CPY(13, PG_ALOG, 8); CPY(14, PG_DSK, 8); CPY(15, PG_SON, 512);
#undef CPY
        }
    }
    SEAM(0);

    for (int l = 0; l < DEPTH; ++l) {
        const int pb = 1 + 7 * l;
        const float* xin = l == 0 ? x_in : out;
        const float* par = PAR + l * PSTRIDE;
        if (IN(pb + 0)) {
            pg8::Gemm g{XN, WIN + (size_t)l * NINP * D, M, NMAIN, D}; pg8::StaticOrder S; S.init(M, NMAIN, G, bx);
            pg8::EpiBf16<0> E{PROJ, NMAIN};
            pg8::gemm_phase<pg8::EpiBf16<0>, pg8::StaticOrder, true, true>(lds + RING_OFF, g, S, E, otid());
        }
        SEAM(pb + 0);
        if (IN(pb + 1)) naive_kprep(PROJ, par + PG_KN, CS, KR, gw, NGW, lane);
        SEAM(pb + 1);
        if (IN(pb + 2)) {
            for (int uu = bx; uu < 192; uu += G) {
            if (uu < 64) naive_ssd_unit(uu, PROJ, par + PG_CW, par + PG_CB, par + PG_DTB, par + PG_ALOG, par + PG_DSK, par + PG_SON, Y + (size_t)2 * M * 512, lds, otid());
            else naive_gla_unit(uu - 64, PROJ, par + PG_GWG, par + PG_GBG, par + PG_GON, Y + (size_t)1 * M * 512, lds, otid());
            }
            for (int item = bx; item < M / 64; item += G) { const int t_ = otid(); naive_attn_item(item, PROJ, KR, CS, par + PG_QN, par + PG_SINK, Y, __builtin_amdgcn_readfirstlane(t_ >> 6), t_ & 63); }
        }
        SEAM(pb + 2);
        if (IN(pb + 3)) {
            pg8::Gemm g{XN, WIN + (size_t)l * NINP * D + (size_t)NMAIN * D, M, NMG, D}; pg8::StaticOrder S; S.init(M, NMG, G, bx);
            pg8::EpiBf16<1> E{MG, NMG};
            pg8::gemm_phase<pg8::EpiBf16<1>, pg8::StaticOrder, true, true>(lds + RING_OFF, g, S, E, otid());
        }
        SEAM(pb + 3);
        if (IN(pb + 4)) {
            for (int n = 0; n < 3; ++n) {
                pg8::Gemm g{Y + (size_t)n * M * 512, WB + (size_t)(l * 3 + n) * D * 512, M, D, 512}; pg8::StaticOrder S; S.init(M, D, G, bx);
                pg8::EpiMerge E{MG + n * D, NMG, MERGED, D, n == 0 ? 1 : 0};
                pg8::gemm_phase<pg8::EpiMerge, pg8::StaticOrder, true, true>(lds + RING_OFF, g, S, E, otid());
                asm volatile("s_waitcnt vmcnt(0)" ::: "memory"); __syncthreads();
            }
        }
        SEAM(pb + 4);
        if (IN(pb + 5)) {
            pg8::Gemm g{MERGED, WO + (size_t)l * D * D, M, D, D}; pg8::StaticOrder S; S.init(M, D, G, bx);
            pg8::EpiResid E{xin, out, D};
            pg8::gemm_phase<pg8::EpiResid, pg8::StaticOrder, true, true>(lds + RING_OFF, g, S, E, otid());
        }
        SEAM(pb + 5);
        if (l + 1 < DEPTH) {
            if (IN(pb + 6)) { for (int m = gw; m < M; m += NGW) rms_row_to_bf16(out + (size_t)m * D, par + PSTRIDE + PG_NORM, XN + (size_t)m * D, lane); }
            SEAM(pb + 6);
        }
    }
#undef IN
#undef SEAM
}

#ifndef MK_SPLIT
#define MK_SPLIT 1
#endif
extern "C" void kernel_launch(void* const* d_in, const int* in_sizes, int n_in, void* d_out, int out_size, void* d_ws, size_t ws_size, hipStream_t stream) {
    static int grid = 0;
    if (grid == 0) {
        if (n_in != 18 || in_sizes[0] != M * D || out_size != M * D || ws_size < WS_END) { fprintf(stderr, "kernel_launch: unexpected shapes/ws (n_in %d, ws %zu)\n", n_in, ws_size); grid = -1; return; }
        int dev = 0, cus = 0, per_cu = 0;
        if (hipGetDevice(&dev) != hipSuccess || hipDeviceGetAttribute(&cus, hipDeviceAttributeMultiprocessorCount, dev) != hipSuccess) { grid = -1; return; }
        if (hipFuncSetAttribute((const void*)mega_fwd, hipFuncAttributeMaxDynamicSharedMemorySize, LDS_BYTES) != hipSuccess) { grid = -1; return; }
        if (hipOccupancyMaxActiveBlocksPerMultiprocessor(&per_cu, (const void*)mega_fwd, NTHR, LDS_BYTES) != hipSuccess || per_cu < 1) { fprintf(stderr, "kernel_launch: occupancy query says %d\n", per_cu); }
        (void)hipGetLastError();
        grid = cus;
    }
    if (grid < 0) return;
    if (hipMemsetAsync((char*)d_ws + WS_CTL, 0, CTL_ZERO_BYTES, stream) != hipSuccess) return;
    Args a{};
    for (int i = 0; i < 18; ++i) a.in[i] = d_in[i];
    a.out = (float*)d_out; a.ws = (unsigned char*)d_ws;
#if MK_SPLIT
    int li = 0;
    for (int ph = 0; ph < NPHASE; ++ph) {
        a.ph_lo = ph; a.ph_hi = ph + 1; a.li = li++; a.pad = 0;
        hipLaunchKernelGGL(mega_fwd, dim3(grid), dim3(NTHR), LDS_BYTES, stream, a); }
#else
    a.ph_lo = 0; a.ph_hi = NPHASE; a.li = 0; a.pad = 0;
    hipLaunchKernelGGL(mega_fwd, dim3(grid), dim3(NTHR), LDS_BYTES, stream, a);
#endif
}
```

```cpp
#include <hip/hip_runtime.h>
#include <cstdio>
#include <cstdint>
#define MK_SPLIT 0
namespace pg8 {
#define PG8_LAS __attribute__((address_space(3)))
typedef unsigned short bf16_t;
typedef short bf16x8 __attribute__((ext_vector_type(8)));
typedef float f32x4 __attribute__((ext_vector_type(4)));
typedef unsigned u32x4 __attribute__((ext_vector_type(4)));
constexpr int BM = 256, BK = 64, HALF = 128, HTB = HALF * BK * 2  , STAGE_BYTES = 8 * HTB, NXCD = 8, WGM = 8;

__host__ __device__ __forceinline__ int lds_byte(int r, int c) { const int st = (r >> 4) * 2 + (c >> 5), rr = r & 15, cc = c & 31, ob = rr * 64 + cc * 2; return st * 1024 + (ob ^ (((ob >> 9) & 1) << 5)); }
__host__ __device__ __forceinline__ void stage_rc(int b, int& R, int& C) { const int st = b / 1024, sb = b % 1024, swz = sb ^ (((sb >> 9) & 1) << 5); R = (st >> 1) * 16 + swz / 64; C = (st & 1) * 32 + (swz % 64) / 2; }
__host__ __device__ __forceinline__ int perm32(int rho) { const int n = rho >> 4, i = rho & 15; return 8 * (i >> 2) + 4 * n + (i & 3); }

struct Unit { int pm, pn; };
struct Gemm { const bf16_t* A; const bf16_t* Bt; int M, N, K; };

struct StaticOrder {
    int nM, nN, nwg, G, c;
    __host__ __device__ void init(int M, int N, int G_, int c_) { nM = M / BM; nN = N / BM; nwg = nM * nN; G = G_; c = c_; }
    __host__ __device__ bool next(int i, Unit& u) const {
        const long L = (long)i * G + c; if (L >= nwg) return false;
        int wgid = (int)L; { const int q = nwg / NXCD, r = nwg % NXCD, xcd = wgid % NXCD, off = wgid / NXCD; wgid = (xcd < r ? xcd * (q + 1) : r * (q + 1) + (xcd - r) * q) + off; }
        const int nig = WGM * nN, gid = wgid / nig, fm = gid * WGM, gsz = (nM - fm) < WGM ? (nM - fm) : WGM;
        u.pm = fm + ((wgid % nig) % gsz); u.pn = (wgid % nig) / gsz; return true;
    }
    __device__ __forceinline__ void a_ready(const Unit&) const {}
    __device__ __forceinline__ void done(const Unit&) const {}
};

typedef float f32x2c __attribute__((ext_vector_type(2))); typedef __bf16 bf16x2c __attribute__((ext_vector_type(2)));
__device__ __forceinline__ unsigned cvt_pk_bf16(float lo, float hi) { const f32x2c v = {lo, hi}; const bf16x2c b = __builtin_convertvector(v, bf16x2c); return __builtin_bit_cast(unsigned, b); }
typedef float f32x2 __attribute__((ext_vector_type(2)));

#define PG8_GAS __attribute__((address_space(1)))
template <class T> __device__ __forceinline__ T gld_(const void* p) { return *(const PG8_GAS T*)p; }
template <class T> __device__ __forceinline__ void gst_(void* p, T v) { *(PG8_GAS T*)p = v; }
__device__ __forceinline__ float sigmoid_fast(float x) { return __builtin_amdgcn_rcpf(1.f + __builtin_amdgcn_exp2f(-1.44269504f * x)); }
__device__ __forceinline__ float bf_lo(unsigned w) { return __builtin_bit_cast(float, w << 16); }
__device__ __forceinline__ float bf_hi(unsigned w) { return __builtin_bit_cast(float, w & 0xffff0000u); }

__device__ __forceinline__ float xrow_sum_e(float x) { unsigned a = __builtin_bit_cast(unsigned, x), b = a; asm volatile("s_nop 1\n\tv_permlane16_swap_b32 %0, %1" : "+v"(a), "+v"(b));
    const float y = __builtin_bit_cast(float, a) + __builtin_bit_cast(float, b); unsigned c = __builtin_bit_cast(unsigned, y), d = c; asm volatile("s_nop 1\n\tv_permlane32_swap_b32 %0, %1" : "+v"(c), "+v"(d));
    return __builtin_bit_cast(float, c) + __builtin_bit_cast(float, d); }
template <int ACT> struct EpiBf16 {
    static constexpr bool PERM = true, AFTER_DRAIN = false, CHAIN = false;
    bf16_t* O; int ldc; const float* rinv;
    __device__ __forceinline__ void operator()(const f32x4 (&acc)[2][2][4][2], const Unit& u, int wr, int wc, int fr, int fq) const {
        const int row0 = u.pm * BM + wr * 64 + fr; const int col0 = u.pn * BM + wc * 32 + 8 * fq;
        float rs[2][4];
#pragma unroll
        for (int ai = 0; ai < 2; ++ai)
#pragma unroll
            for (int m = 0; m < 4; ++m) rs[ai][m] = rinv ? gld_<float>(rinv + row0 + ai * HALF + m * 16) : 1.f;
#pragma unroll
        for (int ai = 0; ai < 2; ++ai)
#pragma unroll
            for (int m = 0; m < 4; ++m) { bf16_t* rowp = O + (size_t)(row0 + ai * HALF + m * 16) * ldc + col0;
#pragma unroll
                for (int bj = 0; bj < 2; ++bj) { f32x4 v0 = acc[ai][bj][m][0] * rs[ai][m], v1 = acc[ai][bj][m][1] * rs[ai][m];
                    if (ACT == 1) {
#pragma unroll
                        for (int j = 0; j < 4; ++j) { v0[j] = __builtin_amdgcn_rcpf(1.f + __builtin_amdgcn_exp2f(fminf(v0[j], 60.f))); v1[j] = __builtin_amdgcn_rcpf(1.f + __builtin_amdgcn_exp2f(fminf(v1[j], 60.f))); } }
                    u32x4 w; w.x = cvt_pk_bf16(v0[0], v0[1]); w.y = cvt_pk_bf16(v0[2], v0[3]); w.z = cvt_pk_bf16(v1[0], v1[1]); w.w = cvt_pk_bf16(v1[2], v1[3]);
                    gst_<u32x4>(rowp + bj * HALF, w); } }
    }
};
struct EpiGate {
    static constexpr bool PERM = true, AFTER_DRAIN = false, CHAIN = false;
    bf16_t* O; int ldc; const float* rinv;
    __device__ __forceinline__ void operator()(const f32x4 (&acc)[2][2][4][2], const Unit& u, int wr, int wc, int fr, int fq) const {
        const int row0 = u.pm * BM + wr * 64 + fr;
        float rs[2][4];
#pragma unroll
        for (int ai = 0; ai < 2; ++ai)
#pragma unroll
            for (int m = 0; m < 4; ++m) rs[ai][m] = rinv ? gld_<float>(rinv + row0 + ai * HALF + m * 16) : 1.f;
        if (u.pn < 8) {
            const int colq = u.pn * HALF + wc * 32 + 8 * fq;
#pragma unroll
            for (int ai = 0; ai < 2; ++ai)
#pragma unroll
                for (int m = 0; m < 4; ++m) { bf16_t* rowp = O + (size_t)(row0 + ai * HALF + m * 16) * ldc + colq;
                    float r[8], g[8];
#pragma unroll
                    for (int n = 0; n < 2; ++n)
#pragma unroll
                        for (int j = 0; j < 4; ++j) { const float d0 = 1.f + __builtin_amdgcn_exp2f(fminf(acc[ai][0][m][n][j] * rs[ai][m], 60.f)), d1 = 1.f + __builtin_amdgcn_exp2f(fminf(acc[ai][1][m][n][j] * rs[ai][m], 60.f));
                            g[4 * n + j] = __builtin_amdgcn_rcpf(d1); r[4 * n + j] = d1 * __builtin_amdgcn_rcpf(d0); }
                    u32x4 w; w.x = cvt_pk_bf16(r[0], r[1]); w.y = cvt_pk_bf16(r[2], r[3]); w.z = cvt_pk_bf16(r[4], r[5]); w.w = cvt_pk_bf16(r[6], r[7]);
                    gst_<u32x4>(rowp, w);
                    w.x = cvt_pk_bf16(g[0], g[1]); w.y = cvt_pk_bf16(g[2], g[3]); w.z = cvt_pk_bf16(g[4], g[5]); w.w = cvt_pk_bf16(g[6], g[7]);
                    gst_<u32x4>(rowp + 1024, w); }
        } else {
            const int col0 = u.pn * BM + wc * 32 + 8 * fq;
#pragma unroll
            for (int ai = 0; ai < 2; ++ai)
#pragma unroll
                for (int m = 0; m < 4; ++m) { bf16_t* rowp = O + (size_t)(row0 + ai * HALF + m * 16) * ldc + col0;
#pragma unroll
                    for (int bj = 0; bj < 2; ++bj) { f32x4 v0 = acc[ai][bj][m][0] * rs[ai][m], v1 = acc[ai][bj][m][1] * rs[ai][m];
#pragma unroll
                        for (int j = 0; j < 4; ++j) { v0[j] = __builtin_amdgcn_rcpf(1.f + __builtin_amdgcn_exp2f(fminf(v0[j], 60.f))); v1[j] = __builtin_amdgcn_rcpf(1.f + __builtin_amdgcn_exp2f(fminf(v1[j], 60.f))); }
                        u32x4 w; w.x = cvt_pk_bf16(v0[0], v0[1]); w.y = cvt_pk_bf16(v0[2], v0[3]); w.z = cvt_pk_bf16(v1[0], v1[1]); w.w = cvt_pk_bf16(v1[2], v1[3]);
                        gst_<u32x4>(rowp + bj * HALF, w); } }
        }
    }
};
struct EpiProj {
    static constexpr bool PERM = true, AFTER_DRAIN = false, CHAIN = false;
    bf16_t *pa, *pg, *ps, *px; const float* rinv;
    __device__ __forceinline__ void operator()(const f32x4 (&acc)[2][2][4][2], const Unit& u, int wr, int wc, int fr, int fq) const {
        bf16_t* O; int ldc, ct;
        if (u.pn < 5) { O = pa; ldc = 1280; ct = u.pn; } else if (u.pn < 11) { O = pg; ldc = 1536; ct = u.pn - 5; } else if (u.pn < 17) { O = ps; ldc = 1536; ct = u.pn - 11; } else { O = px; ldc = 32; ct = 0; }
        const int row0 = u.pm * BM + wr * 64 + fr; const int col0 = ct * BM + wc * 32 + 8 * fq;
        float rs[2][4];
#pragma unroll
        for (int ai = 0; ai < 2; ++ai)
#pragma unroll
            for (int m = 0; m < 4; ++m) rs[ai][m] = rinv ? gld_<float>(rinv + row0 + ai * HALF + m * 16) : 1.f;
#pragma unroll
        for (int ai = 0; ai < 2; ++ai)
#pragma unroll
            for (int m = 0; m < 4; ++m) { bf16_t* rowp = O + (size_t)(row0 + ai * HALF + m * 16) * ldc + col0;
#pragma unroll
                for (int bj = 0; bj < 2; ++bj) { const f32x4 v0 = acc[ai][bj][m][0] * rs[ai][m], v1 = acc[ai][bj][m][1] * rs[ai][m];
                    u32x4 w; w.x = cvt_pk_bf16(v0[0], v0[1]); w.y = cvt_pk_bf16(v0[2], v0[3]); w.z = cvt_pk_bf16(v1[0], v1[1]); w.w = cvt_pk_bf16(v1[2], v1[3]);
                    if (u.pn < 17 || (bj == 0 && wc == 0)) gst_<u32x4>(rowp + bj * HALF, w); } }
    }
};
struct EpiMerge {
    static constexpr bool PERM = true, AFTER_DRAIN = false, CHAIN = false;
    const bf16_t* Gt; int ldg; bf16_t* Mg; int ldm; int first;
    __device__ __forceinline__ void operator()(const f32x4 (&acc)[2][2][4][2], const Unit& u, int wr, int wc, int fr, int fq) const {
        const int row0 = u.pm * BM + wr * 64 + fr; const int col0 = u.pn * BM + wc * 32 + 8 * fq;
#pragma unroll
        for (int ai = 0; ai < 2; ++ai) {
            u32x4 g[4][2], p[4][2];
#pragma unroll
            for (int m = 0; m < 4; ++m) { const size_t row = (size_t)(row0 + ai * HALF + m * 16);
#pragma unroll
                for (int bj = 0; bj < 2; ++bj) { g[m][bj] = gld_<u32x4>(Gt + row * ldg + col0 + bj * HALF);
                    p[m][bj] = (u32x4){0u, 0u, 0u, 0u}; if (!first) p[m][bj] = gld_<u32x4>(Mg + row * ldm + col0 + bj * HALF); } }
#pragma unroll
            for (int m = 0; m < 4; ++m) { const size_t row = (size_t)(row0 + ai * HALF + m * 16);
#pragma unroll
                for (int bj = 0; bj < 2; ++bj) { const f32x4 a0 = acc[ai][bj][m][0], a1 = acc[ai][bj][m][1]; const u32x4 gg = g[m][bj], pp = p[m][bj];
                    u32x4 w;
                    w.x = cvt_pk_bf16(bf_lo(pp.x) + bf_lo(gg.x) * a0[0], bf_hi(pp.x) + bf_hi(gg.x) * a0[1]);
                    w.y = cvt_pk_bf16(bf_lo(pp.y) + bf_lo(gg.y) * a0[2], bf_hi(pp.y) + bf_hi(gg.y) * a0[3]);
                    w.z = cvt_pk_bf16(bf_lo(pp.z) + bf_lo(gg.z) * a1[0], bf_hi(pp.z) + bf_hi(gg.z) * a1[1]);
                    w.w = cvt_pk_bf16(bf_lo(pp.w) + bf_lo(gg.w) * a1[2], bf_hi(pp.w) + bf_hi(gg.w) * a1[3]);
                    gst_<u32x4>(Mg + row * ldm + col0 + bj * HALF, w); } }
        }
    }
};
struct EpiMerge3 {
    static constexpr bool PERM = true, AFTER_DRAIN = false, CHAIN = true;
    static constexpr int LDG = 3072, LDM = 1024;
    const bf16_t* Gt; bf16_t* Mg;
    template <class T> static __device__ __forceinline__ T ldo(const bf16_t* base, int cdisp, unsigned off) { return *(const PG8_GAS T*)((const PG8_GAS unsigned char*)(base + cdisp) + (size_t)off); }
    template <int BR> __device__ __forceinline__ void run(f32x4 (&acc)[2][2][4][2], const Unit& u, int wr, int wc, int fr, int fq) const {
        const int row0 = (u.pm & 255) * BM + wr * 64 + fr; const int col0 = (u.pn & 3) * BM + wc * 32 + 8 * fq;
        const unsigned og = ((unsigned)row0 * LDG + col0) * 2u, om = ((unsigned)row0 * LDM + col0) * 2u;
        if constexpr (BR == 0) {
            u32x4 a[2][4][2];
#pragma unroll
            for (int ai = 0; ai < 2; ++ai)
#pragma unroll
                for (int m = 0; m < 4; ++m)
#pragma unroll
                    for (int bj = 0; bj < 2; ++bj) a[ai][m][bj] = ldo<u32x4>(Gt, (ai * HALF + m * 16) * LDG + bj * HALF, og);
#pragma unroll
            for (int ai = 0; ai < 2; ++ai)
#pragma unroll
                for (int m = 0; m < 4; ++m)
#pragma unroll
                    for (int bj = 0; bj < 2; ++bj) { const u32x4 aa = a[ai][m][bj];
                        acc[ai][bj][m][0] *= (f32x4){bf_lo(aa.x), bf_hi(aa.x), bf_lo(aa.y), bf_hi(aa.y)}; acc[ai][bj][m][1] *= (f32x4){bf_lo(aa.z), bf_hi(aa.z), bf_lo(aa.w), bf_hi(aa.w)};
                        asm volatile("" : "+v"(acc[ai][bj][m][0]), "+v"(acc[ai][bj][m][1])); }
        } else if constexpr (BR == 1) {
#pragma unroll
            for (int ai = 0; ai < 2; ++ai) {
                __builtin_amdgcn_sched_barrier(0);
                u32x4 a[4][2], d[4][2];
#pragma unroll
                for (int m = 0; m < 4; ++m)
#pragma unroll
                    for (int bj = 0; bj < 2; ++bj) { a[m][bj] = ldo<u32x4>(Gt, 1024 + (ai * HALF + m * 16) * LDG + bj * HALF, og); d[m][bj] = ldo<u32x4>(Gt, 2048 + (ai * HALF + m * 16) * LDG + bj * HALF, og); }
#pragma unroll
                for (int m = 0; m < 4; ++m)
#pragma unroll
                    for (int bj = 0; bj < 2; ++bj) { const u32x4 aa = a[m][bj], dd = d[m][bj];
                        const f32x4 r0 = {bf_lo(aa.x) * __builtin_amdgcn_rcpf(bf_lo(dd.x)), bf_hi(aa.x) * __builtin_amdgcn_rcpf(bf_hi(dd.x)), bf_lo(aa.y) * __builtin_amdgcn_rcpf(bf_lo(dd.y)), bf_hi(aa.y) * __builtin_amdgcn_rcpf(bf_hi(dd.y))};
                        const f32x4 r1 = {bf_lo(aa.z) * __builtin_amdgcn_rcpf(bf_lo(dd.z)), bf_hi(aa.z) * __builtin_amdgcn_rcpf(bf_hi(dd.z)), bf_lo(aa.w) * __builtin_amdgcn_rcpf(bf_lo(dd.w)), bf_hi(aa.w) * __builtin_amdgcn_rcpf(bf_hi(dd.w))};
                        acc[ai][bj][m][0] *= r0; acc[ai][bj][m][1] *= r1; asm volatile("" : "+v"(acc[ai][bj][m][0]), "+v"(acc[ai][bj][m][1])); }
            }
        } else {
            u32x4 g[2][4][2];
#pragma unroll
            for (int ai = 0; ai < 2; ++ai)
#pragma unroll
                for (int m = 0; m < 4; ++m)
#pragma unroll
                    for (int bj = 0; bj < 2; ++bj) g[ai][m][bj] = ldo<u32x4>(Gt, 2048 + (ai * HALF + m * 16) * LDG + bj * HALF, og);
#pragma unroll
            for (int ai = 0; ai < 2; ++ai)
#pragma unroll
                for (int m = 0; m < 4; ++m)
#pragma unroll
                    for (int bj = 0; bj < 2; ++bj) { const f32x4 a0 = acc[ai][bj][m][0], a1 = acc[ai][bj][m][1]; const u32x4 gg = g[ai][m][bj];
                        u32x4 w;
                        w.x = cvt_pk_bf16(bf_lo(gg.x) * a0[0], bf_hi(gg.x) * a0[1]); w.y = cvt_pk_bf16(bf_lo(gg.y) * a0[2], bf_hi(gg.y) * a0[3]);
                        w.z = cvt_pk_bf16(bf_lo(gg.z) * a1[0], bf_hi(gg.z) * a1[1]); w.w = cvt_pk_bf16(bf_lo(gg.w) * a1[2], bf_hi(gg.w) * a1[3]);
                        *(PG8_GAS u32x4*)((PG8_GAS unsigned char*)(Mg + (ai * HALF + m * 16) * LDM + bj * HALF) + (size_t)om) = w; }
        }
    }
};
template <class T> __device__ __forceinline__ T ldo_(const void* base, unsigned off) { return *(const PG8_GAS T*)((const PG8_GAS unsigned char*)base + (size_t)off); }
template <class T> __device__ __forceinline__ void sto_(void* base, unsigned off, T v) { *(PG8_GAS T*)((PG8_GAS unsigned char*)base + (size_t)off) = v; }
struct EpiResidA {
    static constexpr bool PERM = true, AFTER_DRAIN = false, CHAIN = false;
    static constexpr int LD = 1024;
    const float* base; bf16_t* xb; float* rpart;
    __device__ __forceinline__ void operator()(const f32x4 (&acc)[2][2][4][2], const Unit& u, int wr, int wc, int fr, int fq) const {
        const int row0 = u.pm * BM + wr * 64 + fr, col0 = u.pn * BM + wc * 32 + 8 * fq;
        const unsigned o4 = ((unsigned)row0 * LD + col0) * 4u, o2 = ((unsigned)row0 * LD + col0) * 2u;
#pragma unroll
        for (int ai = 0; ai < 2; ++ai) {
            __builtin_amdgcn_sched_barrier(0);
            f32x4 bs[4][2][2];
#pragma unroll
            for (int m = 0; m < 4; ++m)
#pragma unroll
                for (int bj = 0; bj < 2; ++bj)
#pragma unroll
                    for (int n = 0; n < 2; ++n) bs[m][bj][n] = ldo_<f32x4>(base + (ai * HALF + m * 16) * LD + bj * HALF + 4 * n, o4);
#pragma unroll
            for (int m = 0; m < 4; ++m) { float ss = 0.f;
#pragma unroll
                for (int bj = 0; bj < 2; ++bj) { const f32x4 p0 = bs[m][bj][0] + acc[ai][bj][m][0], p1 = bs[m][bj][1] + acc[ai][bj][m][1];
                    ss += ((p0[0] * p0[0] + p0[1] * p0[1]) + (p0[2] * p0[2] + p0[3] * p0[3])) + ((p1[0] * p1[0] + p1[1] * p1[1]) + (p1[2] * p1[2] + p1[3] * p1[3]));
                    u32x4 w; w.x = cvt_pk_bf16(p0[0], p0[1]); w.y = cvt_pk_bf16(p0[2], p0[3]); w.z = cvt_pk_bf16(p1[0], p1[1]); w.w = cvt_pk_bf16(p1[2], p1[3]);
                    sto_<u32x4>(xb + (ai * HALF + m * 16) * LD + bj * HALF, o2, w); }
                ss = xrow_sum_e(ss); if (fq == 0) gst_<float>(rpart + (size_t)(row0 + ai * HALF + m * 16) * 16 + u.pn * 4 + wc, ss); }
        }
    }
};
struct EpiResidB {
    static constexpr bool PERM = true, AFTER_DRAIN = false, CHAIN = false;
    static constexpr int LD = 1024;
    const bf16_t* xb; float* out;
    __device__ __forceinline__ void operator()(const f32x4 (&acc)[2][2][4][2], const Unit& u, int wr, int wc, int fr, int fq) const {
        const int row0 = u.pm * BM + wr * 64 + fr, col0 = u.pn * BM + wc * 32 + 8 * fq;
        const unsigned o4 = ((unsigned)row0 * LD + col0) * 4u, o2 = ((unsigned)row0 * LD + col0) * 2u;
        u32x4 b[2][4][2];
#pragma unroll
        for (int ai = 0; ai < 2; ++ai)
#pragma unroll
            for (int m = 0; m < 4; ++m)
#pragma unroll
                for (int bj = 0; bj < 2; ++bj) b[ai][m][bj] = ldo_<u32x4>(xb + (ai * HALF + m * 16) * LD + bj * HALF, o2);
#pragma unroll
        for (int ai = 0; ai < 2; ++ai)
#pragma unroll
            for (int m = 0; m < 4; ++m)
#pragma unroll
                for (int bj = 0; bj < 2; ++bj) { const u32x4 bb = b[ai][m][bj];
                    sto_<f32x4>(out + (ai * HALF + m * 16) * LD + bj * HALF, o4, (f32x4){bf_lo(bb.x), bf_hi(bb.x), bf_lo(bb.y), bf_hi(bb.y)} + acc[ai][bj][m][0]);
                    sto_<f32x4>(out + (ai * HALF + m * 16) * LD + bj * HALF + 4, o4, (f32x4){bf_lo(bb.z), bf_hi(bb.z), bf_lo(bb.w), bf_hi(bb.w)} + acc[ai][bj][m][1]); }
    }
};


template <int V> struct IC { static constexpr int value = V; };
template <class Epi, class Sched, bool ALIGN_EPI = false, bool SP2 = false>
__device__ __forceinline__ void gemm_phase(PG8_LAS unsigned char* lds, const Gemm g, const Sched& S, const Epi& E, const int tid) {
    const int wid = __builtin_amdgcn_readfirstlane(tid >> 6), lane = tid & 63, wr = wid >> 2, wc = wid & 3, fr = lane & 15, fq = lane >> 4;
    const int K = g.K, nt = K / BK;
    unsigned voffA[2], voffB[2];
#pragma unroll
    for (int i = 0; i < 2; ++i) { int R, C; stage_rc(tid * 16 + i * 8192, R, C); const int Rb = Epi::PERM ? ((R & ~31) + perm32(R & 31)) : R;
        voffA[i] = (unsigned)(R * K + C) * 2u; voffB[i] = (unsigned)(Rb * K + C) * 2u; }
    const size_t kstep = (size_t)(BK * 2);
    const size_t hstep = (size_t)HALF * K * 2;
    const size_t tstep = 2 * hstep;
    const unsigned ldsw = (unsigned)wid * 1024u;
    const int aoff = lds_byte(wr * 64 + fr, fq * 8), boff = lds_byte(wc * 32 + fr, fq * 8);
#define PG8_SA(b, h) (((b) * 2 + (h)) * HTB)
#define PG8_SB(b, h) ((4 + (b) * 2 + (h)) * HTB)
#define PG8_STAGE(bufoff, gbase, voff) do { _Pragma("unroll") for (int _i = 0; _i < 2; ++_i) \
        __builtin_amdgcn_global_load_lds((const unsigned*)((const char*)(gbase) + (voff)[_i]), (PG8_LAS unsigned*)(lds + (bufoff) + ldsw + _i * 8192), 16, 0, 0); } while (0)
#define PG8_LDA(dst, b, h) do { _Pragma("unroll") for (int m = 0; m < 4; ++m) _Pragma("unroll") for (int k = 0; k < 2; ++k) dst[m][k] = *(const PG8_LAS bf16x8*)(lds + PG8_SA(b, h) + aoff + m * 2048 + k * 1024); } while (0)
#define PG8_LDB(dst, b, h) do { _Pragma("unroll") for (int n = 0; n < 2; ++n) _Pragma("unroll") for (int k = 0; k < 2; ++k) dst[n][k] = *(const PG8_LAS bf16x8*)(lds + PG8_SB(b, h) + boff + n * 2048 + k * 1024); } while (0)
#define PG8_MMA(ai, bj, At, Bt) do { __builtin_amdgcn_s_setprio(1); _Pragma("unroll") for (int m = 0; m < 4; ++m) _Pragma("unroll") for (int n = 0; n < 2; ++n) _Pragma("unroll") for (int k = 0; k < 2; ++k) \
        acc[ai][bj][m][n] = __builtin_amdgcn_mfma_f32_16x16x32_bf16(Bt[n][k], At[m][k], acc[ai][bj][m][n], 0, 0, 0); __builtin_amdgcn_s_setprio(0); } while (0)
#define PG8_WAIT_V(n) asm volatile("s_waitcnt vmcnt(" #n ")" ::: "memory")
#define PG8_WAIT_L(n) asm volatile("s_waitcnt lgkmcnt(" #n ")" ::: "memory")
#define PG8_BAR __builtin_amdgcn_s_barrier()
#define PG8_SCHED __builtin_amdgcn_sched_barrier(0)
    Unit cur, nxt; int ui = 0;
    if (!S.next(0, cur)) return;
    f32x4 acc[2][2][4][2];
#pragma unroll
    for (int a = 0; a < 2; ++a)
#pragma unroll
        for (int b = 0; b < 2; ++b)
#pragma unroll
            for (int m = 0; m < 4; ++m)
#pragma unroll
                for (int n = 0; n < 2; ++n) acc[a][b][m][n] = (f32x4){0.f, 0.f, 0.f, 0.f};
    bf16x8 At[4][2], B0[2][2], B1[2][2];
    const char* cA = (const char*)g.A + (size_t)cur.pm * tstep; const char* cB = (const char*)g.Bt + (size_t)cur.pn * tstep;
    S.a_ready(cur);
    if constexpr (SP2) {
        PG8_STAGE(PG8_SB(0, 0), cB, voffB); PG8_STAGE(PG8_SB(0, 1), cB + hstep, voffB); PG8_STAGE(PG8_SA(0, 0), cA, voffA); PG8_STAGE(PG8_SA(0, 1), cA + hstep, voffA);
        if (wr == 1) PG8_BAR;
        PG8_WAIT_V(2); PG8_BAR;
        PG8_STAGE(PG8_SB(1, 0), cB + kstep, voffB); PG8_STAGE(PG8_SA(1, 0), cA + kstep, voffA); PG8_STAGE(PG8_SB(1, 1), cB + hstep + kstep, voffB);
        PG8_WAIT_V(6); PG8_BAR;
    } else {
        PG8_STAGE(PG8_SB(0, 0), cB, voffB); PG8_STAGE(PG8_SA(0, 0), cA, voffA); PG8_STAGE(PG8_SB(0, 1), cB + hstep, voffB); PG8_STAGE(PG8_SA(0, 1), cA + hstep, voffA);
        if (wr == 1) PG8_BAR;
        PG8_WAIT_V(4); PG8_BAR;
        PG8_STAGE(PG8_SB(1, 0), cB + kstep, voffB); PG8_STAGE(PG8_SA(1, 0), cA + kstep, voffA); PG8_STAGE(PG8_SB(1, 1), cB + hstep + kstep, voffB);
        PG8_WAIT_V(6); PG8_BAR;
    }
    auto unit = [&](auto BRC) __attribute__((always_inline)) -> bool {
        constexpr int BR = decltype(BRC)::value;
        const bool has_next = S.next(ui + 1, nxt);
        const char* nA = has_next ? (const char*)g.A + (size_t)nxt.pm * tstep : cA; const char* nB = has_next ? (const char*)g.Bt + (size_t)nxt.pn * tstep : cB;
        for (int t = 0; t < nt; t += 2) {
            const bool last = (t == nt - 2);
            const char* a1 = cA + (size_t)(t + 1) * kstep;
            const char* a2 = last ? nA : cA + (size_t)(t + 2) * kstep; const char* b2 = last ? nB : cB + (size_t)(t + 2) * kstep;
            const char* a3 = a2 + kstep; const char* b3 = b2 + kstep;
            if (last && has_next) S.a_ready(nxt);
            if constexpr (SP2) {
            PG8_LDB(B0, 0, 0); PG8_LDB(B1, 0, 1); PG8_SCHED; PG8_LDA(At, 0, 0); PG8_STAGE(PG8_SA(1, 1), a1 + hstep, voffA);
            PG8_WAIT_V(8); PG8_WAIT_L(0); PG8_BAR; PG8_MMA(0, 0, At, B0); PG8_MMA(0, 1, At, B1); PG8_BAR; PG8_SCHED;
            PG8_LDA(At, 0, 1); PG8_STAGE(PG8_SB(0, 0), b2, voffB); PG8_STAGE(PG8_SB(0, 1), b2 + hstep, voffB); PG8_STAGE(PG8_SA(0, 0), a2, voffA);
            PG8_WAIT_V(8); PG8_WAIT_L(0); PG8_BAR; PG8_MMA(1, 0, At, B0); PG8_MMA(1, 1, At, B1); PG8_BAR; PG8_SCHED;
            PG8_LDB(B0, 1, 0); PG8_LDB(B1, 1, 1); PG8_SCHED; PG8_LDA(At, 1, 0); PG8_STAGE(PG8_SA(0, 1), a2 + hstep, voffA);
            PG8_WAIT_V(8); PG8_WAIT_L(0); PG8_BAR; PG8_MMA(0, 0, At, B0); PG8_MMA(0, 1, At, B1); PG8_BAR; PG8_SCHED;
            PG8_LDA(At, 1, 1); PG8_STAGE(PG8_SB(1, 0), b3, voffB); PG8_STAGE(PG8_SB(1, 1), b3 + hstep, voffB); PG8_STAGE(PG8_SA(1, 0), a3, voffA);
            PG8_WAIT_V(8); PG8_WAIT_L(0); PG8_BAR; PG8_MMA(1, 0, At, B0); PG8_MMA(1, 1, At, B1); PG8_BAR; PG8_SCHED;
            } else {
            PG8_LDB(B0, 0, 0); PG8_SCHED; PG8_LDA(At, 0, 0); PG8_STAGE(PG8_SA(1, 1), a1 + hstep, voffA);
            PG8_WAIT_L(8); PG8_BAR; PG8_WAIT_L(0); PG8_MMA(0, 0, At, B0); PG8_BAR; PG8_SCHED;
            PG8_LDB(B1, 0, 1); PG8_STAGE(PG8_SB(0, 0), b2, voffB);
            PG8_BAR; PG8_WAIT_L(0); PG8_MMA(0, 1, At, B1); PG8_BAR;
            PG8_LDA(At, 0, 1); PG8_STAGE(PG8_SA(0, 0), a2, voffA);
            PG8_BAR; PG8_WAIT_L(0); PG8_MMA(1, 0, At, B0); PG8_BAR; PG8_SCHED;
            PG8_STAGE(PG8_SB(0, 1), b2 + hstep, voffB);
            PG8_WAIT_V(6); PG8_BAR; PG8_MMA(1, 1, At, B1); PG8_BAR;
            PG8_LDB(B0, 1, 0); PG8_SCHED; PG8_LDA(At, 1, 0); PG8_STAGE(PG8_SA(0, 1), a2 + hstep, voffA);
            PG8_WAIT_L(8); PG8_BAR; PG8_WAIT_L(0); PG8_MMA(0, 0, At, B0); PG8_BAR; PG8_SCHED;
            PG8_LDB(B1, 1, 1); PG8_STAGE(PG8_SB(1, 0), b3, voffB);
            PG8_BAR; PG8_WAIT_L(0); PG8_MMA(0, 1, At, B1); PG8_BAR;
            PG8_LDA(At, 1, 1); PG8_STAGE(PG8_SA(1, 0), a3, voffA);
            PG8_BAR; PG8_WAIT_L(0); PG8_MMA(1, 0, At, B0); PG8_BAR; PG8_SCHED;
            PG8_STAGE(PG8_SB(1, 1), b3 + hstep, voffB);
            PG8_WAIT_V(6); PG8_BAR; PG8_MMA(1, 1, At, B1); PG8_BAR;
            }
        }
        if constexpr (ALIGN_EPI) { if (wr == 0) PG8_BAR; }
        if constexpr (Epi::CHAIN) { E.template run<BR>(acc, cur, wr, wc, fr, fq); S.done(cur); }
        else if constexpr (!Epi::AFTER_DRAIN) { E(acc, cur, wr, wc, fr, fq); S.done(cur); }
        if (!has_next) return false;
        if constexpr (!Epi::CHAIN || BR == 2) {
#pragma unroll
        for (int a = 0; a < 2; ++a)
#pragma unroll
            for (int b = 0; b < 2; ++b)
#pragma unroll
                for (int m = 0; m < 4; ++m)
#pragma unroll
                    for (int n = 0; n < 2; ++n) acc[a][b][m][n] = (f32x4){0.f, 0.f, 0.f, 0.f};
        }
        cur = nxt; cA = nA; cB = nB; ++ui;
        if constexpr (ALIGN_EPI) { if (wr == 1) PG8_BAR; }
        return true;
    };
    if constexpr (Epi::CHAIN) { for (;;) { if (!unit(IC<0>{})) break; if (!unit(IC<1>{})) break; if (!unit(IC<2>{})) break; } }
    else { for (;;) if (!unit(IC<0>{})) break; }
    PG8_WAIT_V(0);
    if constexpr (!ALIGN_EPI) { if (wr == 0) PG8_BAR; }
    PG8_BAR;
    if constexpr (Epi::AFTER_DRAIN) { E.fused(acc, cur, wr, wc, fr, fq, lds, wid, lane); S.done(cur); }
#undef PG8_SA
#undef PG8_SB
#undef PG8_STAGE
#undef PG8_LDA
#undef PG8_LDB
#undef PG8_MMA
#undef PG8_WAIT_V
#undef PG8_WAIT_L
#undef PG8_BAR
#undef PG8_SCHED
}
}
#define GAS __attribute__((address_space(1)))
#define LAS __attribute__((address_space(3)))
typedef unsigned short bf16;
typedef unsigned v4u __attribute__((ext_vector_type(4)));
typedef float f32x4 __attribute__((ext_vector_type(4)));
typedef short bf16x8 __attribute__((ext_vector_type(8)));
typedef GAS unsigned gu32;
typedef GAS unsigned long long gu64;
#define RLX_AGENT __ATOMIC_RELAXED, __HIP_MEMORY_SCOPE_AGENT
#define LDS_WAIT() asm volatile("s_waitcnt lgkmcnt(0)" ::: "memory")
#define VM_WAIT() asm volatile("s_waitcnt vmcnt(0)" ::: "memory")
__device__ __forceinline__ unsigned long long rt() { return __builtin_amdgcn_s_memrealtime(); }
__device__ __forceinline__ unsigned f2bf(float f) { unsigned u = __builtin_bit_cast(unsigned, f); return (u + 0x7fffu + ((u >> 16) & 1u)) >> 16; }
__device__ __forceinline__ unsigned pk2(float lo, float hi) { return f2bf(lo) | (f2bf(hi) << 16); }

#define XB_TMO      128
#define XB_XCNT(j)  (256  + 64 * (j))
#define XB_XSUB(j)  (1280 + 64 * (j))
#define XB_XGEN(j)  (2304 + 64 * (j))
#define XB_TOP      3328
#define XB_TOPGEN   3392
#define XCD_BAR_WORDS 3456
#define XB_SPIN_CAP (1u << 18)

__device__ __forceinline__ unsigned xb_ld(unsigned* p)              { return __hip_atomic_load(p, __ATOMIC_RELAXED, __HIP_MEMORY_SCOPE_AGENT); }
__device__ __forceinline__ unsigned xb_add(unsigned* p, unsigned v) { return __hip_atomic_fetch_add(p, v, __ATOMIC_RELAXED, __HIP_MEMORY_SCOPE_AGENT); }
__device__ __forceinline__ unsigned xb_xcc_id() { return (unsigned)__builtin_amdgcn_s_getreg((3 << 11) | 20) & 0xFu; }
#define XB_SPIN(cond, bar) do { unsigned _sp = 0; while (cond) { __builtin_amdgcn_s_sleep(1); \
    if ((++_sp & 255u) == 0u) { if (xb_ld(&(bar)[XB_TMO])) break; if (_sp > XB_SPIN_CAP) { atomicAdd(&(bar)[XB_TMO], 1u); break; } } } } while (0)

struct XcdBarrier {
    unsigned* bar; unsigned x;
    volatile LAS unsigned* st;
};

__device__ __forceinline__ XcdBarrier xcd_barrier_post(unsigned* bar, volatile LAS unsigned* st) {
    XcdBarrier b; b.bar = bar; b.x = xb_xcc_id(); b.st = st;
    if (threadIdx.x == 0) (void)xb_add(&bar[XB_XCNT(b.x)], 1u);
    return b;
}
__device__ __forceinline__ void xcd_barrier_complete(unsigned* bar, unsigned x, unsigned& nloc, unsigned& nx) {
    const unsigned G = gridDim.x * gridDim.y * gridDim.z;
    unsigned sum, cnt, mine, sp = 0u;
    for (;;) {
        sum = 0u; cnt = 0u; mine = 0u;
#pragma unroll
        for (unsigned j = 0; j < 16; ++j) { const unsigned c = xb_ld(&bar[XB_XCNT(j)]); sum += c; cnt += (c > 0u) ? 1u : 0u; mine = (j == x) ? c : mine; }
        if (sum == G) break;
        __builtin_amdgcn_s_sleep(1);
        if ((++sp & 255u) == 0u) { if (xb_ld(&bar[XB_TMO])) break; if (sp > XB_SPIN_CAP) { atomicAdd(&bar[XB_TMO], 1u); break; } }
    }
    nloc = mine > 0u ? mine : 1u; nx = cnt > 0u ? cnt : 1u;
}

__device__ __forceinline__ void xcd_barrier(const XcdBarrier& b) {
    asm volatile("s_waitcnt vmcnt(0)" ::: "memory");
    __syncthreads();
    if (threadIdx.x == 0) {
        unsigned* bar = b.bar;
        __builtin_amdgcn_s_waitcnt(0);
        unsigned nloc = b.st[0], nx = b.st[1];
        if (nloc == 0u) { xcd_barrier_complete(bar, b.x, nloc, nx); b.st[0] = nloc; b.st[1] = nx; }
        const unsigned old = xb_add(&bar[XB_XSUB(b.x)], 1u);
        const unsigned gen = old / nloc;
        if (old + 1u == (gen + 1u) * nloc) {
            __builtin_amdgcn_fence(__ATOMIC_RELEASE, "agent");
            asm volatile("s_waitcnt vmcnt(0)" ::: "memory");
            const unsigned og = xb_add(&bar[XB_TOP], 1u);
            const unsigned tg = og / nx;
            if (og + 1u == (tg + 1u) * nx) xb_add(&bar[XB_TOPGEN], 1u);
            else XB_SPIN(xb_ld(&bar[XB_TOPGEN]) == tg, bar);
            __builtin_amdgcn_fence(__ATOMIC_ACQUIRE, "agent");
            xb_add(&bar[XB_XGEN(b.x)], 1u);
            asm volatile("s_waitcnt vmcnt(0)" ::: "memory");
        } else {
            XB_SPIN(xb_ld(&bar[XB_XGEN(b.x)]) == gen, bar);
            __builtin_amdgcn_fence(__ATOMIC_ACQUIRE, "agent");
            asm volatile("s_waitcnt vmcnt(0)" ::: "memory");
        }
    }
    __syncthreads();
}


constexpr int BATCH = 32, SEQ = 2048, D = 1024, M = BATCH * SEQ, DEPTH = 2;
constexpr int NIN = 7448, NMAIN = 4608, NMG = 3072, NINP = NMAIN + NMG;
constexpr float EPS = 1e-6f;
constexpr int PA_LD = 1280, PG_LD = 1536, PS_LD = 1536, PX_LD = 32;
constexpr int PC_AQ = 0, PC_AK = 512, PC_AV = 640, PC_AG = 768, PC_GQ = 0, PC_GK = 256, PC_GV = 512, PC_GG = 1024, PC_XBC = 0, PC_SZ = 1024, PC_GD = 0, PC_DT = 16;
__host__ __device__ __forceinline__ int src_col(int d) {
    if (d < 2816) return d;
    if (d < 3840) return d + 16;
    if (d < 4352) return d + 24;
    if (d < 4368) return 2816 + (d - 4352);
    if (d < 4376) return 3856 + (d - 4368);
    if (d < NMAIN) return -1;
    const int e = d - NMAIN, t = e >> 8, w = e & 255;
    return 4376 + (t < 8 ? (w >> 7) * 1024 + 128 * t + (w & 127) : e);
}
constexpr size_t MiB = 1u << 20;
constexpr size_t WS_CTL = 0, CTL_ZERO_BYTES = 1 * MiB;
constexpr size_t WS_WIN = 1 * MiB;
constexpr size_t WS_WB = 31 * MiB;
constexpr size_t WS_WO = 37 * MiB;
constexpr size_t WS_PAR = 41 * MiB;
constexpr int PG_NORM = 0, PG_QN = 1024, PG_KN = 1088, PG_SINK = 1152, PG_GWG = 1160, PG_GBG = 5256, PG_GON = 5512, PG_CW = 5640, PG_CB = 9736, PG_DTB = 10760, PG_ALOG = 10768, PG_DSK = 10776, PG_SON = 10784, PSTRIDE = 11296;
constexpr size_t WS_RPART = 42 * MiB;
constexpr size_t WS_RINV = 46 * MiB;
constexpr size_t WS_XN = 48 * MiB;
constexpr size_t WS_Y = 176 * MiB;
constexpr size_t WS_PA = 368 * MiB, WS_PG = 528 * MiB, WS_SPARE = 720 * MiB, WS_PS = 752 * MiB, WS_PX = 960 * MiB;
constexpr size_t WS_MG = 368 * MiB;
constexpr size_t WS_MERGED = 752 * MiB;
constexpr size_t WS_CS = 944 * MiB;
constexpr size_t WS_END = 1024 * MiB;
static_assert(WS_PA + (size_t)M * PA_LD * 2 == WS_PG && WS_PG + (size_t)M * PG_LD * 2 == WS_SPARE && WS_MG + (size_t)M * NMG * 2 == WS_PS && WS_PS + (size_t)M * PS_LD * 2 == WS_CS && WS_MERGED + (size_t)M * D * 2 <= WS_CS && WS_PX + (size_t)M * PX_LD * 2 <= WS_END, "ws map");
constexpr int CW_TMO = 0, CW_CODE = 1;
constexpr int CW_Q = 64;
constexpr int CW_DONE = 256;
constexpr int N_AG_UNITS = 128 + 1024;
constexpr int CW_BAR = 4096;
constexpr int NPHASE = 14, MAX_LAUNCH = 16;
constexpr int RING_OFF = 0, RING_BYTES = 131072;
constexpr int LDS_BYTES = 163840;
constexpr int LDSCTL_OFF = LDS_BYTES - 1024, MISC_OFF = LDSCTL_OFF + 320;
constexpr int NWAVES = 8, NTHR = 512;

struct Args { const void* in[18]; float* out; unsigned char* ws; int ph_lo, ph_hi, li, pad; };

template <int CTRL, int ROWMASK = 0xF> __device__ __forceinline__ float dpp_f(float x) { return __builtin_bit_cast(float, __builtin_amdgcn_update_dpp(0, __builtin_bit_cast(int, x), CTRL, ROWMASK, 0xF, ROWMASK == 0xF)); }
__device__ __forceinline__ float quad_sum(float x) { x += dpp_f<0xB1>(x); x += dpp_f<0x4E>(x); return x; }
__device__ __forceinline__ float row16_sum(float x) { x = quad_sum(x); x += dpp_f<0x141>(x); x += dpp_f<0x140>(x); return x; }
typedef unsigned u32x2p __attribute__((ext_vector_type(2)));
__device__ __forceinline__ void swap16(unsigned& a, unsigned& b) { asm volatile("s_nop 1\n\tv_permlane16_swap_b32 %0, %1" : "+v"(a), "+v"(b)); }
__device__ __forceinline__ void swap32(unsigned& a, unsigned& b) { asm volatile("s_nop 1\n\tv_permlane32_swap_b32 %0, %1" : "+v"(a), "+v"(b)); }
__device__ __forceinline__ float xrow_sum(float x) { unsigned a = __builtin_bit_cast(unsigned, x), b = a; swap16(a, b); const float y = __builtin_bit_cast(float, a) + __builtin_bit_cast(float, b);
    unsigned c = __builtin_bit_cast(unsigned, y), d = c; swap32(c, d); return __builtin_bit_cast(float, c) + __builtin_bit_cast(float, d); }
__device__ __forceinline__ float xrow_max(float x) { unsigned a = __builtin_bit_cast(unsigned, x), b = a; swap16(a, b); const float y = fmaxf(__builtin_bit_cast(float, a), __builtin_bit_cast(float, b));
    unsigned c = __builtin_bit_cast(unsigned, y), d = c; swap32(c, d); return fmaxf(__builtin_bit_cast(float, c), __builtin_bit_cast(float, d)); }
__device__ __forceinline__ float wave_sum(float v) {
    v = row16_sum(v);
    return ((__builtin_bit_cast(float, __builtin_amdgcn_readlane(__builtin_bit_cast(int, v), 0)) + __builtin_bit_cast(float, __builtin_amdgcn_readlane(__builtin_bit_cast(int, v), 16)))
         + (__builtin_bit_cast(float, __builtin_amdgcn_readlane(__builtin_bit_cast(int, v), 32)) + __builtin_bit_cast(float, __builtin_amdgcn_readlane(__builtin_bit_cast(int, v), 48))));
}
__device__ __forceinline__ float bf2f(bf16 b) { return __builtin_bit_cast(float, ((unsigned)b) << 16); }
__device__ __forceinline__ float siluf(float x) { return x * __builtin_amdgcn_rcpf(1.f + __builtin_amdgcn_exp2f(-1.44269504f * x)); }
__device__ __forceinline__ float softplusf(float x) { return x > 20.f ? x : __logf(1.f + __expf(x)); }
__device__ __forceinline__ float logsigmoidf(float x) { return fminf(x, 0.f) - __logf(1.f + __expf(-fabsf(x))); }
__device__ __forceinline__ float rsqf(float x) { return __builtin_amdgcn_rsqf(x); }

template <bool MAPPED>
__device__ __forceinline__ void transpose_item(const float* W, int K, int N, bf16* WT, LAS float* scr, int item, int nblk, int lane, const float* gk = nullptr) {
    const int kb = item / nblk, nb = item % nblk, k0 = 64 * kb, n0 = 32 * nb;
    const int nd = n0 + (lane & 31); const int sc = MAPPED ? src_col(nd) : nd;
    const float wmul = (MAPPED && nd >= NMAIN) ? -1.44269504f : 1.f;
#pragma unroll 8
    for (int i = 0; i < 32; ++i) { const int kk = 2 * i + (lane >> 5); scr[kk * 33 + (lane & 31)] = sc >= 0 ? W[(size_t)(k0 + kk) * N + sc] * (gk ? wmul * gk[k0 + kk] : wmul) : 0.f; }
    LDS_WAIT(); asm volatile("" ::: "memory");
    const int c = lane & 7;
#pragma unroll
    for (int j = 0; j < 4; ++j) { const int n = (lane >> 3) + 8 * j; const LAS float* s = scr + (8 * c) * 33 + n;
        v4u o; o.x = pk2(s[0 * 33], s[1 * 33]); o.y = pk2(s[2 * 33], s[3 * 33]); o.z = pk2(s[4 * 33], s[5 * 33]); o.w = pk2(s[6 * 33], s[7 * 33]);
        *(GAS v4u*)(WT + (size_t)(n0 + n) * K + k0 + 8 * c) = o; }
    LDS_WAIT(); asm volatile("" ::: "memory");
}
__device__ __forceinline__ void rms_rows2_to_bf16(const float* xrow0, const float* xrow1, const float* g, bf16* orow0, bf16* orow1, int lane) {
    const GAS f32x4* xr0 = (const GAS f32x4*)xrow0 + lane; const GAS f32x4* xr1 = (const GAS f32x4*)xrow1 + lane; const GAS f32x4* gr = (const GAS f32x4*)g + lane;
    f32x4 v[4], w[4]; float s = 0.f, t = 0.f;
#pragma unroll
    for (int j = 0; j < 4; ++j) { v[j] = xr0[64 * j]; w[j] = xr1[64 * j]; }
#pragma unroll
    for (int j = 0; j < 4; ++j) { s += (v[j].x * v[j].x + v[j].y * v[j].y) + (v[j].z * v[j].z + v[j].w * v[j].w); t += (w[j].x * w[j].x + w[j].y * w[j].y) + (w[j].z * w[j].z + w[j].w * w[j].w); }
    const float r = 1.f / sqrtf(wave_sum(s) * (1.f / D) + EPS), q = 1.f / sqrtf(wave_sum(t) * (1.f / D) + EPS);
    GAS unsigned long long* o0 = (GAS unsigned long long*)orow0 + lane; GAS unsigned long long* o1 = (GAS unsigned long long*)orow1 + lane;
#pragma unroll
    for (int j = 0; j < 4; ++j) { const f32x4 gg = gr[64 * j];
        o0[64 * j] = (unsigned long long)pk2(v[j].x * r * gg.x, v[j].y * r * gg.y) | ((unsigned long long)pk2(v[j].z * r * gg.z, v[j].w * r * gg.w) << 32);
        o1[64 * j] = (unsigned long long)pk2(w[j].x * q * gg.x, w[j].y * q * gg.y) | ((unsigned long long)pk2(w[j].z * q * gg.z, w[j].w * q * gg.w) << 32); }
}

typedef unsigned long long u64;
typedef unsigned u32x2 __attribute__((ext_vector_type(2)));
#define LBAR() do { asm volatile("s_waitcnt lgkmcnt(0)" ::: "memory"); __builtin_amdgcn_s_barrier(); asm volatile("" ::: "memory"); } while (0)
#define GLD(T, base, off) (*(const GAS T*)((const GAS unsigned char*)(base) + (size_t)(unsigned)(off)))
#define GST(T, base, off) (*(GAS T*)((GAS unsigned char*)(base) + (size_t)(unsigned)(off)))
#define MFMA16(a, b, c) __builtin_amdgcn_mfma_f32_16x16x32_bf16((a), (b), (c), 0, 0, 0)
__device__ __forceinline__ unsigned pk2c(float lo, float hi) { return pg8::cvt_pk_bf16(lo, hi); }
__device__ __forceinline__ bf16x8 mk8(unsigned a, unsigned b, unsigned c, unsigned d) { const v4u t = {a, b, c, d}; return __builtin_bit_cast(bf16x8, t); }
__device__ __forceinline__ bf16x8 mk8(u32x2 lo, u32x2 hi) { const v4u t = {lo.x, lo.y, hi.x, hi.y}; return __builtin_bit_cast(bf16x8, t); }
__device__ __forceinline__ float ex2(float x) { return __builtin_amdgcn_exp2f(x); }

constexpr int AT_KS = 0, AT_KSTR = 144, AT_VT = 36864, AT_VSTR = 528;
__device__ __forceinline__ void attn_unit(int unit, const bf16* PROJ, const float2* CS, const float* par_g, bf16* YA, LAS unsigned char* lds, int tid) {
    const GAS float* par = (const GAS float*)par_g;
    const int lane = tid & 63, wave = __builtin_amdgcn_readfirstlane(tid >> 6);
    const int jb = unit & 15, kvh = (unit >> 4) & 1, b = unit >> 5;
    const long mq0 = (long)b * SEQ + jb * 128, mk0 = mq0 - 128;
    LAS unsigned char* Ks = lds + AT_KS; LAS unsigned char* Vt = lds + AT_VT;
    const GAS float* kn = par + PG_KN; const GAS float* qn = par + PG_QN;
    const int g = wave >> 1, hq = 4 * kvh + g, i16 = lane & 15, quad = lane >> 4;
    v4u qr0, qr1; f32x4 qcs[4];
#define AT_QLOAD(itn) do { const int qrel_ = 16 * ((wave & 1) * 4 + (itn)) + i16; const unsigned qo_ = (unsigned)(qrel_ * PA_LD + PC_AQ + 64 * hq + 8 * quad) * 2u, cso_ = (unsigned)(qrel_ * 32 + 8 * quad) * 8u; \
        qr0 = GLD(v4u, PROJ + mq0 * PA_LD, qo_); qr1 = GLD(v4u, PROJ + mq0 * PA_LD, qo_ + 64u); \
        _Pragma("unroll") for (int j2 = 0; j2 < 4; ++j2) qcs[j2] = GLD(f32x4, CS + mq0 * 32, cso_ + 16u * j2); } while (0)
    AT_QLOAD(0);
#pragma unroll
    for (int it = 0; it < 2; ++it) {
        const int task = tid + it * NTHR, kk = task >> 2, c = task & 3;
        v4u w0 = {0u, 0u, 0u, 0u}, w1 = {0u, 0u, 0u, 0u};
        if (jb > 0 || kk >= 128) {
            const unsigned ko = (unsigned)(kk * PA_LD + PC_AK + 64 * kvh + 8 * c) * 2u;
            const v4u r0 = GLD(v4u, PROJ + mk0 * PA_LD, ko), r1 = GLD(v4u, PROJ + mk0 * PA_LD, ko + 64u);
            float x0[8], x1[8]; float ss = 0.f;
#pragma unroll
            for (int j = 0; j < 4; ++j) { x0[2 * j] = pg8::bf_lo(r0[j]); x0[2 * j + 1] = pg8::bf_hi(r0[j]); x1[2 * j] = pg8::bf_lo(r1[j]); x1[2 * j + 1] = pg8::bf_hi(r1[j]); }
#pragma unroll
            for (int j = 0; j < 8; ++j) ss += x0[j] * x0[j] + x1[j] * x1[j];
            ss = quad_sum(ss);
            const float r = rsqf(ss * (1.f / 64.f) + EPS);
            const unsigned cso = (unsigned)(kk * 32 + 8 * c) * 8u;
            float o0[8], o1[8];
#pragma unroll
            for (int j2 = 0; j2 < 4; ++j2) { const f32x4 cs = GLD(f32x4, CS + mk0 * 32, cso + 16u * j2);
#pragma unroll
                for (int e = 0; e < 2; ++e) { const int j = 2 * j2 + e; const float cn = e ? cs.z : cs.x, sn = e ? cs.w : cs.y;
                    const float y0 = x0[j] * r * kn[8 * c + j], y1 = x1[j] * r * kn[32 + 8 * c + j];
                    o0[j] = y0 * cn - y1 * sn; o1[j] = y1 * cn + y0 * sn; } }
            w0 = (v4u){pk2c(o0[0], o0[1]), pk2c(o0[2], o0[3]), pk2c(o0[4], o0[5]), pk2c(o0[6], o0[7])};
            w1 = (v4u){pk2c(o1[0], o1[1]), pk2c(o1[2], o1[3]), pk2c(o1[4], o1[5]), pk2c(o1[6], o1[7])};
        }
        *(LAS v4u*)(Ks + kk * AT_KSTR + c * 16) = w0; *(LAS v4u*)(Ks + kk * AT_KSTR + 64 + c * 16) = w1;
    }
    {
        const int kk = tid & 255, dh = tid >> 8;
        v4u r[4] = {{0u, 0u, 0u, 0u}, {0u, 0u, 0u, 0u}, {0u, 0u, 0u, 0u}, {0u, 0u, 0u, 0u}};
        if (jb > 0 || kk >= 128) { const unsigned vo = (unsigned)(kk * PA_LD + PC_AV + 64 * kvh + 32 * dh) * 2u;
#pragma unroll
            for (int j = 0; j < 4; ++j) r[j] = GLD(v4u, PROJ + mk0 * PA_LD, vo + 16u * j); }
#pragma unroll
        for (int j = 0; j < 4; ++j)
#pragma unroll
            for (int e = 0; e < 4; ++e) { const unsigned w = r[j][e]; const int d = 32 * dh + 8 * j + 2 * e;
                *(LAS unsigned short*)(Vt + d * AT_VSTR + kk * 2) = (unsigned short)(w & 0xffffu);
                *(LAS unsigned short*)(Vt + (d + 1) * AT_VSTR + kk * 2) = (unsigned short)(w >> 16); }
    }
    LBAR();
    const float sinkl = par[PG_SINK + hq] * 1.44269504f;
    for (int it = 0; it < 4; ++it) {
        const int qt = (wave & 1) * 4 + it, qrel = 16 * qt + i16;
        bf16x8 qf0, qf1;
        {
            const v4u r0 = qr0, r1 = qr1;
            float x0[8], x1[8]; float ss = 0.f;
#pragma unroll
            for (int j = 0; j < 4; ++j) { x0[2 * j] = pg8::bf_lo(r0[j]); x0[2 * j + 1] = pg8::bf_hi(r0[j]); x1[2 * j] = pg8::bf_lo(r1[j]); x1[2 * j + 1] = pg8::bf_hi(r1[j]); }
#pragma unroll
            for (int j = 0; j < 8; ++j) ss += x0[j] * x0[j] + x1[j] * x1[j];
            ss = xrow_sum(ss);
            const float r = (0.125f * 1.44269504f) * rsqf(ss * (1.f / 64.f) + EPS);
            float o0[8], o1[8];
#pragma unroll
            for (int j2 = 0; j2 < 4; ++j2) { const f32x4 cs = qcs[j2];
#pragma unroll
                for (int e = 0; e < 2; ++e) { const int j = 2 * j2 + e; const float cn = e ? cs.z : cs.x, sn = e ? cs.w : cs.y;
                    const float y0 = x0[j] * r * qn[8 * quad + j], y1 = x1[j] * r * qn[32 + 8 * quad + j];
                    o0[j] = y0 * cn - y1 * sn; o1[j] = y1 * cn + y0 * sn; } }
            qf0 = mk8(pk2c(o0[0], o0[1]), pk2c(o0[2], o0[3]), pk2c(o0[4], o0[5]), pk2c(o0[6], o0[7]));
            qf1 = mk8(pk2c(o1[0], o1[1]), pk2c(o1[2], o1[3]), pk2c(o1[4], o1[5]), pk2c(o1[6], o1[7]));
        }
        if (it < 3) AT_QLOAD(it + 1);
        u32x2 gwv[4];
#pragma unroll
        for (int dt = 0; dt < 4; ++dt) gwv[dt] = GLD(u32x2, PROJ + mq0 * PA_LD, (unsigned)(qrel * PA_LD + PC_AG + 64 * hq + 16 * dt + 4 * quad) * 2u);
        f32x4 s[9];
#pragma unroll
        for (int t = 0; t < 9; ++t) { const LAS unsigned char* kp = Ks + (16 * (qt + t) + i16) * AT_KSTR + quad * 16;
            const bf16x8 a0 = *(const LAS bf16x8*)kp, a1 = *(const LAS bf16x8*)(kp + 64);
            f32x4 z = {0.f, 0.f, 0.f, 0.f}; z = MFMA16(a0, qf0, z); s[t] = MFMA16(a1, qf1, z); }
        float mx = sinkl;
        if (jb > 0) {
#pragma unroll
            for (int r = 0; r < 4; ++r) { s[0][r] = (4 * quad + r > i16) ? s[0][r] : -1.0e30f; s[8][r] = (4 * quad + r <= i16) ? s[8][r] : -1.0e30f; }
        } else {
#pragma unroll
            for (int t = 0; t < 9; ++t)
#pragma unroll
                for (int r = 0; r < 4; ++r) { const int kk = 16 * (qt + t) + 4 * quad + r;
                    const bool valid = (kk > qrel) && (kk <= qrel + 128) && (kk >= 128);
                    s[t][r] = valid ? s[t][r] : -1.0e30f; }
        }
#pragma unroll
        for (int t = 0; t < 9; ++t) mx = fmaxf(mx, fmaxf(fmaxf(s[t][0], s[t][1]), fmaxf(s[t][2], s[t][3])));
        mx = xrow_max(mx);
        float lsum = 0.f;
#pragma unroll
        for (int t = 0; t < 9; ++t)
#pragma unroll
            for (int r = 0; r < 4; ++r) { const float p = ex2(s[t][r] - mx); s[t][r] = p; lsum += p; }
        lsum = xrow_sum(lsum) + ex2(sinkl - mx);
        f32x4 o[4];
#pragma unroll
        for (int dt = 0; dt < 4; ++dt) o[dt] = (f32x4){0.f, 0.f, 0.f, 0.f};
#pragma unroll
        for (int st = 0; st < 5; ++st) { const int t0 = 2 * st, t1 = 2 * st + 1;
            bf16x8 pb;
            if (t1 < 9) pb = mk8(pk2c(s[t0][0], s[t0][1]), pk2c(s[t0][2], s[t0][3]), pk2c(s[t1][0], s[t1][1]), pk2c(s[t1][2], s[t1][3]));
            else pb = mk8(pk2c(s[t0][0], s[t0][1]), pk2c(s[t0][2], s[t0][3]), 0u, 0u);
            const int k0 = 16 * (qt + t0) + 4 * quad, k1 = t1 < 9 ? 16 * (qt + t1) + 4 * quad : k0;
#pragma unroll
            for (int dt = 0; dt < 4; ++dt) { const LAS unsigned char* vp = Vt + (16 * dt + i16) * AT_VSTR;
                const u32x2 lo = *(const LAS u32x2*)(vp + k0 * 2), hi = *(const LAS u32x2*)(vp + k1 * 2);
                o[dt] = MFMA16(mk8(lo, hi), pb, o[dt]); } }
        const float inv = __builtin_amdgcn_rcpf(lsum);
#pragma unroll
        for (int dt = 0; dt < 4; ++dt) { const int d0 = 16 * dt + 4 * quad;
            const u32x2 gw = gwv[dt];
            const float g0 = pg8::bf_lo(gw.x), g1 = pg8::bf_hi(gw.x), g2 = pg8::bf_lo(gw.y), g3 = pg8::bf_hi(gw.y);
            u32x2 ow; ow.x = pk2c(o[dt][0] * inv * siluf(g0), o[dt][1] * inv * siluf(g1)); ow.y = pk2c(o[dt][2] * inv * siluf(g2), o[dt][3] * inv * siluf(g3));
            GST(u32x2, YA + mq0 * 512, (unsigned)(qrel * 512 + 64 * hq + d0) * 2u) = ow; }
    }
    LBAR();
}


#undef AT_QLOAD
constexpr int GL_STR = 144;
constexpr int GL_QD = 0, GL_KI = 9216, GL_KET = 18432, GL_VT = 27648, GL_SEG = 46080, GL_BL = 48128, GL_PART = 48384;
__device__ __forceinline__ void gla_unit(int unit, const bf16* PROJ, const bf16* PX, const float* par_g, bf16* YB, LAS unsigned char* lds, int tid) {
    const GAS float* par = (const GAS float*)par_g;
    const int lane = tid & 63, wave = __builtin_amdgcn_readfirstlane(tid >> 6);
    const int b = unit >> 2, h = unit & 3, i16 = lane & 15, quad = lane >> 4;
    const int d = lane, tseg = wave, vA = tid & 127, q4 = wave >> 1, v0 = 16 * wave;
    LAS unsigned char* Qd = lds + GL_QD; LAS unsigned char* Ki = lds + GL_KI; LAS unsigned char* KeT = lds + GL_KET; LAS unsigned char* Vt = lds + GL_VT;
    LAS float* seg = (LAS float*)(lds + GL_SEG); LAS float* bl = (LAS float*)(lds + GL_BL); LAS float* part = (LAS float*)(lds + GL_PART);
    float Wg[16];
#pragma unroll
    for (int r = 0; r < 16; ++r) Wg[r] = par[PG_GWG + r * 256 + 64 * h + d];
    const float bgd = par[PG_GBG + 64 * h + d];
    const float gon = par[PG_GON + v0 + i16];
    f32x4 S[4];
#pragma unroll
    for (int i = 0; i < 4; ++i) S[i] = (f32x4){0.f, 0.f, 0.f, 0.f};
    unsigned gdw; unsigned short qs[8], ks[8], vv[16];
#define GLA_LOADS(mm) do { const bf16* ub_ = PROJ + ((mm) + 8 * tseg) * PG_LD; const bf16* uv_ = PROJ + ((mm) + 16 * q4) * PG_LD; \
        gdw = GLD(unsigned, PX + ((mm) + 8 * tseg) * PX_LD, (unsigned)((lane >> 3) * PX_LD + PC_GD + 2 * (lane & 7)) * 2u); \
        _Pragma("unroll") for (int i = 0; i < 8; ++i) { qs[i] = GLD(unsigned short, ub_ + i * PG_LD, (unsigned)(PC_GQ + 64 * h + d) * 2u); ks[i] = GLD(unsigned short, ub_ + i * PG_LD, (unsigned)(PC_GK + 64 * h + d) * 2u); } \
        _Pragma("unroll") for (int i = 0; i < 16; ++i) vv[i] = GLD(unsigned short, uv_ + i * PG_LD, (unsigned)(PC_GV + 128 * h + vA) * 2u); } while (0)
    GLA_LOADS((size_t)b * SEQ);
    for (int ch = 0; ch < SEQ / 64; ++ch) {
        const size_t m0 = (size_t)b * SEQ + ch * 64;
        float la[8], qv[8], kv[8];
#pragma unroll
        for (int i = 0; i < 8; ++i) { float lg = bgd;
#pragma unroll
            for (int j = 0; j < 8; ++j) { const unsigned w = (unsigned)__builtin_amdgcn_readlane((int)gdw, i * 8 + j); lg += pg8::bf_lo(w) * Wg[2 * j] + pg8::bf_hi(w) * Wg[2 * j + 1]; }
            la[i] = logsigmoidf(lg) * (1.f / 16.f); qv[i] = bf2f(qs[i]); kv[i] = bf2f(ks[i]); }
#pragma unroll
        for (int i = 1; i < 8; ++i) la[i] += la[i - 1];
        seg[tseg * 64 + d] = la[7];
        LBAR();
        float off = 0.f, tot = 0.f;
#pragma unroll
        for (int s = 0; s < 8; ++s) { const float x = seg[s * 64 + d]; tot += x; off += (s < tseg) ? x : 0.f; }
        if (tseg == 0) bl[d] = __expf(tot);
        {
            float ke[8];
#pragma unroll
            for (int i = 0; i < 8; ++i) { const float bc = off + la[i]; const int t = 8 * tseg + i;
                const float qd = qv[i] * 0.125f * __expf(bc), ki = kv[i] * __expf(-bc); ke[i] = kv[i] * __expf(tot - bc);
                *(LAS unsigned short*)(Qd + t * GL_STR + d * 2) = (unsigned short)f2bf(qd);
                *(LAS unsigned short*)(Ki + t * GL_STR + d * 2) = (unsigned short)f2bf(ki); }
            *(LAS v4u*)(KeT + d * GL_STR + 16 * tseg) = (v4u){pk2c(ke[0], ke[1]), pk2c(ke[2], ke[3]), pk2c(ke[4], ke[5]), pk2c(ke[6], ke[7])};
            v4u w0, w1;
#pragma unroll
            for (int j = 0; j < 4; ++j) { w0[j] = (unsigned)vv[2 * j] | ((unsigned)vv[2 * j + 1] << 16); w1[j] = (unsigned)vv[8 + 2 * j] | ((unsigned)vv[8 + 2 * j + 1] << 16); }
            *(LAS v4u*)(Vt + vA * GL_STR + 32 * q4) = w0; *(LAS v4u*)(Vt + vA * GL_STR + 32 * q4 + 16) = w1;
        }
        if (ch + 1 < SEQ / 64) GLA_LOADS(m0 + 64);
        LBAR();
        float gt[4][4];
#pragma unroll
        for (int I = 0; I < 4; ++I)
#pragma unroll
            for (int r = 0; r < 4; ++r) gt[I][r] = bf2f(GLD(unsigned short, PROJ + (m0 + 16 * I + r) * PG_LD, (unsigned)(4 * quad * PG_LD + PC_GG + 128 * h + v0 + i16) * 2u));
        f32x4 oacc[4];
        {
            bf16x8 kiA[4][2], qdB[4][2];
#pragma unroll
            for (int J = 0; J < 4; ++J)
#pragma unroll
                for (int s = 0; s < 2; ++s) { kiA[J][s] = *(const LAS bf16x8*)(Ki + (16 * J + i16) * GL_STR + quad * 16 + 64 * s); qdB[J][s] = *(const LAS bf16x8*)(Qd + (16 * J + i16) * GL_STR + quad * 16 + 64 * s); }
            f32x4 at[4][4];
#pragma unroll
            for (int I = 0; I < 4; ++I)
#pragma unroll
                for (int J = 0; J <= I; ++J) { f32x4 z = {0.f, 0.f, 0.f, 0.f}; z = MFMA16(kiA[J][0], qdB[I][0], z); z = MFMA16(kiA[J][1], qdB[I][1], z);
                    if (J == I) {
#pragma unroll
                        for (int r = 0; r < 4; ++r) z[r] = (4 * quad + r <= i16) ? z[r] : 0.f; }
                    at[J][I] = z; }
            const LAS unsigned char* vrow = Vt + (v0 + i16) * GL_STR;
            const bf16x8 vB01 = mk8(*(const LAS u32x2*)(vrow + (0 + 4 * quad) * 2), *(const LAS u32x2*)(vrow + (16 + 4 * quad) * 2));
            const bf16x8 vB23 = mk8(*(const LAS u32x2*)(vrow + (32 + 4 * quad) * 2), *(const LAS u32x2*)(vrow + (48 + 4 * quad) * 2));
#define PK4(x, y) mk8(pk2c((x)[0], (x)[1]), pk2c((x)[2], (x)[3]), pk2c((y)[0], (y)[1]), pk2c((y)[2], (y)[3]))
#define PK4Z(x) mk8(pk2c((x)[0], (x)[1]), pk2c((x)[2], (x)[3]), 0u, 0u)
            const f32x4 zz = {0.f, 0.f, 0.f, 0.f};
            oacc[0] = MFMA16(PK4Z(at[0][0]), vB01, zz);
            oacc[1] = MFMA16(PK4(at[0][1], at[1][1]), vB01, zz);
            oacc[2] = MFMA16(PK4(at[0][2], at[1][2]), vB01, zz); oacc[2] = MFMA16(PK4Z(at[2][2]), vB23, oacc[2]);
            oacc[3] = MFMA16(PK4(at[0][3], at[1][3]), vB01, zz); oacc[3] = MFMA16(PK4(at[2][3], at[3][3]), vB23, oacc[3]);
        }
        {
            const bf16x8 sB0 = PK4(S[0], S[1]), sB1 = PK4(S[2], S[3]);
#pragma unroll
            for (int I = 0; I < 4; ++I) { const LAS unsigned char* qrow = Qd + (16 * I + i16) * GL_STR;
                const bf16x8 a0 = mk8(*(const LAS u32x2*)(qrow + (0 + 4 * quad) * 2), *(const LAS u32x2*)(qrow + (16 + 4 * quad) * 2));
                const bf16x8 a1 = mk8(*(const LAS u32x2*)(qrow + (32 + 4 * quad) * 2), *(const LAS u32x2*)(qrow + (48 + 4 * quad) * 2));
                oacc[I] = MFMA16(a0, sB0, oacc[I]); oacc[I] = MFMA16(a1, sB1, oacc[I]); }
        }
        {
            const LAS unsigned char* vrow = Vt + (v0 + i16) * GL_STR + quad * 16;
            const bf16x8 vb0 = *(const LAS bf16x8*)vrow, vb1 = *(const LAS bf16x8*)(vrow + 64);
#pragma unroll
            for (int dt = 0; dt < 4; ++dt) { const f32x4 e = *(const LAS f32x4*)(bl + 16 * dt + 4 * quad); const LAS unsigned char* krow = KeT + (16 * dt + i16) * GL_STR + quad * 16;
                f32x4 z = S[dt] * e; z = MFMA16(*(const LAS bf16x8*)krow, vb0, z); S[dt] = MFMA16(*(const LAS bf16x8*)(krow + 64), vb1, z); }
        }
#pragma unroll
        for (int I = 0; I < 4; ++I) { f32x4 q = oacc[I] * oacc[I];
#pragma unroll
            for (int r = 0; r < 4; ++r) q[r] = row16_sum(q[r]);
            if (i16 == 0) *(LAS f32x4*)(part + wave * 64 + 16 * I + 4 * quad) = q; }
        LBAR();
#pragma unroll
        for (int I = 0; I < 4; ++I) { f32x4 tot4 = {0.f, 0.f, 0.f, 0.f};
#pragma unroll
            for (int w = 0; w < 8; ++w) tot4 += *(const LAS f32x4*)(part + w * 64 + 16 * I + 4 * quad);
#pragma unroll
            for (int r = 0; r < 4; ++r) { const float rs = rsqf(tot4[r] * (1.f / 128.f) + EPS);
                GST(unsigned short, YB + (m0 + 16 * I + r) * 512, (unsigned)(4 * quad * 512 + 128 * h + v0 + i16) * 2u) = (unsigned short)f2bf(oacc[I][r] * rs * gon * siluf(gt[I][r])); } }
    }
    LBAR();
#undef PK4
#undef PK4Z
#undef GLA_LOADS
}

constexpr int SD_XT = 0, SD_XW = 36864, SD_BN = 73728, SD_BT = 91136, SD_CN = 109568, SD_GS = 126976, SD_SM = 144384, SD_PART = 148544;
constexpr int SD_XSTR = 144, SD_NSTR = 272;
typedef float f32x2s __attribute__((ext_vector_type(2)));
__device__ __forceinline__ void ssd_unit(int unit, const bf16* PROJ, const bf16* PX, const float* par_g, bf16* YC, LAS unsigned char* lds, int tid) {
    const GAS float* par = (const GAS float*)par_g;
    const int lane = tid & 63, wave = __builtin_amdgcn_readfirstlane(tid >> 6);
    const int b = unit >> 1, g = unit & 1, i16 = lane & 15, quad = lane >> 4;
    const int hl = wave >> 1, ph = wave & 1;
    LAS unsigned char* XT = lds + SD_XT; LAS unsigned char* XW = lds + SD_XW; LAS unsigned char* BN = lds + SD_BN; LAS unsigned char* BT = lds + SD_BT; LAS unsigned char* CN = lds + SD_CN;
    LAS float* GS = (LAS float*)(lds + SD_GS); LAS float* SDT = (LAS float*)(lds + SD_SM); LAS float* SACS = SDT + 256; LAS float* SW = SACS + 256; LAS float* SEA = SW + 256; LAS float* EAL = SEA + 256;
    LAS float* PART = (LAS float*)(lds + SD_PART);
    const int th = wave >> 2, lc0_ = 2 * (tid & 255);
#define SSD_CIDX(lc) ((lc) < 256 ? 256 * g + (lc) : ((lc) < 384 ? 512 + 128 * g + ((lc) - 256) : 768 + 128 * g + ((lc) - 384)))
    const int chb0 = 64 * hl + 32 * ph;
    f32x4 H[8][2];
#pragma unroll
    for (int i = 0; i < 8; ++i) { H[i][0] = (f32x4){0.f, 0.f, 0.f, 0.f}; H[i][1] = (f32x4){0.f, 0.f, 0.f, 0.f}; }
    unsigned raw[35]; unsigned short dtr;
#define SSD_LOADS(mm, first) do { const bf16* ub_ = PROJ + ((long)(mm) + 32 * th - 3) * PS_LD; \
        _Pragma("unroll") for (int i = 0; i < 35; ++i) { raw[i] = 0u; if (!(first) || th > 0 || i >= 3) raw[i] = GLD(unsigned, ub_ + i * PS_LD, (unsigned)(PC_XBC + cidx) * 2u); } \
        dtr = GLD(unsigned short, PX + (mm) * PX_LD, (unsigned)(lane * PX_LD + PC_DT + 4 * g + (wave & 3)) * 2u); } while (0)
    { const int cidx = SSD_CIDX(lc0_); SSD_LOADS((size_t)b * SEQ, true); }
    for (int ch = 0; ch < SEQ / 64; ++ch) {
        const size_t m0 = (size_t)b * SEQ + ch * 64;
        int lc0 = lc0_; asm volatile("" : "+v"(lc0));
        const int cidx = SSD_CIDX(lc0);
        const f32x2s cw0 = *(const GAS f32x2s*)(par + PG_CW + 0 * 1024 + cidx), cw1 = *(const GAS f32x2s*)(par + PG_CW + 1 * 1024 + cidx), cw2 = *(const GAS f32x2s*)(par + PG_CW + 2 * 1024 + cidx),
                      cw3 = *(const GAS f32x2s*)(par + PG_CW + 3 * 1024 + cidx), cbv = *(const GAS f32x2s*)(par + PG_CB + cidx);
        const float wa0 = cw0.x, wb0 = cw0.y, wa1 = cw1.x, wb1 = cw1.y, wa2 = cw2.x, wb2 = cw2.y, wa3 = cw3.x, wb3 = cw3.y, cba = cbv.x, cbb = cbv.y;
        if (wave < 4) {
            const float dtb = par[PG_DTB + 4 * g + wave], negA = -__expf(par[PG_ALOG + 4 * g + wave]);
            const float dt = softplusf(bf2f(dtr) + dtb); float acs = dt * negA;
            acs += dpp_f<0x111>(acs); acs += dpp_f<0x112>(acs); acs += dpp_f<0x114>(acs); acs += dpp_f<0x118>(acs);
            acs += dpp_f<0x142, 0xA>(acs);
            acs += dpp_f<0x143, 0xC>(acs);
            const float alast = __builtin_bit_cast(float, __builtin_amdgcn_readlane(__builtin_bit_cast(int, acs), 63));
            SDT[wave * 64 + lane] = dt; SACS[wave * 64 + lane] = acs; SW[wave * 64 + lane] = dt * __expf(alast - acs); SEA[wave * 64 + lane] = __expf(acs);
            if (lane == 0) EAL[wave] = __expf(alast);
        }
        LBAR();
        {
            float ua0 = pg8::bf_lo(raw[0]), ua1 = pg8::bf_lo(raw[1]), ua2 = pg8::bf_lo(raw[2]), ub0 = pg8::bf_hi(raw[0]), ub1 = pg8::bf_hi(raw[1]), ub2 = pg8::bf_hi(raw[2]);
#pragma unroll
            for (int grp = 0; grp < 4; ++grp) {
                float xa[8], xb[8];
#pragma unroll
                for (int i = 0; i < 8; ++i) { const unsigned wv = raw[3 + 8 * grp + i]; const float ua3 = pg8::bf_lo(wv), ub3 = pg8::bf_hi(wv);
                    const float pa = cba + wa0 * ua0 + wa1 * ua1 + wa2 * ua2 + wa3 * ua3, pb = cbb + wb0 * ub0 + wb1 * ub1 + wb2 * ub2 + wb3 * ub3;
                    xa[i] = pa * __builtin_amdgcn_rcpf(1.f + __expf(-pa)); xb[i] = pb * __builtin_amdgcn_rcpf(1.f + __expf(-pb));
                    ua0 = ua1; ua1 = ua2; ua2 = ua3; ub0 = ub1; ub1 = ub2; ub2 = ub3; }
                const int t0 = 32 * th + 8 * grp;
                const v4u pka = {pk2c(xa[0], xa[1]), pk2c(xa[2], xa[3]), pk2c(xa[4], xa[5]), pk2c(xa[6], xa[7])}, pkb = {pk2c(xb[0], xb[1]), pk2c(xb[2], xb[3]), pk2c(xb[4], xb[5]), pk2c(xb[6], xb[7])};
                if (lc0 < 256) {
                    *(LAS v4u*)(XT + lc0 * SD_XSTR + t0 * 2) = pka; *(LAS v4u*)(XT + (lc0 + 1) * SD_XSTR + t0 * 2) = pkb;
                    const f32x4 wa = *(const LAS f32x4*)(SW + (lc0 >> 6) * 64 + t0), wb = *(const LAS f32x4*)(SW + (lc0 >> 6) * 64 + t0 + 4);
                    *(LAS v4u*)(XW + lc0 * SD_XSTR + t0 * 2) = (v4u){pk2c(xa[0] * wa[0], xa[1] * wa[1]), pk2c(xa[2] * wa[2], xa[3] * wa[3]), pk2c(xa[4] * wb[0], xa[5] * wb[1]), pk2c(xa[6] * wb[2], xa[7] * wb[3])};
                    *(LAS v4u*)(XW + (lc0 + 1) * SD_XSTR + t0 * 2) = (v4u){pk2c(xb[0] * wa[0], xb[1] * wa[1]), pk2c(xb[2] * wa[2], xb[3] * wa[3]), pk2c(xb[4] * wb[0], xb[5] * wb[1]), pk2c(xb[6] * wb[2], xb[7] * wb[3])};
                } else if (lc0 < 384) { const int n = lc0 - 256;
                    *(LAS v4u*)(BT + n * SD_XSTR + t0 * 2) = pka; *(LAS v4u*)(BT + (n + 1) * SD_XSTR + t0 * 2) = pkb;
#pragma unroll
                    for (int i = 0; i < 8; ++i) *(LAS unsigned*)(BN + (t0 + i) * SD_NSTR + n * 2) = pk2c(xa[i], xb[i]);
                } else { const int n = lc0 - 384;
#pragma unroll
                    for (int i = 0; i < 8; ++i) *(LAS unsigned*)(CN + (t0 + i) * SD_NSTR + n * 2) = pk2c(xa[i], xb[i]);
                }
            }
        }
        if (ch + 1 < SEQ / 64) SSD_LOADS(m0 + 64, false);
        LBAR();
        {
#pragma unroll
            for (int rep = 0; rep < 2; ++rep) { const int ti = wave + 8 * rep;
                if (ti < 10) { const int S_ = ti < 4 ? 0 : (ti < 7 ? 1 : (ti < 9 ? 2 : 3)); const int L_ = ti < 4 ? ti : (ti < 7 ? ti - 3 : (ti < 9 ? ti - 5 : 3));
                    f32x4 z = {0.f, 0.f, 0.f, 0.f};
#pragma unroll
                    for (int ks = 0; ks < 4; ++ks) z = MFMA16(*(const LAS bf16x8*)(BN + (16 * S_ + i16) * SD_NSTR + quad * 16 + 64 * ks), *(const LAS bf16x8*)(CN + (16 * L_ + i16) * SD_NSTR + quad * 16 + 64 * ks), z);
#pragma unroll
                    for (int r = 0; r < 4; ++r) GS[(16 * S_ + 4 * quad + r) * 68 + 16 * L_ + i16] = z[r]; } }
        }
        LBAR();
        unsigned zg[4][4];
#pragma unroll
        for (int L = 0; L < 4; ++L)
#pragma unroll
            for (int r = 0; r < 4; ++r) zg[L][r] = GLD(unsigned, PROJ + (m0 + 16 * L + r) * PS_LD, (unsigned)(4 * quad * PS_LD + PC_SZ + 256 * g + chb0 + 2 * i16) * 2u);
        f32x4 yd[4][2];
#define PK4(x, y) mk8(pk2c((x)[0], (x)[1]), pk2c((x)[2], (x)[3]), pk2c((y)[0], (y)[1]), pk2c((y)[2], (y)[3]))
#define PK4Z(x) mk8(pk2c((x)[0], (x)[1]), pk2c((x)[2], (x)[3]), 0u, 0u)
        {
            const f32x4 zz = {0.f, 0.f, 0.f, 0.f};
#pragma unroll
            for (int L = 0; L < 4; ++L) { yd[L][0] = zz; yd[L][1] = zz; }
#pragma unroll
            for (int ks = 0; ks < 4; ++ks) { __builtin_amdgcn_sched_barrier(0); const bf16x8 hB0 = PK4(H[2 * ks][0], H[2 * ks + 1][0]), hB1 = PK4(H[2 * ks][1], H[2 * ks + 1][1]);
#pragma unroll
                for (int L = 0; L < 4; ++L) { const LAS unsigned char* cr = CN + (16 * L + i16) * SD_NSTR + (32 * ks + 4 * quad) * 2;
                    const bf16x8 ca = mk8(*(const LAS u32x2*)cr, *(const LAS u32x2*)(cr + 32));
                    yd[L][0] = MFMA16(ca, hB0, yd[L][0]); yd[L][1] = MFMA16(ca, hB1, yd[L][1]); } }
#pragma unroll
            for (int L = 0; L < 4; ++L) { const f32x4 ea = *(const LAS f32x4*)(SEA + hl * 64 + 16 * L + 4 * quad); yd[L][0] *= ea; yd[L][1] *= ea; }
        }
        __builtin_amdgcn_sched_barrier(0);
        {
            bf16x8 xB01[2], xB23[2];
#pragma unroll
            for (int pt = 0; pt < 2; ++pt) { const LAS unsigned char* xr = XT + (chb0 + 2 * i16 + pt) * SD_XSTR;
                xB01[pt] = mk8(*(const LAS u32x2*)(xr + (0 + 4 * quad) * 2), *(const LAS u32x2*)(xr + (16 + 4 * quad) * 2));
                xB23[pt] = mk8(*(const LAS u32x2*)(xr + (32 + 4 * quad) * 2), *(const LAS u32x2*)(xr + (48 + 4 * quad) * 2)); }
#pragma unroll
            for (int L = 0; L < 4; ++L) { __builtin_amdgcn_sched_barrier(0); const float acs_l = SACS[hl * 64 + 16 * L + i16];
                f32x4 mt[4];
#pragma unroll
                for (int S_ = 0; S_ <= L; ++S_) { const f32x4 acs_s = *(const LAS f32x4*)(SACS + hl * 64 + 16 * S_ + 4 * quad), dt_s = *(const LAS f32x4*)(SDT + hl * 64 + 16 * S_ + 4 * quad);
#pragma unroll
                    for (int r = 0; r < 4; ++r) { const float gv = GS[(16 * S_ + 4 * quad + r) * 68 + 16 * L + i16]; const float v = gv * __expf(acs_l - acs_s[r]) * dt_s[r];
                        mt[S_][r] = (S_ < L || 4 * quad + r <= i16) ? v : 0.f; } }
#pragma unroll
                for (int pt = 0; pt < 2; ++pt) {
                    if (L == 0) yd[L][pt] = MFMA16(PK4Z(mt[0]), xB01[pt], yd[L][pt]);
                    else if (L == 1) yd[L][pt] = MFMA16(PK4(mt[0], mt[1]), xB01[pt], yd[L][pt]);
                    else if (L == 2) { yd[L][pt] = MFMA16(PK4(mt[0], mt[1]), xB01[pt], yd[L][pt]); yd[L][pt] = MFMA16(PK4Z(mt[2]), xB23[pt], yd[L][pt]); }
                    else { yd[L][pt] = MFMA16(PK4(mt[0], mt[1]), xB01[pt], yd[L][pt]); yd[L][pt] = MFMA16(PK4(mt[2], mt[3]), xB23[pt], yd[L][pt]); } } }
        }
        __builtin_amdgcn_sched_barrier(0);
        {
            const float eal = EAL[hl];
            bf16x8 xw[2][2];
#pragma unroll
            for (int pt = 0; pt < 2; ++pt)
#pragma unroll
                for (int k2 = 0; k2 < 2; ++k2) xw[pt][k2] = *(const LAS bf16x8*)(XW + (chb0 + 2 * i16 + pt) * SD_XSTR + quad * 16 + 64 * k2);
#pragma unroll
            for (int nt = 0; nt < 8; ++nt) { if ((nt & 1) == 0) __builtin_amdgcn_sched_barrier(0); const LAS unsigned char* br = BT + (16 * nt + i16) * SD_XSTR + quad * 16;
                const bf16x8 b0 = *(const LAS bf16x8*)br, b1 = *(const LAS bf16x8*)(br + 64);
#pragma unroll
                for (int pt = 0; pt < 2; ++pt) { f32x4 z = H[nt][pt] * eal; z = MFMA16(b0, xw[pt][0], z); H[nt][pt] = MFMA16(b1, xw[pt][1], z); } }
        }
        __builtin_amdgcn_sched_barrier(0);
        const float Dk = par[PG_DSK + 4 * g + hl]; const f32x2s onv = *(const GAS f32x2s*)(par + PG_SON + 256 * g + chb0 + 2 * i16); const float on0 = onv.x, on1 = onv.y;
#pragma unroll
        for (int L = 0; L < 4; ++L) { f32x4 q = {0.f, 0.f, 0.f, 0.f};
#pragma unroll
            for (int pt = 0; pt < 2; ++pt) { const u32x2 xw2 = *(const LAS u32x2*)(XT + (chb0 + 2 * i16 + pt) * SD_XSTR + (16 * L + 4 * quad) * 2);
                const float xv[4] = {pg8::bf_lo(xw2.x), pg8::bf_hi(xw2.x), pg8::bf_lo(xw2.y), pg8::bf_hi(xw2.y)};
#pragma unroll
                for (int r = 0; r < 4; ++r) { const float y = yd[L][pt][r] + Dk * xv[r]; const float u = y * siluf(pt ? pg8::bf_hi(zg[L][r]) : pg8::bf_lo(zg[L][r])); yd[L][pt][r] = u; q[r] += u * u; } }
#pragma unroll
            for (int r = 0; r < 4; ++r) q[r] = row16_sum(q[r]);
            if (i16 == 0) *(LAS f32x4*)(PART + wave * 64 + 16 * L + 4 * quad) = q; }
        LBAR();
#pragma unroll
        for (int L = 0; L < 4; ++L) { f32x4 tot4 = {0.f, 0.f, 0.f, 0.f};
#pragma unroll
            for (int w = 0; w < 8; ++w) tot4 += *(const LAS f32x4*)(PART + w * 64 + 16 * L + 4 * quad);
#pragma unroll
            for (int r = 0; r < 4; ++r) { const float rs = rsqf(tot4[r] * (1.f / 256.f) + EPS); GST(unsigned, YC + (m0 + 16 * L + r) * 512, (unsigned)(4 * quad * 512 + 256 * g + chb0 + 2 * i16) * 2u) = pk2c(yd[L][0][r] * rs * on0, yd[L][1][r] * rs * on1); } }
    }
    LBAR();
#undef PK4
#undef PK4Z
#undef SSD_LOADS
#undef SSD_CIDX
}


struct MgOrder {
    int xcd, nloc, first, stride;
    __device__ __forceinline__ void init(int bx) { xcd = bx & 7; if (bx < 64) { nloc = 9; first = 312 + (bx >> 3); stride = 8; } else { nloc = 13; first = (bx - 64) >> 3; stride = 24; } }
    __device__ __forceinline__ bool next(int i, pg8::Unit& u) const { if (i >= nloc) return false; const int off = first + i * stride, grp = off / 96, w = off % 96; u.pm = (xcd * 4 + grp) * 8 + (w & 7); u.pn = w >> 3; return true; }
    __device__ __forceinline__ void a_ready(const pg8::Unit&) const {}
    __device__ __forceinline__ void done(const pg8::Unit&) const {}
};

struct Merge3Order {
    pg8::StaticOrder S;
    __device__ __forceinline__ bool next(int i, pg8::Unit& u) const { const int j = i / 3, br = i - 3 * j; const int R = S.nwg / S.G; if (!S.next((S.nwg == R * S.G && j < R) ? R - 1 - j : j, u)) return false;
        u.pm += br * 256; u.pn += br * 4; return true; }
    __device__ __forceinline__ void a_ready(const pg8::Unit&) const {}
    __device__ __forceinline__ void done(const pg8::Unit&) const {}
};

__global__ void __launch_bounds__(NTHR, 2) mega_fwd(Args args) {
    extern __shared__ __attribute__((aligned(16))) unsigned char lds_raw[];
    LAS unsigned char* lds = (LAS unsigned char*)lds_raw;
    volatile LAS unsigned* MISC = (volatile LAS unsigned*)(lds + MISC_OFF);
    const int tid = threadIdx.x, lane = tid & 63, wave = __builtin_amdgcn_readfirstlane(tid >> 6);
    const int G = gridDim.x, bx = blockIdx.x;
    unsigned char* ws = args.ws;
    gu32* ctl = (gu32*)(ws + WS_CTL);
    const float* x_in = (const float*)args.in[0];
    float* out = args.out;

    for (int u = tid; u < (LDS_BYTES - LDSCTL_OFF) / 4; u += NTHR) ((LAS unsigned*)(lds + LDSCTL_OFF))[u] = 0u;
    __syncthreads();
    XcdBarrier bar = xcd_barrier_post((unsigned*)(ctl + CW_BAR) + args.li * XCD_BAR_WORDS, MISC + 8);
    const int lo = args.ph_lo, hi = args.ph_hi; (void)lo; (void)hi;
#define IN(k) (lo <= (k) && (k) < hi)
#define OWS() ({ unsigned char* w_ = ws; asm volatile("" : "+s"(w_)); w_; })
#define WIN ((bf16*)(OWS() + WS_WIN))
#define WB ((bf16*)(OWS() + WS_WB))
#define WO ((bf16*)(OWS() + WS_WO))
#define XN ((bf16*)(OWS() + WS_XN))
#define Y ((bf16*)(OWS() + WS_Y))
#define PA ((bf16*)(OWS() + WS_PA))
#define PG ((bf16*)(OWS() + WS_PG))
#define PS ((bf16*)(OWS() + WS_PS))
#define PX ((bf16*)(OWS() + WS_PX))
#define MG ((bf16*)(OWS() + WS_MG))
#define MERGED ((bf16*)(OWS() + WS_MERGED))
#define CS ((float2*)(OWS() + WS_CS))
#define KR ((float*)(OWS() + WS_KR))
#define PAR ((float*)(OWS() + WS_PAR))
#define otid() ({ int t_ = tid; asm volatile("" : "+v"(t_)); t_; })
#define SEAM(k) do { if (IN(k) && IN((k) + 1)) xcd_barrier(bar); } while (0)
    const int gw = bx * NWAVES + wave, NGW = G * NWAVES;

    if (IN(0)) {
        LAS float* scr = (LAS float*)(lds + RING_OFF + wave * 16384);
        constexpr int I_IN = (D / 64) * (NINP / 32), I_B = (512 / 64) * (D / 32), I_O = (D / 64) * (D / 32);
        constexpr int NITEMS = DEPTH * (I_IN + 3 * I_B + I_O);
        for (int it = gw; it < NITEMS; it += NGW) {
            int r = it; const int l = r / (I_IN + 3 * I_B + I_O); r -= l * (I_IN + 3 * I_B + I_O);
            if (r < I_IN) { transpose_item<true>((const float*)args.in[3] + (size_t)l * D * NIN, D, NIN, WIN + (size_t)l * NINP * D, scr, r, NINP / 32, lane, l > 0 ? (const float*)args.in[2] + (size_t)l * D : nullptr); continue; } r -= I_IN;
            if (r < 3 * I_B) { const int n = r / I_B; r -= n * I_B;
                transpose_item<false>((const float*)args.in[16] + (size_t)(l * 3 + n) * 512 * D, 512, D, WB + (size_t)(l * 3 + n) * D * 512, scr, r, D / 32, lane); continue; } r -= 3 * I_B;
            transpose_item<false>((const float*)args.in[17] + (size_t)l * D * D, D, D, WO + (size_t)l * D * D, scr, r, D / 32, lane);
        }
        for (int m = 2 * gw; m < M; m += 2 * NGW) rms_rows2_to_bf16(x_in + (size_t)m * D, x_in + (size_t)(m + 1) * D, (const float*)args.in[2], XN + (size_t)m * D, XN + (size_t)(m + 1) * D, lane);
        for (int e = bx * NTHR + tid; e < M * 32; e += G * NTHR) { const int m = e >> 5, i = e & 31;
            const float inv = exp2f(-(float)(2 * i) * (13.287712379549449f / 64.f)); const float ang = (float)((const int*)args.in[1])[m] * inv; const float rev = ang * 0.15915494309189535f; const float fr = rev - floorf(rev);
            *(GAS f32x2s*)(CS + e) = (f32x2s){__builtin_amdgcn_cosf(fr), __builtin_amdgcn_sinf(fr)}; }
        {
            const int gt = bx * NTHR + tid, GT = G * NTHR;
#define CPY(idx, off, n) for (int e = gt; e < DEPTH * (n); e += GT) *(GAS float*)(PAR + (e / (n)) * PSTRIDE + (off) + e % (n)) = ((const GAS float*)args.in[idx])[e]
            CPY(2, PG_NORM, 1024); CPY(4, PG_QN, 64); CPY(5, PG_KN, 64); CPY(6, PG_SINK, 8); CPY(7, PG_GWG, 4096); CPY(8, PG_GBG, 256); CPY(9, PG_GON, 128);
            CPY(10, PG_CW, 4096); CPY(11, PG_CB, 1024); CPY(12, PG_DTB, 8); CPY(13, PG_ALOG, 8); CPY(14, PG_DSK, 8); CPY(15, PG_SON, 512);
#undef CPY
        }
    }
    SEAM(0);

    for (int l = 0; l < DEPTH; ++l) {
        const int pb = 1 + 7 * l;
        const float* xin = l == 0 ? x_in : out;
        const float* par = PAR + l * PSTRIDE;
        if (IN(pb + 0)) {
            pg8::Gemm g{XN, WIN + (size_t)l * NINP * D, M, NMAIN, D}; pg8::StaticOrder S; S.init(M, NMAIN, G, bx);
            pg8::EpiProj E{PA, PG, PS, PX, l > 0 ? (const float*)(OWS() + WS_RINV) : nullptr};
            pg8::gemm_phase<pg8::EpiProj, pg8::StaticOrder, true, true>(lds + RING_OFF, g, S, E, otid());
        }
        SEAM(pb + 0);
        if (IN(pb + 2)) {
            for (int uu = bx; uu < 192; uu += G) {
            if (uu < 64) ssd_unit(uu, PS, PX, par, Y + (size_t)2 * M * 512, lds, otid());
            else { gla_unit(uu - 64, PG, PX, par, Y + (size_t)1 * M * 512, lds, otid()); if (otid() == 0) __hip_atomic_fetch_add((unsigned*)(ctl + CW_DONE + 64 * l), 1u, __ATOMIC_RELAXED, __HIP_MEMORY_SCOPE_AGENT); }
            }
            for (;;) {
                __syncthreads();
                if (otid() == 0) MISC[0] = __hip_atomic_fetch_add((unsigned*)(ctl + CW_Q + 64 * l), 1u, __ATOMIC_RELAXED, __HIP_MEMORY_SCOPE_AGENT);
                __syncthreads();
                const unsigned item = (unsigned)__builtin_amdgcn_readfirstlane((int)MISC[0]);
                if (item >= 1024u) break;
                attn_unit((int)item, PA, CS, par, Y, lds, otid());
                if (otid() == 0) __hip_atomic_fetch_add((unsigned*)(ctl + CW_DONE + 64 * l), 1u, __ATOMIC_RELAXED, __HIP_MEMORY_SCOPE_AGENT);
            }
        }
        const bool ovl = (G == 256) && IN(pb + 2) && IN(pb + 3);
        if (!ovl) SEAM(pb + 2);
        if (IN(pb + 3)) {
            pg8::Gemm g{XN, WIN + (size_t)l * NINP * D + (size_t)NMAIN * D, M, NMG, D};
            pg8::EpiGate E{MG, NMG, l > 0 ? (const float*)(OWS() + WS_RINV) : nullptr};
            if (ovl) {
                if (otid() == 0) { unsigned sp_ = 0; while (__hip_atomic_load((unsigned*)(ctl + CW_DONE + 64 * l), __ATOMIC_RELAXED, __HIP_MEMORY_SCOPE_AGENT) < (unsigned)N_AG_UNITS) { __builtin_amdgcn_s_sleep(8);
                        if (++sp_ > (1u << 22)) { __hip_atomic_store((unsigned*)(ctl + CW_TMO), 1u, __ATOMIC_RELAXED, __HIP_MEMORY_SCOPE_AGENT); break; } } }
                __syncthreads();
                MgOrder S; S.init(bx);
                pg8::gemm_phase<pg8::EpiGate, MgOrder, true, true>(lds + RING_OFF, g, S, E, otid());
            } else {
                pg8::StaticOrder S; S.init(M, NMG, G, bx);
                pg8::gemm_phase<pg8::EpiGate, pg8::StaticOrder, true, true>(lds + RING_OFF, g, S, E, otid());
            }
        }
        SEAM(pb + 3);
        if (IN(pb + 4)) {
            pg8::Gemm g{Y, WB + (size_t)(l * 3) * D * 512, M, D, 512}; Merge3Order S; S.S.init(M, D, G, bx);
            pg8::EpiMerge3 E{MG, MERGED};
            pg8::gemm_phase<pg8::EpiMerge3, Merge3Order, true, true>(lds + RING_OFF, g, S, E, otid());
        }
        SEAM(pb + 4);
        if (IN(pb + 5)) {
            pg8::Gemm g{MERGED, WO + (size_t)l * D * D, M, D, D}; pg8::StaticOrder S; S.init(M, D, G, bx);
            if (l + 1 < DEPTH) { pg8::EpiResidA E{xin, XN, (float*)(OWS() + WS_RPART)}; pg8::gemm_phase<pg8::EpiResidA, pg8::StaticOrder, true, true>(lds + RING_OFF, g, S, E, otid()); }
            else { pg8::EpiResidB E{XN, out}; pg8::gemm_phase<pg8::EpiResidB, pg8::StaticOrder, true, true>(lds + RING_OFF, g, S, E, otid()); }
        }
        SEAM(pb + 5);
        if (l + 1 < DEPTH) {
            if (IN(pb + 6)) { const float* rp = (const float*)(OWS() + WS_RPART); float* ri = (float*)(OWS() + WS_RINV);
                for (int r_ = bx * NTHR + otid(); r_ < M; r_ += G * NTHR) { const f32x4 a0 = GLD(f32x4, rp, (unsigned)r_ * 64u), a1 = GLD(f32x4, rp, (unsigned)r_ * 64u + 16u), a2 = GLD(f32x4, rp, (unsigned)r_ * 64u + 32u), a3 = GLD(f32x4, rp, (unsigned)r_ * 64u + 48u);
                    const f32x4 s4 = (a0 + a1) + (a2 + a3); *(GAS float*)(ri + r_) = rsqf(((s4[0] + s4[1]) + (s4[2] + s4[3])) * (1.f / D) + EPS); } }
            SEAM(pb + 6);
        }
    }
#undef IN
#undef WIN
#undef WB
#undef WO
#undef XN
#undef Y
#undef PA
#undef PG
#undef PS
#undef PX
#undef MG
#undef MERGED
#undef CS
#undef KR
#undef PAR
#undef SEAM
}

#ifndef MK_SPLIT
#define MK_SPLIT 1
#endif
extern "C" void kernel_launch(void* const* d_in, const int* in_sizes, int n_in, void* d_out, int out_size, void* d_ws, size_t ws_size, hipStream_t stream) {
    static int grid = 0;
    if (grid == 0) {
        if (n_in != 18 || in_sizes[0] != M * D || out_size != M * D || ws_size < WS_END) { fprintf(stderr, "kernel_launch: unexpected shapes/ws (n_in %d, ws %zu)\n", n_in, ws_size); grid = -1; return; }
        int dev = 0, cus = 0, per_cu = 0;
        if (hipGetDevice(&dev) != hipSuccess || hipDeviceGetAttribute(&cus, hipDeviceAttributeMultiprocessorCount, dev) != hipSuccess) { grid = -1; return; }
        if (hipFuncSetAttribute((const void*)mega_fwd, hipFuncAttributeMaxDynamicSharedMemorySize, LDS_BYTES) != hipSuccess) { grid = -1; return; }
        if (hipOccupancyMaxActiveBlocksPerMultiprocessor(&per_cu, (const void*)mega_fwd, NTHR, LDS_BYTES) != hipSuccess || per_cu < 1) { fprintf(stderr, "kernel_launch: occupancy query says %d\n", per_cu); }
        (void)hipGetLastError();
        grid = cus;
    }
    if (grid < 0) return;
    if (hipMemsetAsync((char*)d_ws + WS_CTL, 0, CTL_ZERO_BYTES, stream) != hipSuccess) return;
    Args a{};
    for (int i = 0; i < 18; ++i) a.in[i] = d_in[i];
    a.out = (float*)d_out; a.ws = (unsigned char*)d_ws;
#if MK_SPLIT
    int li = 0;
    for (int ph = 0; ph < NPHASE; ++ph) {
        a.ph_lo = ph; a.ph_hi = ph + 1; a.li = li++; a.pad = 0;
        hipLaunchKernelGGL(mega_fwd, dim3(grid), dim3(NTHR), LDS_BYTES, stream, a); }
#else
    a.ph_lo = 0; a.ph_hi = NPHASE; a.li = 0; a.pad = 0;
    hipLaunchKernelGGL(mega_fwd, dim3(grid), dim3(NTHR), LDS_BYTES, stream, a);
#endif
}
```

```cpp
#include <hip/hip_runtime.h>
#include <cstdio>
#include <cstdint>
#define MK_SPLIT 0
namespace pg8 {
#define PG8_LAS __attribute__((address_space(3)))
typedef unsigned short bf16_t;
typedef short bf16x8 __attribute__((ext_vector_type(8)));
typedef float f32x4 __attribute__((ext_vector_type(4)));
typedef unsigned u32x4 __attribute__((ext_vector_type(4)));
constexpr int BM = 256, BK = 64, HALF = 128, HTB = HALF * BK * 2  , STAGE_BYTES = 8 * HTB, NXCD = 8, WGM = 8;

__host__ __device__ __forceinline__ int lds_byte(int r, int c) { const int st = (r >> 4) * 2 + (c >> 5), rr = r & 15, cc = c & 31, ob = rr * 64 + cc * 2; return st * 1024 + (ob ^ (((ob >> 9) & 1) << 5)); }
__host__ __device__ __forceinline__ void stage_rc(int b, int& R, int& C) { const int st = b / 1024, sb = b % 1024, swz = sb ^ (((sb >> 9) & 1) << 5); R = (st >> 1) * 16 + swz / 64; C = (st & 1) * 32 + (swz % 64) / 2; }
__host__ __device__ __forceinline__ int perm32(int rho) { const int n = rho >> 4, i = rho & 15; return 8 * (i >> 2) + 4 * n + (i & 3); }

struct Unit { int pm, pn; };
struct Gemm { const bf16_t* A; const bf16_t* Bt; int M, N, K; };

struct StaticOrder {
    int nM, nN, nwg, G, c;
    __host__ __device__ void init(int M, int N, int G_, int c_) { nM = M / BM; nN = N / BM; nwg = nM * nN; G = G_; c = c_; }
    __host__ __device__ bool next(int i, Unit& u) const {
        const long L = (long)i * G + c; if (L >= nwg) return false;
        int wgid = (int)L; { const int q = nwg / NXCD, r = nwg % NXCD, xcd = wgid % NXCD, off = wgid / NXCD; wgid = (xcd < r ? xcd * (q + 1) : r * (q + 1) + (xcd - r) * q) + off; }
        const int nig = WGM * nN, gid = wgid / nig, fm = gid * WGM, gsz = (nM - fm) < WGM ? (nM - fm) : WGM;
        u.pm = fm + ((wgid % nig) % gsz); u.pn = (wgid % nig) / gsz; return true;
    }
    __device__ __forceinline__ void a_ready(const Unit&) const {}
    __device__ __forceinline__ void done(const Unit&) const {}
};

typedef float f32x2c __attribute__((ext_vector_type(2))); typedef __bf16 bf16x2c __attribute__((ext_vector_type(2)));
__device__ __forceinline__ unsigned cvt_pk_bf16(float lo, float hi) { const f32x2c v = {lo, hi}; const bf16x2c b = __builtin_convertvector(v, bf16x2c); return __builtin_bit_cast(unsigned, b); }
typedef float f32x2 __attribute__((ext_vector_type(2)));

#define PG8_GAS __attribute__((address_space(1)))
template <class T> __device__ __forceinline__ T gld_(const void* p) { return *(const PG8_GAS T*)p; }
template <class T> __device__ __forceinline__ void gst_(void* p, T v) { *(PG8_GAS T*)p = v; }
__device__ __forceinline__ float sigmoid_fast(float x) { return __builtin_amdgcn_rcpf(1.f + __builtin_amdgcn_exp2f(-1.44269504f * x)); }
__device__ __forceinline__ float bf_lo(unsigned w) { return __builtin_bit_cast(float, w << 16); }
__device__ __forceinline__ float bf_hi(unsigned w) { return __builtin_bit_cast(float, w & 0xffff0000u); }

__device__ __forceinline__ float xrow_sum_e(float x) { unsigned a = __builtin_bit_cast(unsigned, x), b = a; asm volatile("s_nop 1\n\tv_permlane16_swap_b32 %0, %1" : "+v"(a), "+v"(b));
    const float y = __builtin_bit_cast(float, a) + __builtin_bit_cast(float, b); unsigned c = __builtin_bit_cast(unsigned, y), d = c; asm volatile("s_nop 1\n\tv_permlane32_swap_b32 %0, %1" : "+v"(c), "+v"(d));
    return __builtin_bit_cast(float, c) + __builtin_bit_cast(float, d); }
template <int ACT> struct EpiBf16 {
    static constexpr bool PERM = true, AFTER_DRAIN = false, CHAIN = false;
    bf16_t* O; int ldc; const float* rinv;
    __device__ __forceinline__ void operator()(const f32x4 (&acc)[2][2][4][2], const Unit& u, int wr, int wc, int fr, int fq) const {
        const int row0 = u.pm * BM + wr * 64 + fr; const int col0 = u.pn * BM + wc * 32 + 8 * fq;
        float rs[2][4];
#pragma unroll
        for (int ai = 0; ai < 2; ++ai)
#pragma unroll
            for (int m = 0; m < 4; ++m) rs[ai][m] = rinv ? gld_<float>(rinv + row0 + ai * HALF + m * 16) : 1.f;
#pragma unroll
        for (int ai = 0; ai < 2; ++ai)
#pragma unroll
            for (int m = 0; m < 4; ++m) { bf16_t* rowp = O + (size_t)(row0 + ai * HALF + m * 16) * ldc + col0;
#pragma unroll
                for (int bj = 0; bj < 2; ++bj) { f32x4 v0 = acc[ai][bj][m][0] * rs[ai][m], v1 = acc[ai][bj][m][1] * rs[ai][m];
                    if (ACT == 1) {
#pragma unroll
                        for (int j = 0; j < 4; ++j) { v0[j] = __builtin_amdgcn_rcpf(1.f + __builtin_amdgcn_exp2f(fminf(v0[j], 60.f))); v1[j] = __builtin_amdgcn_rcpf(1.f + __builtin_amdgcn_exp2f(fminf(v1[j], 60.f))); } }
                    u32x4 w; w.x = cvt_pk_bf16(v0[0], v0[1]); w.y = cvt_pk_bf16(v0[2], v0[3]); w.z = cvt_pk_bf16(v1[0], v1[1]); w.w = cvt_pk_bf16(v1[2], v1[3]);
                    gst_<u32x4>(rowp + bj * HALF, w); } }
    }
};
struct EpiGate {
    static constexpr bool PERM = true, AFTER_DRAIN = false, CHAIN = false;
    bf16_t* O; int ldc; const float* rinv;
    __device__ __forceinline__ void operator()(const f32x4 (&acc)[2][2][4][2], const Unit& u, int wr, int wc, int fr, int fq) const {
        const int row0 = u.pm * BM + wr * 64 + fr;
        float rs[2][4];
#pragma unroll
        for (int ai = 0; ai < 2; ++ai)
#pragma unroll
            for (int m = 0; m < 4; ++m) rs[ai][m] = rinv ? gld_<float>(rinv + row0 + ai * HALF + m * 16) : 1.f;
        if (u.pn < 8) {
            const int colq = u.pn * HALF + wc * 32 + 8 * fq;
#pragma unroll
            for (int ai = 0; ai < 2; ++ai)
#pragma unroll
                for (int m = 0; m < 4; ++m) { bf16_t* rowp = O + (size_t)(row0 + ai * HALF + m * 16) * ldc + colq;
                    float r[8], g[8];
#pragma unroll
                    for (int n = 0; n < 2; ++n)
#pragma unroll
                        for (int j = 0; j < 4; ++j) { const float d0 = 1.f + __builtin_amdgcn_exp2f(fminf(acc[ai][0][m][n][j] * rs[ai][m], 60.f)), d1 = 1.f + __builtin_amdgcn_exp2f(fminf(acc[ai][1][m][n][j] * rs[ai][m], 60.f));
                            g[4 * n + j] = __builtin_amdgcn_rcpf(d1); r[4 * n + j] = d1 * __builtin_amdgcn_rcpf(d0); }
                    u32x4 w; w.x = cvt_pk_bf16(r[0], r[1]); w.y = cvt_pk_bf16(r[2], r[3]); w.z = cvt_pk_bf16(r[4], r[5]); w.w = cvt_pk_bf16(r[6], r[7]);
                    gst_<u32x4>(rowp, w);
                    w.x = cvt_pk_bf16(g[0], g[1]); w.y = cvt_pk_bf16(g[2], g[3]); w.z = cvt_pk_bf16(g[4], g[5]); w.w = cvt_pk_bf16(g[6], g[7]);
                    gst_<u32x4>(rowp + 1024, w); }
        } else {
            const int col0 = u.pn * BM + wc * 32 + 8 * fq;
#pragma unroll
            for (int ai = 0; ai < 2; ++ai)
#pragma unroll
                for (int m = 0; m < 4; ++m) { bf16_t* rowp = O + (size_t)(row0 + ai * HALF + m * 16) * ldc + col0;
#pragma unroll
                    for (int bj = 0; bj < 2; ++bj) { f32x4 v0 = acc[ai][bj][m][0] * rs[ai][m], v1 = acc[ai][bj][m][1] * rs[ai][m];
#pragma unroll
                        for (int j = 0; j < 4; ++j) { v0[j] = __builtin_amdgcn_rcpf(1.f + __builtin_amdgcn_exp2f(fminf(v0[j], 60.f))); v1[j] = __builtin_amdgcn_rcpf(1.f + __builtin_amdgcn_exp2f(fminf(v1[j], 60.f))); }
                        u32x4 w; w.x = cvt_pk_bf16(v0[0], v0[1]); w.y = cvt_pk_bf16(v0[2], v0[3]); w.z = cvt_pk_bf16(v1[0], v1[1]); w.w = cvt_pk_bf16(v1[2], v1[3]);
                        gst_<u32x4>(rowp + bj * HALF, w); } }
        }
    }
};
struct EpiProj {
    static constexpr bool PERM = true, AFTER_DRAIN = false, CHAIN = false;
    bf16_t *pa, *pg, *ps, *px; const float* rinv;
    __device__ __forceinline__ void operator()(const f32x4 (&acc)[2][2][4][2], const Unit& u, int wr, int wc, int fr, int fq) const {
        bf16_t* O; int ldc, ct;
        if (u.pn < 5) { O = pa; ldc = 1280; ct = u.pn; } else if (u.pn < 11) { O = pg; ldc = 1536; ct = u.pn - 5; } else if (u.pn < 17) { O = ps; ldc = 1536; ct = u.pn - 11; } else { O = px; ldc = 32; ct = 0; }
        const int row0 = u.pm * BM + wr * 64 + fr; const int col0 = ct * BM + wc * 32 + 8 * fq;
        float rs[2][4];
#pragma unroll
        for (int ai = 0; ai < 2; ++ai)
#pragma unroll
            for (int m = 0; m < 4; ++m) rs[ai][m] = rinv ? gld_<float>(rinv + row0 + ai * HALF + m * 16) : 1.f;
#pragma unroll
        for (int ai = 0; ai < 2; ++ai)
#pragma unroll
            for (int m = 0; m < 4; ++m) { bf16_t* rowp = O + (size_t)(row0 + ai * HALF + m * 16) * ldc + col0;
#pragma unroll
                for (int bj = 0; bj < 2; ++bj) { const f32x4 v0 = acc[ai][bj][m][0] * rs[ai][m], v1 = acc[ai][bj][m][1] * rs[ai][m];
                    u32x4 w; w.x = cvt_pk_bf16(v0[0], v0[1]); w.y = cvt_pk_bf16(v0[2], v0[3]); w.z = cvt_pk_bf16(v1[0], v1[1]); w.w = cvt_pk_bf16(v1[2], v1[3]);
                    if (u.pn < 17 || (bj == 0 && wc == 0)) gst_<u32x4>(rowp + bj * HALF, w); } }
    }
};
struct EpiMerge {
    static constexpr bool PERM = true, AFTER_DRAIN = false, CHAIN = false;
    const bf16_t* Gt; int ldg; bf16_t* Mg; int ldm; int first;
    __device__ __forceinline__ void operator()(const f32x4 (&acc)[2][2][4][2], const Unit& u, int wr, int wc, int fr, int fq) const {
        const int row0 = u.pm * BM + wr * 64 + fr; const int col0 = u.pn * BM + wc * 32 + 8 * fq;
#pragma unroll
        for (int ai = 0; ai < 2; ++ai) {
            u32x4 g[4][2], p[4][2];
#pragma unroll
            for (int m = 0; m < 4; ++m) { const size_t row = (size_t)(row0 + ai * HALF + m * 16);
#pragma unroll
                for (int bj = 0; bj < 2; ++bj) { g[m][bj] = gld_<u32x4>(Gt + row * ldg + col0 + bj * HALF);
                    p[m][bj] = (u32x4){0u, 0u, 0u, 0u}; if (!first) p[m][bj] = gld_<u32x4>(Mg + row * ldm + col0 + bj * HALF); } }
#pragma unroll
            for (int m = 0; m < 4; ++m) { const size_t row = (size_t)(row0 + ai * HALF + m * 16);
#pragma unroll
                for (int bj = 0; bj < 2; ++bj) { const f32x4 a0 = acc[ai][bj][m][0], a1 = acc[ai][bj][m][1]; const u32x4 gg = g[m][bj], pp = p[m][bj];
                    u32x4 w;
                    w.x = cvt_pk_bf16(bf_lo(pp.x) + bf_lo(gg.x) * a0[0], bf_hi(pp.x) + bf_hi(gg.x) * a0[1]);
                    w.y = cvt_pk_bf16(bf_lo(pp.y) + bf_lo(gg.y) * a0[2], bf_hi(pp.y) + bf_hi(gg.y) * a0[3]);
                    w.z = cvt_pk_bf16(bf_lo(pp.z) + bf_lo(gg.z) * a1[0], bf_hi(pp.z) + bf_hi(gg.z) * a1[1]);
                    w.w = cvt_pk_bf16(bf_lo(pp.w) + bf_lo(gg.w) * a1[2], bf_hi(pp.w) + bf_hi(gg.w) * a1[3]);
                    gst_<u32x4>(Mg + row * ldm + col0 + bj * HALF, w); } }
        }
    }
};
struct EpiMerge3 {
    static constexpr bool PERM = true, AFTER_DRAIN = false, CHAIN = true;
    static constexpr int LDG = 3072, LDM = 1024;
    const bf16_t* Gt; bf16_t* Mg;
    template <class T> static __device__ __forceinline__ T ldo(const bf16_t* base, int cdisp, unsigned off) { return *(const PG8_GAS T*)((const PG8_GAS unsigned char*)(base + cdisp) + (size_t)off); }
    template <int BR> __device__ __forceinline__ void run(f32x4 (&acc)[2][2][4][2], const Unit& u, int wr, int wc, int fr, int fq) const {
        const int row0 = (u.pm & 255) * BM + wr * 64 + fr; const int col0 = (u.pn & 3) * BM + wc * 32 + 8 * fq;
        const unsigned og = ((unsigned)row0 * LDG + col0) * 2u, om = ((unsigned)row0 * LDM + col0) * 2u;
        if constexpr (BR == 0) {
            u32x4 a[2][4][2];
#pragma unroll
            for (int ai = 0; ai < 2; ++ai)
#pragma unroll
                for (int m = 0; m < 4; ++m)
#pragma unroll
                    for (int bj = 0; bj < 2; ++bj) a[ai][m][bj] = ldo<u32x4>(Gt, (ai * HALF + m * 16) * LDG + bj * HALF, og);
#pragma unroll
            for (int ai = 0; ai < 2; ++ai)
#pragma unroll
                for (int m = 0; m < 4; ++m)
#pragma unroll
                    for (int bj = 0; bj < 2; ++bj) { const u32x4 aa = a[ai][m][bj];
                        acc[ai][bj][m][0] *= (f32x4){bf_lo(aa.x), bf_hi(aa.x), bf_lo(aa.y), bf_hi(aa.y)}; acc[ai][bj][m][1] *= (f32x4){bf_lo(aa.z), bf_hi(aa.z), bf_lo(aa.w), bf_hi(aa.w)};
                        asm volatile("" : "+v"(acc[ai][bj][m][0]), "+v"(acc[ai][bj][m][1])); }
        } else if constexpr (BR == 1) {
#pragma unroll
            for (int ai = 0; ai < 2; ++ai) {
                __builtin_amdgcn_sched_barrier(0);
                u32x4 a[4][2], d[4][2];
#pragma unroll
                for (int m = 0; m < 4; ++m)
#pragma unroll
                    for (int bj = 0; bj < 2; ++bj) { a[m][bj] = ldo<u32x4>(Gt, 1024 + (ai * HALF + m * 16) * LDG + bj * HALF, og); d[m][bj] = ldo<u32x4>(Gt, 2048 + (ai * HALF + m * 16) * LDG + bj * HALF, og); }
#pragma unroll
                for (int m = 0; m < 4; ++m)
#pragma unroll
                    for (int bj = 0; bj < 2; ++bj) { const u32x4 aa = a[m][bj], dd = d[m][bj];
                        const f32x4 r0 = {bf_lo(aa.x) * __builtin_amdgcn_rcpf(bf_lo(dd.x)), bf_hi(aa.x) * __builtin_amdgcn_rcpf(bf_hi(dd.x)), bf_lo(aa.y) * __builtin_amdgcn_rcpf(bf_lo(dd.y)), bf_hi(aa.y) * __builtin_amdgcn_rcpf(bf_hi(dd.y))};
                        const f32x4 r1 = {bf_lo(aa.z) * __builtin_amdgcn_rcpf(bf_lo(dd.z)), bf_hi(aa.z) * __builtin_amdgcn_rcpf(bf_hi(dd.z)), bf_lo(aa.w) * __builtin_amdgcn_rcpf(bf_lo(dd.w)), bf_hi(aa.w) * __builtin_amdgcn_rcpf(bf_hi(dd.w))};
                        acc[ai][bj][m][0] *= r0; acc[ai][bj][m][1] *= r1; asm volatile("" : "+v"(acc[ai][bj][m][0]), "+v"(acc[ai][bj][m][1])); }
            }
        } else {
            u32x4 g[2][4][2];
#pragma unroll
            for (int ai = 0; ai < 2; ++ai)
#pragma unroll
                for (int m = 0; m < 4; ++m)
#pragma unroll
                    for (int bj = 0; bj < 2; ++bj) g[ai][m][bj] = ldo<u32x4>(Gt, 2048 + (ai * HALF + m * 16) * LDG + bj * HALF, og);
#pragma unroll
            for (int ai = 0; ai < 2; ++ai)
#pragma unroll
                for (int m = 0; m < 4; ++m)
#pragma unroll
                    for (int bj = 0; bj < 2; ++bj) { const f32x4 a0 = acc[ai][bj][m][0], a1 = acc[ai][bj][m][1]; const u32x4 gg = g[ai][m][bj];
                        u32x4 w;
                        w.x = cvt_pk_bf16(bf_lo(gg.x) * a0[0], bf_hi(gg.x) * a0[1]); w.y = cvt_pk_bf16(bf_lo(gg.y) * a0[2], bf_hi(gg.y) * a0[3]);
                        w.z = cvt_pk_bf16(bf_lo(gg.z) * a1[0], bf_hi(gg.z) * a1[1]); w.w = cvt_pk_bf16(bf_lo(gg.w) * a1[2], bf_hi(gg.w) * a1[3]);
                        *(PG8_GAS u32x4*)((PG8_GAS unsigned char*)(Mg + (ai * HALF + m * 16) * LDM + bj * HALF) + (size_t)om) = w; }
        }
    }
};
template <class T> __device__ __forceinline__ T ldo_(const void* base, unsigned off) { return *(const PG8_GAS T*)((const PG8_GAS unsigned char*)base + (size_t)off); }
template <class T> __device__ __forceinline__ void sto_(void* base, unsigned off, T v) { *(PG8_GAS T*)((PG8_GAS unsigned char*)base + (size_t)off) = v; }
struct EpiResidA {
    static constexpr bool PERM = true, AFTER_DRAIN = false, CHAIN = false;
    static constexpr int LD = 1024;
    const float* base; bf16_t* xb; float* rpart;
    __device__ __forceinline__ void operator()(const f32x4 (&acc)[2][2][4][2], const Unit& u, int wr, int wc, int fr, int fq) const {
        const int row0 = u.pm * BM + wr * 64 + fr, col0 = u.pn * BM + wc * 32 + 8 * fq;
        const unsigned o4 = ((unsigned)row0 * LD + col0) * 4u, o2 = ((unsigned)row0 * LD + col0) * 2u;
#pragma unroll
        for (int ai = 0; ai < 2; ++ai) {
            __builtin_amdgcn_sched_barrier(0);
            f32x4 bs[4][2][2];
#pragma unroll
            for (int m = 0; m < 4; ++m)
#pragma unroll
                for (int bj = 0; bj < 2; ++bj)
#pragma unroll
                    for (int n = 0; n < 2; ++n) bs[m][bj][n] = ldo_<f32x4>(base + (ai * HALF + m * 16) * LD + bj * HALF + 4 * n, o4);
#pragma unroll
            for (int m = 0; m < 4; ++m) { float ss = 0.f;
#pragma unroll
                for (int bj = 0; bj < 2; ++bj) { const f32x4 p0 = bs[m][bj][0] + acc[ai][bj][m][0], p1 = bs[m][bj][1] + acc[ai][bj][m][1];
                    ss += ((p0[0] * p0[0] + p0[1] * p0[1]) + (p0[2] * p0[2] + p0[3] * p0[3])) + ((p1[0] * p1[0] + p1[1] * p1[1]) + (p1[2] * p1[2] + p1[3] * p1[3]));
                    u32x4 w; w.x = cvt_pk_bf16(p0[0], p0[1]); w.y = cvt_pk_bf16(p0[2], p0[3]); w.z = cvt_pk_bf16(p1[0], p1[1]); w.w = cvt_pk_bf16(p1[2], p1[3]);
                    sto_<u32x4>(xb + (ai * HALF + m * 16) * LD + bj * HALF, o2, w); }
                ss = xrow_sum_e(ss); if (fq == 0) gst_<float>(rpart + (size_t)(row0 + ai * HALF + m * 16) * 16 + u.pn * 4 + wc, ss); }
        }
    }
};
struct EpiResidB {
    static constexpr bool PERM = true, AFTER_DRAIN = false, CHAIN = false;
    static constexpr int LD = 1024;
    const bf16_t* xb; float* out;
    __device__ __forceinline__ void operator()(const f32x4 (&acc)[2][2][4][2], const Unit& u, int wr, int wc, int fr, int fq) const {
        const int row0 = u.pm * BM + wr * 64 + fr, col0 = u.pn * BM + wc * 32 + 8 * fq;
        const unsigned o4 = ((unsigned)row0 * LD + col0) * 4u, o2 = ((unsigned)row0 * LD + col0) * 2u;
        u32x4 b[2][4][2];
#pragma unroll
        for (int ai = 0; ai < 2; ++ai)
#pragma unroll
            for (int m = 0; m < 4; ++m)
#pragma unroll
                for (int bj = 0; bj < 2; ++bj) b[ai][m][bj] = ldo_<u32x4>(xb + (ai * HALF + m * 16) * LD + bj * HALF, o2);
#pragma unroll
        for (int ai = 0; ai < 2; ++ai)
#pragma unroll
            for (int m = 0; m < 4; ++m)
#pragma unroll
                for (int bj = 0; bj < 2; ++bj) { const u32x4 bb = b[ai][m][bj];
                    sto_<f32x4>(out + (ai * HALF + m * 16) * LD + bj * HALF, o4, (f32x4){bf_lo(bb.x), bf_hi(bb.x), bf_lo(bb.y), bf_hi(bb.y)} + acc[ai][bj][m][0]);
                    sto_<f32x4>(out + (ai * HALF + m * 16) * LD + bj * HALF + 4, o4, (f32x4){bf_lo(bb.z), bf_hi(bb.z), bf_lo(bb.w), bf_hi(bb.w)} + acc[ai][bj][m][1]); }
    }
};


template <int V> struct IC { static constexpr int value = V; };
template <class Epi, class Sched, bool ALIGN_EPI = false, bool SP2 = false>
__device__ __forceinline__ void gemm_phase(PG8_LAS unsigned char* lds, const Gemm g, const Sched& S, const Epi& E, const int tid) {
    const int wid = __builtin_amdgcn_readfirstlane(tid >> 6), lane = tid & 63, wr = wid >> 2, wc = wid & 3, fr = lane & 15, fq = lane >> 4;
    const int K = g.K, nt = K / BK;
    unsigned voffA[2], voffB[2];
#pragma unroll
    for (int i = 0; i < 2; ++i) { int R, C; stage_rc(tid * 16 + i * 8192, R, C); const int Rb = Epi::PERM ? ((R & ~31) + perm32(R & 31)) : R;
        voffA[i] = (unsigned)(R * K + C) * 2u; voffB[i] = (unsigned)(Rb * K + C) * 2u; }
    const size_t kstep = (size_t)(BK * 2);
    const size_t hstep = (size_t)HALF * K * 2;
    const size_t tstep = 2 * hstep;
    const unsigned ldsw = (unsigned)wid * 1024u;
    const int aoff = lds_byte(wr * 64 + fr, fq * 8), boff = lds_byte(wc * 32 + fr, fq * 8);
#define PG8_SA(b, h) (((b) * 2 + (h)) * HTB)
#define PG8_SB(b, h) ((4 + (b) * 2 + (h)) * HTB)
#define PG8_STAGE(bufoff, gbase, voff) do { _Pragma("unroll") for (int _i = 0; _i < 2; ++_i) \
        __builtin_amdgcn_global_load_lds((const unsigned*)((const char*)(gbase) + (voff)[_i]), (PG8_LAS unsigned*)(lds + (bufoff) + ldsw + _i * 8192), 16, 0, 0); } while (0)
#define PG8_LDA(dst, b, h) do { _Pragma("unroll") for (int m = 0; m < 4; ++m) _Pragma("unroll") for (int k = 0; k < 2; ++k) dst[m][k] = *(const PG8_LAS bf16x8*)(lds + PG8_SA(b, h) + aoff + m * 2048 + k * 1024); } while (0)
#define PG8_LDB(dst, b, h) do { _Pragma("unroll") for (int n = 0; n < 2; ++n) _Pragma("unroll") for (int k = 0; k < 2; ++k) dst[n][k] = *(const PG8_LAS bf16x8*)(lds + PG8_SB(b, h) + boff + n * 2048 + k * 1024); } while (0)
#define PG8_MMA(ai, bj, At, Bt) do { __builtin_amdgcn_s_setprio(1); _Pragma("unroll") for (int m = 0; m < 4; ++m) _Pragma("unroll") for (int n = 0; n < 2; ++n) _Pragma("unroll") for (int k = 0; k < 2; ++k) \
        acc[ai][bj][m][n] = __builtin_amdgcn_mfma_f32_16x16x32_bf16(Bt[n][k], At[m][k], acc[ai][bj][m][n], 0, 0, 0); __builtin_amdgcn_s_setprio(0); } while (0)
#define PG8_WAIT_V(n) asm volatile("s_waitcnt vmcnt(" #n ")" ::: "memory")
#define PG8_WAIT_L(n) asm volatile("s_waitcnt lgkmcnt(" #n ")" ::: "memory")
#define PG8_BAR __builtin_amdgcn_s_barrier()
#define PG8_SCHED __builtin_amdgcn_sched_barrier(0)
    Unit cur, nxt; int ui = 0;
    if (!S.next(0, cur)) return;
    f32x4 acc[2][2][4][2];
#pragma unroll
    for (int a = 0; a < 2; ++a)
#pragma unroll
        for (int b = 0; b < 2; ++b)
#pragma unroll
            for (int m = 0; m < 4; ++m)
#pragma unroll
                for (int n = 0; n < 2; ++n) acc[a][b][m][n] = (f32x4){0.f, 0.f, 0.f, 0.f};
    bf16x8 At[4][2], B0[2][2], B1[2][2];
    const char* cA = (const char*)g.A + (size_t)cur.pm * tstep; const char* cB = (const char*)g.Bt + (size_t)cur.pn * tstep;
    S.a_ready(cur);
    if constexpr (SP2) {
        PG8_STAGE(PG8_SB(0, 0), cB, voffB); PG8_STAGE(PG8_SB(0, 1), cB + hstep, voffB); PG8_STAGE(PG8_SA(0, 0), cA, voffA); PG8_STAGE(PG8_SA(0, 1), cA + hstep, voffA);
        if (wr == 1) PG8_BAR;
        PG8_WAIT_V(2); PG8_BAR;
        PG8_STAGE(PG8_SB(1, 0), cB + kstep, voffB); PG8_STAGE(PG8_SA(1, 0), cA + kstep, voffA); PG8_STAGE(PG8_SB(1, 1), cB + hstep + kstep, voffB);
        PG8_WAIT_V(6); PG8_BAR;
    } else {
        PG8_STAGE(PG8_SB(0, 0), cB, voffB); PG8_STAGE(PG8_SA(0, 0), cA, voffA); PG8_STAGE(PG8_SB(0, 1), cB + hstep, voffB); PG8_STAGE(PG8_SA(0, 1), cA + hstep, voffA);
        if (wr == 1) PG8_BAR;
        PG8_WAIT_V(4); PG8_BAR;
        PG8_STAGE(PG8_SB(1, 0), cB + kstep, voffB); PG8_STAGE(PG8_SA(1, 0), cA + kstep, voffA); PG8_STAGE(PG8_SB(1, 1), cB + hstep + kstep, voffB);
        PG8_WAIT_V(6); PG8_BAR;
    }
    auto unit = [&](auto BRC) __attribute__((always_inline)) -> bool {
        constexpr int BR = decltype(BRC)::value;
        const bool has_next = S.next(ui + 1, nxt);
        const char* nA = has_next ? (const char*)g.A + (size_t)nxt.pm * tstep : cA; const char* nB = has_next ? (const char*)g.Bt + (size_t)nxt.pn * tstep : cB;
        for (int t = 0; t < nt; t += 2) {
            const bool last = (t == nt - 2);
            const char* a1 = cA + (size_t)(t + 1) * kstep;
            const char* a2 = last ? nA : cA + (size_t)(t + 2) * kstep; const char* b2 = last ? nB : cB + (size_t)(t + 2) * kstep;
            const char* a3 = a2 + kstep; const char* b3 = b2 + kstep;
            if (last && has_next) S.a_ready(nxt);
            if constexpr (SP2) {
            PG8_LDB(B0, 0, 0); PG8_LDB(B1, 0, 1); PG8_SCHED; PG8_LDA(At, 0, 0); PG8_STAGE(PG8_SA(1, 1), a1 + hstep, voffA);
            PG8_WAIT_V(8); PG8_WAIT_L(0); PG8_BAR; PG8_MMA(0, 0, At, B0); PG8_MMA(0, 1, At, B1); PG8_BAR; PG8_SCHED;
            PG8_LDA(At, 0, 1); PG8_STAGE(PG8_SB(0, 0), b2, voffB); PG8_STAGE(PG8_SB(0, 1), b2 + hstep, voffB); PG8_STAGE(PG8_SA(0, 0), a2, voffA);
            PG8_WAIT_V(8); PG8_WAIT_L(0); PG8_BAR; PG8_MMA(1, 0, At, B0); PG8_MMA(1, 1, At, B1); PG8_BAR; PG8_SCHED;
            PG8_LDB(B0, 1, 0); PG8_LDB(B1, 1, 1); PG8_SCHED; PG8_LDA(At, 1, 0); PG8_STAGE(PG8_SA(0, 1), a2 + hstep, voffA);
            PG8_WAIT_V(8); PG8_WAIT_L(0); PG8_BAR; PG8_MMA(0, 0, At, B0); PG8_MMA(0, 1, At, B1); PG8_BAR; PG8_SCHED;
            PG8_LDA(At, 1, 1); PG8_STAGE(PG8_SB(1, 0), b3, voffB); PG8_STAGE(PG8_SB(1, 1), b3 + hstep, voffB); PG8_STAGE(PG8_SA(1, 0), a3, voffA);
            PG8_WAIT_V(8); PG8_WAIT_L(0); PG8_BAR; PG8_MMA(1, 0, At, B0); PG8_MMA(1, 1, At, B1); PG8_BAR; PG8_SCHED;
            } else {
            PG8_LDB(B0, 0, 0); PG8_SCHED; PG8_LDA(At, 0, 0); PG8_STAGE(PG8_SA(1, 1), a1 + hstep, voffA);
            PG8_WAIT_L(8); PG8_BAR; PG8_WAIT_L(0); PG8_MMA(0, 0, At, B0); PG8_BAR; PG8_SCHED;
            PG8_LDB(B1, 0, 1); PG8_STAGE(PG8_SB(0, 0), b2, voffB);
            PG8_BAR; PG8_WAIT_L(0); PG8_MMA(0, 1, At, B1); PG8_BAR;
            PG8_LDA(At, 0, 1); PG8_STAGE(PG8_SA(0, 0), a2, voffA);
            PG8_BAR; PG8_WAIT_L(0); PG8_MMA(1, 0, At, B0); PG8_BAR; PG8_SCHED;
            PG8_STAGE(PG8_SB(0, 1), b2 + hstep, voffB);
            PG8_WAIT_V(6); PG8_BAR; PG8_MMA(1, 1, At, B1); PG8_BAR;
            PG8_LDB(B0, 1, 0); PG8_SCHED; PG8_LDA(At, 1, 0); PG8_STAGE(PG8_SA(0, 1), a2 + hstep, voffA);
            PG8_WAIT_L(8); PG8_BAR; PG8_WAIT_L(0); PG8_MMA(0, 0, At, B0); PG8_BAR; PG8_SCHED;
            PG8_LDB(B1, 1, 1); PG8_STAGE(PG8_SB(1, 0), b3, voffB);
            PG8_BAR; PG8_WAIT_L(0); PG8_MMA(0, 1, At, B1); PG8_BAR;
            PG8_LDA(At, 1, 1); PG8_STAGE(PG8_SA(1, 0), a3, voffA);
            PG8_BAR; PG8_WAIT_L(0); PG8_MMA(1, 0, At, B0); PG8_BAR; PG8_SCHED;
            PG8_STAGE(PG8_SB(1, 1), b3 + hstep, voffB);
            PG8_WAIT_V(6); PG8_BAR; PG8_MMA(1, 1, At, B1); PG8_BAR;
            }
        }
        if constexpr (ALIGN_EPI) { if (wr == 0) PG8_BAR; }
        if constexpr (Epi::CHAIN) { E.template run<BR>(acc, cur, wr, wc, fr, fq); S.done(cur); }
        else if constexpr (!Epi::AFTER_DRAIN) { E(acc, cur, wr, wc, fr, fq); S.done(cur); }
        if (!has_next) return false;
        if constexpr (!Epi::CHAIN || BR == 2) {
#pragma unroll
        for (int a = 0; a < 2; ++a)
#pragma unroll
            for (int b = 0; b < 2; ++b)
#pragma unroll
                for (int m = 0; m < 4; ++m)
#pragma unroll
                    for (int n = 0; n < 2; ++n) acc[a][b][m][n] = (f32x4){0.f, 0.f, 0.f, 0.f};
        }
        cur = nxt; cA = nA; cB = nB; ++ui;
        if constexpr (ALIGN_EPI) { if (wr == 1) PG8_BAR; }
        return true;
    };
    if constexpr (Epi::CHAIN) { for (;;) { if (!unit(IC<0>{})) break; if (!unit(IC<1>{})) break; if (!unit(IC<2>{})) break; } }
    else { for (;;) if (!unit(IC<0>{})) break; }
    PG8_WAIT_V(0);
    if constexpr (!ALIGN_EPI) { if (wr == 0) PG8_BAR; }
    PG8_BAR;
    if constexpr (Epi::AFTER_DRAIN) { E.fused(acc, cur, wr, wc, fr, fq, lds, wid, lane); S.done(cur); }
#undef PG8_SA
#undef PG8_SB
#undef PG8_STAGE
#undef PG8_LDA
#undef PG8_LDB
#undef PG8_MMA
#undef PG8_WAIT_V
#undef PG8_WAIT_L
#undef PG8_BAR
#undef PG8_SCHED
}
}
#define GAS __attribute__((address_space(1)))
#define LAS __attribute__((address_space(3)))
typedef unsigned short bf16;
typedef unsigned v4u __attribute__((ext_vector_type(4)));
typedef float f32x4 __attribute__((ext_vector_type(4)));
typedef short bf16x8 __attribute__((ext_vector_type(8)));
typedef GAS unsigned gu32;
typedef GAS unsigned long long gu64;
#define RLX_AGENT __ATOMIC_RELAXED, __HIP_MEMORY_SCOPE_AGENT
#define LDS_WAIT() asm volatile("s_waitcnt lgkmcnt(0)" ::: "memory")
#define VM_WAIT() asm volatile("s_waitcnt vmcnt(0)" ::: "memory")
__device__ __forceinline__ unsigned long long rt() { return __builtin_amdgcn_s_memrealtime(); }
__device__ __forceinline__ unsigned f2bf(float f) { unsigned u = __builtin_bit_cast(unsigned, f); return (u + 0x7fffu + ((u >> 16) & 1u)) >> 16; }
__device__ __forceinline__ unsigned pk2(float lo, float hi) { return f2bf(lo) | (f2bf(hi) << 16); }

#define XB_TMO      128
#define XB_XCNT(j)  (256  + 64 * (j))
#define XB_XSUB(j)  (1280 + 64 * (j))
#define XB_XGEN(j)  (2304 + 64 * (j))
#define XB_TOP      3328
#define XB_TOPGEN   3392
#define XCD_BAR_WORDS 3456
#define XB_SPIN_CAP (1u << 18)

__device__ __forceinline__ unsigned xb_ld(unsigned* p)              { return __hip_atomic_load(p, __ATOMIC_RELAXED, __HIP_MEMORY_SCOPE_AGENT); }
__device__ __forceinline__ unsigned xb_add(unsigned* p, unsigned v) { return __hip_atomic_fetch_add(p, v, __ATOMIC_RELAXED, __HIP_MEMORY_SCOPE_AGENT); }
__device__ __forceinline__ unsigned xb_xcc_id() { return (unsigned)__builtin_amdgcn_s_getreg((3 << 11) | 20) & 0xFu; }
#define XB_SPIN(cond, bar) do { unsigned _sp = 0; while (cond) { __builtin_amdgcn_s_sleep(1); \
    if ((++_sp & 255u) == 0u) { if (xb_ld(&(bar)[XB_TMO])) break; if (_sp > XB_SPIN_CAP) { atomicAdd(&(bar)[XB_TMO], 1u); break; } } } } while (0)

struct XcdBarrier {
    unsigned* bar; unsigned x;
    volatile LAS unsigned* st;
};

__device__ __forceinline__ XcdBarrier xcd_barrier_post(unsigned* bar, volatile LAS unsigned* st) {
    XcdBarrier b; b.bar = bar; b.x = xb_xcc_id(); b.st = st;
    if (threadIdx.x == 0) (void)xb_add(&bar[XB_XCNT(b.x)], 1u);
    return b;
}
__device__ __forceinline__ void xcd_barrier_complete(unsigned* bar, unsigned x, unsigned& nloc, unsigned& nx) {
    const unsigned G = gridDim.x * gridDim.y * gridDim.z;
    unsigned sum, cnt, mine, sp = 0u;
    for (;;) {
        sum = 0u; cnt = 0u; mine = 0u;
#pragma unroll
        for (unsigned j = 0; j < 16; ++j) { const unsigned c = xb_ld(&bar[XB_XCNT(j)]); sum += c; cnt += (c > 0u) ? 1u : 0u; mine = (j == x) ? c : mine; }
        if (sum == G) break;
        __builtin_amdgcn_s_sleep(1);
        if ((++sp & 255u) == 0u) { if (xb_ld(&bar[XB_TMO])) break; if (sp > XB_SPIN_CAP) { atomicAdd(&bar[XB_TMO], 1u); break; } }
    }
    nloc = mine > 0u ? mine : 1u; nx = cnt > 0u ? cnt : 1u;
}

__device__ __forceinline__ void xcd_barrier(const XcdBarrier& b) {
    asm volatile("s_waitcnt vmcnt(0)" ::: "memory");
    __syncthreads();
    if (threadIdx.x == 0) {
        unsigned* bar = b.bar;
        __builtin_amdgcn_s_waitcnt(0);
        unsigned nloc = b.st[0], nx = b.st[1];
        if (nloc == 0u) { xcd_barrier_complete(bar, b.x, nloc, nx); b.st[0] = nloc; b.st[1] = nx; }
        const unsigned old = xb_add(&bar[XB_XSUB(b.x)], 1u);
        const unsigned gen = old / nloc;
        if (old + 1u == (gen + 1u) * nloc) {
            __builtin_amdgcn_fence(__ATOMIC_RELEASE, "agent");
            asm volatile("s_waitcnt vmcnt(0)" ::: "memory");
            const unsigned og = xb_add(&bar[XB_TOP], 1u);
            const unsigned tg = og / nx;
            if (og + 1u == (tg + 1u) * nx) xb_add(&bar[XB_TOPGEN], 1u);
            else XB_SPIN(xb_ld(&bar[XB_TOPGEN]) == tg, bar);
            __builtin_amdgcn_fence(__ATOMIC_ACQUIRE, "agent");
            xb_add(&bar[XB_XGEN(b.x)], 1u);
            asm volatile("s_waitcnt vmcnt(0)" ::: "memory");
        } else {
            XB_SPIN(xb_ld(&bar[XB_XGEN(b.x)]) == gen, bar);
            __builtin_amdgcn_fence(__ATOMIC_ACQUIRE, "agent");
            asm volatile("s_waitcnt vmcnt(0)" ::: "memory");
        }
    }
    __syncthreads();
}


constexpr int BATCH = 32, SEQ = 2048, D = 1024, M = BATCH * SEQ, DEPTH = 2;
constexpr int NIN = 7448, NMAIN = 4608, NMG = 3072, NINP = NMAIN + NMG;
constexpr float EPS = 1e-6f;
constexpr int PA_LD = 1280, PG_LD = 1536, PS_LD = 1536, PX_LD = 32;
constexpr int PC_AQ = 0, PC_AK = 512, PC_AV = 640, PC_AG = 768, PC_GQ = 0, PC_GK = 256, PC_GV = 512, PC_GG = 1024, PC_XBC = 0, PC_SZ = 1024, PC_GD = 0, PC_DT = 16;
__host__ __device__ __forceinline__ int src_col(int d) {
    if (d < 2816) return d;
    if (d < 3840) return d + 16;
    if (d < 4352) return d + 24;
    if (d < 4368) return 2816 + (d - 4352);
    if (d < 4376) return 3856 + (d - 4368);
    if (d < NMAIN) return -1;
    const int e = d - NMAIN, t = e >> 8, w = e & 255;
    return 4376 + (t < 8 ? (w >> 7) * 1024 + 128 * t + (w & 127) : e);
}
constexpr size_t MiB = 1u << 20;
constexpr size_t WS_CTL = 0, CTL_ZERO_BYTES = 1 * MiB;
constexpr size_t WS_WIN = 1 * MiB;
constexpr size_t WS_WB = 31 * MiB;
constexpr size_t WS_WO = 37 * MiB;
constexpr size_t WS_PAR = 41 * MiB;
constexpr int PG_NORM = 0, PG_QN = 1024, PG_KN = 1088, PG_SINK = 1152, PG_GWG = 1160, PG_GBG = 5256, PG_GON = 5512, PG_CW = 5640, PG_CB = 9736, PG_DTB = 10760, PG_ALOG = 10768, PG_DSK = 10776, PG_SON = 10784, PSTRIDE = 11296;
constexpr size_t WS_RPART = 42 * MiB;
constexpr size_t WS_RINV = 46 * MiB;
constexpr size_t WS_XN = 48 * MiB;
constexpr size_t WS_Y = 176 * MiB;
constexpr size_t WS_PA = 368 * MiB, WS_PG = 528 * MiB, WS_SPARE = 720 * MiB, WS_PS = 752 * MiB, WS_PX = 960 * MiB;
constexpr size_t WS_MG = 368 * MiB;
constexpr size_t WS_MERGED = 752 * MiB;
constexpr size_t WS_CS = 944 * MiB;
constexpr size_t WS_END = 1024 * MiB;
static_assert(WS_PA + (size_t)M * PA_LD * 2 == WS_PG && WS_PG + (size_t)M * PG_LD * 2 == WS_SPARE && WS_MG + (size_t)M * NMG * 2 == WS_PS && WS_PS + (size_t)M * PS_LD * 2 == WS_CS && WS_MERGED + (size_t)M * D * 2 <= WS_CS && WS_PX + (size_t)M * PX_LD * 2 <= WS_END, "ws map");
constexpr int CW_TMO = 0, CW_CODE = 1;
constexpr int CW_Q = 64;
constexpr int CW_DONE = 256;
constexpr int N_AG_UNITS = 128 + 1024;
constexpr int CW_BAR = 4096;
constexpr int NPHASE = 14, MAX_LAUNCH = 16;
constexpr int RING_OFF = 0, RING_BYTES = 131072;
constexpr int LDS_BYTES = 163840;
constexpr int LDSCTL_OFF = LDS_BYTES - 1024, MISC_OFF = LDSCTL_OFF + 320;
constexpr int NWAVES = 8, NTHR = 512;

struct Args { const void* in[18]; float* out; unsigned char* ws; int ph_lo, ph_hi, li, pad; };

template <int CTRL, int ROWMASK = 0xF> __device__ __forceinline__ float dpp_f(float x) { return __builtin_bit_cast(float, __builtin_amdgcn_update_dpp(0, __builtin_bit_cast(int, x), CTRL, ROWMASK, 0xF, ROWMASK == 0xF)); }
__device__ __forceinline__ float quad_sum(float x) { x += dpp_f<0xB1>(x); x += dpp_f<0x4E>(x); return x; }
__device__ __forceinline__ float row16_sum(float x) { x = quad_sum(x); x += dpp_f<0x141>(x); x += dpp_f<0x140>(x); return x; }
typedef unsigned u32x2p __attribute__((ext_vector_type(2)));
__device__ __forceinline__ void swap16(unsigned& a, unsigned& b) { asm volatile("s_nop 1\n\tv_permlane16_swap_b32 %0, %1" : "+v"(a), "+v"(b)); }
__device__ __forceinline__ void swap32(unsigned& a, unsigned& b) { asm volatile("s_nop 1\n\tv_permlane32_swap_b32 %0, %1" : "+v"(a), "+v"(b)); }
__device__ __forceinline__ float xrow_sum(float x) { unsigned a = __builtin_bit_cast(unsigned, x), b = a; swap16(a, b); const float y = __builtin_bit_cast(float, a) + __builtin_bit_cast(float, b);
    unsigned c = __builtin_bit_cast(unsigned, y), d = c; swap32(c, d); return __builtin_bit_cast(float, c) + __builtin_bit_cast(float, d); }
__device__ __forceinline__ float xrow_max(float x) { unsigned a = __builtin_bit_cast(unsigned, x), b = a; swap16(a, b); const float y = fmaxf(__builtin_bit_cast(float, a), __builtin_bit_cast(float, b));
    unsigned c = __builtin_bit_cast(unsigned, y), d = c; swap32(c, d); return fmaxf(__builtin_bit_cast(float, c), __builtin_bit_cast(float, d)); }
__device__ __forceinline__ float wave_sum(float v) {
    v = row16_sum(v);
    return ((__builtin_bit_cast(float, __builtin_amdgcn_readlane(__builtin_bit_cast(int, v), 0)) + __builtin_bit_cast(float, __builtin_amdgcn_readlane(__builtin_bit_cast(int, v), 16)))
         + (__builtin_bit_cast(float, __builtin_amdgcn_readlane(__builtin_bit_cast(int, v), 32)) + __builtin_bit_cast(float, __builtin_amdgcn_readlane(__builtin_bit_cast(int, v), 48))));
}
__device__ __forceinline__ float bf2f(bf16 b) { return __builtin_bit_cast(float, ((unsigned)b) << 16); }
__device__ __forceinline__ float siluf(float x) { return x * __builtin_amdgcn_rcpf(1.f + __builtin_amdgcn_exp2f(-1.44269504f * x)); }
__device__ __forceinline__ float softplusf(float x) { return x > 20.f ? x : __logf(1.f + __expf(x)); }
__device__ __forceinline__ float logsigmoidf(float x) { return fminf(x, 0.f) - __logf(1.f + __expf(-fabsf(x))); }
__device__ __forceinline__ float rsqf(float x) { return __builtin_amdgcn_rsqf(x); }

template <bool MAPPED>
__device__ __forceinline__ void transpose_item(const float* W, int K, int N, bf16* WT, LAS float* scr, int item, int nblk, int lane, const float* gk = nullptr) {
    const int kb = item / nblk, nb = item % nblk, k0 = 64 * kb, n0 = 32 * nb;
    const int nd = n0 + (lane & 31); const int sc = MAPPED ? src_col(nd) : nd;
    const float wmul = (MAPPED && nd >= NMAIN) ? -1.44269504f : 1.f;
#pragma unroll 8
    for (int i = 0; i < 32; ++i) { const int kk = 2 * i + (lane >> 5); scr[kk * 33 + (lane & 31)] = sc >= 0 ? W[(size_t)(k0 + kk) * N + sc] * (gk ? wmul * gk[k0 + kk] : wmul) : 0.f; }
    LDS_WAIT(); asm volatile("" ::: "memory");
    const int c = lane & 7;
#pragma unroll
    for (int j = 0; j < 4; ++j) { const int n = (lane >> 3) + 8 * j; const LAS float* s = scr + (8 * c) * 33 + n;
        v4u o; o.x = pk2(s[0 * 33], s[1 * 33]); o.y = pk2(s[2 * 33], s[3 * 33]); o.z = pk2(s[4 * 33], s[5 * 33]); o.w = pk2(s[6 * 33], s[7 * 33]);
        *(GAS v4u*)(WT + (size_t)(n0 + n) * K + k0 + 8 * c) = o; }
    LDS_WAIT(); asm volatile("" ::: "memory");
}
__device__ __forceinline__ void rms_rows2_to_bf16(const float* xrow0, const float* xrow1, const float* g, bf16* orow0, bf16* orow1, int lane) {
    const GAS f32x4* xr0 = (const GAS f32x4*)xrow0 + lane; const GAS f32x4* xr1 = (const GAS f32x4*)xrow1 + lane; const GAS f32x4* gr = (const GAS f32x4*)g + lane;
    f32x4 v[4], w[4]; float s = 0.f, t = 0.f;
#pragma unroll
    for (int j = 0; j < 4; ++j) { v[j] = xr0[64 * j]; w[j] = xr1[64 * j]; }
#pragma unroll
    for (int j = 0; j < 4; ++j) { s += (v[j].x * v[j].x + v[j].y * v[j].y) + (v[j].z * v[j].z + v[j].w * v[j].w); t += (w[j].x * w[j].x + w[j].y * w[j].y) + (w[j].z * w[j].z + w[j].w * w[j].w); }
    const float r = 1.f / sqrtf(wave_sum(s) * (1.f / D) + EPS), q = 1.f / sqrtf(wave_sum(t) * (1.f / D) + EPS);
    GAS unsigned long long* o0 = (GAS unsigned long long*)orow0 + lane; GAS unsigned long long* o1 = (GAS unsigned long long*)orow1 + lane;
#pragma unroll
    for (int j = 0; j < 4; ++j) { const f32x4 gg = gr[64 * j];
        o0[64 * j] = (unsigned long long)pk2(v[j].x * r * gg.x, v[j].y * r * gg.y) | ((unsigned long long)pk2(v[j].z * r * gg.z, v[j].w * r * gg.w) << 32);
        o1[64 * j] = (unsigned long long)pk2(w[j].x * q * gg.x, w[j].y * q * gg.y) | ((unsigned long long)pk2(w[j].z * q * gg.z, w[j].w * q * gg.w) << 32); }
}

typedef unsigned long long u64;
typedef unsigned u32x2 __attribute__((ext_vector_type(2)));
#define LBAR() do { asm volatile("s_waitcnt lgkmcnt(0)" ::: "memory"); __builtin_amdgcn_s_barrier(); asm volatile("" ::: "memory"); } while (0)
#define GLD(T, base, off) (*(const GAS T*)((const GAS unsigned char*)(base) + (size_t)(unsigned)(off)))
#define GST(T, base, off) (*(GAS T*)((GAS unsigned char*)(base) + (size_t)(unsigned)(off)))
#define MFMA16(a, b, c) __builtin_amdgcn_mfma_f32_16x16x32_bf16((a), (b), (c), 0, 0, 0)
__device__ __forceinline__ unsigned pk2c(float lo, float hi) { return pg8::cvt_pk_bf16(lo, hi); }
__device__ __forceinline__ bf16x8 mk8(unsigned a, unsigned b, unsigned c, unsigned d) { const v4u t = {a, b, c, d}; return __builtin_bit_cast(bf16x8, t); }
__device__ __forceinline__ bf16x8 mk8(u32x2 lo, u32x2 hi) { const v4u t = {lo.x, lo.y, hi.x, hi.y}; return __builtin_bit_cast(bf16x8, t); }
__device__ __forceinline__ float ex2(float x) { return __builtin_amdgcn_exp2f(x); }

constexpr int AT_KS = 0, AT_KSTR = 144, AT_VT = 36864, AT_VSTR = 528;
__device__ __forceinline__ void attn_unit(int unit, const bf16* PROJ, const float2* CS, const float* par_g, bf16* YA, LAS unsigned char* lds, int tid) {
    const GAS float* par = (const GAS float*)par_g;
    const int lane = tid & 63, wave = __builtin_amdgcn_readfirstlane(tid >> 6);
    const int jb = unit & 15, kvh = (unit >> 4) & 1, b = unit >> 5;
    const long mq0 = (long)b * SEQ + jb * 128, mk0 = mq0 - 128;
    LAS unsigned char* Ks = lds + AT_KS; LAS unsigned char* Vt = lds + AT_VT;
    const GAS float* kn = par + PG_KN; const GAS float* qn = par + PG_QN;
    const int g = wave >> 1, hq = 4 * kvh + g, i16 = lane & 15, quad = lane >> 4;
    v4u qr0, qr1; f32x4 qcs[4];
#define AT_QLOAD(itn) do { const int qrel_ = 16 * ((wave & 1) * 4 + (itn)) + i16; const unsigned qo_ = (unsigned)(qrel_ * PA_LD + PC_AQ + 64 * hq + 8 * quad) * 2u, cso_ = (unsigned)(qrel_ * 32 + 8 * quad) * 8u; \
        qr0 = GLD(v4u, PROJ + mq0 * PA_LD, qo_); qr1 = GLD(v4u, PROJ + mq0 * PA_LD, qo_ + 64u); \
        _Pragma("unroll") for (int j2 = 0; j2 < 4; ++j2) qcs[j2] = GLD(f32x4, CS + mq0 * 32, cso_ + 16u * j2); } while (0)
    AT_QLOAD(0);
#pragma unroll
    for (int it = 0; it < 2; ++it) {
        const int task = tid + it * NTHR, kk = task >> 2, c = task & 3;
        v4u w0 = {0u, 0u, 0u, 0u}, w1 = {0u, 0u, 0u, 0u};
        if (jb > 0 || kk >= 128) {
            const unsigned ko = (unsigned)(kk * PA_LD + PC_AK + 64 * kvh + 8 * c) * 2u;
            const v4u r0 = GLD(v4u, PROJ + mk0 * PA_LD, ko), r1 = GLD(v4u, PROJ + mk0 * PA_LD, ko + 64u);
            float x0[8], x1[8]; float ss = 0.f;
#pragma unroll
            for (int j = 0; j < 4; ++j) { x0[2 * j] = pg8::bf_lo(r0[j]); x0[2 * j + 1] = pg8::bf_hi(r0[j]); x1[2 * j] = pg8::bf_lo(r1[j]); x1[2 * j + 1] = pg8::bf_hi(r1[j]); }
#pragma unroll
            for (int j = 0; j < 8; ++j) ss += x0[j] * x0[j] + x1[j] * x1[j];
            ss = quad_sum(ss);
            const float r = rsqf(ss * (1.f / 64.f) + EPS);
            const unsigned cso = (unsigned)(kk * 32 + 8 * c) * 8u;
            float o0[8], o1[8];
#pragma unroll
            for (int j2 = 0; j2 < 4; ++j2) { const f32x4 cs = GLD(f32x4, CS + mk0 * 32, cso + 16u * j2);
#pragma unroll
                for (int e = 0; e < 2; ++e) { const int j = 2 * j2 + e; const float cn = e ? cs.z : cs.x, sn = e ? cs.w : cs.y;
                    const float y0 = x0[j] * r * kn[8 * c + j], y1 = x1[j] * r * kn[32 + 8 * c + j];
                    o0[j] = y0 * cn - y1 * sn; o1[j] = y1 * cn + y0 * sn; } }
            w0 = (v4u){pk2c(o0[0], o0[1]), pk2c(o0[2], o0[3]), pk2c(o0[4], o0[5]), pk2c(o0[6], o0[7])};
            w1 = (v4u){pk2c(o1[0], o1[1]), pk2c(o1[2], o1[3]), pk2c(o1[4], o1[5]), pk2c(o1[6], o1[7])};
        }
        *(LAS v4u*)(Ks + kk * AT_KSTR + c * 16) = w0; *(LAS v4u*)(Ks + kk * AT_KSTR + 64 + c * 16) = w1;
    }
    {
        const int kk = tid & 255, dh = tid >> 8;
        v4u r[4] = {{0u, 0u, 0u, 0u}, {0u, 0u, 0u, 0u}, {0u, 0u, 0u, 0u}, {0u, 0u, 0u, 0u}};
        if (jb > 0 || kk >= 128) { const unsigned vo = (unsigned)(kk * PA_LD + PC_AV + 64 * kvh + 32 * dh) * 2u;
#pragma unroll
            for (int j = 0; j < 4; ++j) r[j] = GLD(v4u, PROJ + mk0 * PA_LD, vo + 16u * j); }
#pragma unroll
        for (int j = 0; j < 4; ++j)
#pragma unroll
            for (int e = 0; e < 4; ++e) { const unsigned w = r[j][e]; const int d = 32 * dh + 8 * j + 2 * e;
                *(LAS unsigned short*)(Vt + d * AT_VSTR + kk * 2) = (unsigned short)(w & 0xffffu);
                *(LAS unsigned short*)(Vt + (d + 1) * AT_VSTR + kk * 2) = (unsigned short)(w >> 16); }
    }
    LBAR();
    const float sinkl = par[PG_SINK + hq] * 1.44269504f;
    for (int it = 0; it < 4; ++it) {
        const int qt = (wave & 1) * 4 + it, qrel = 16 * qt + i16;
        bf16x8 qf0, qf1;
        {
            const v4u r0 = qr0, r1 = qr1;
            float x0[8], x1[8]; float ss = 0.f;
#pragma unroll
            for (int j = 0; j < 4; ++j) { x0[2 * j] = pg8::bf_lo(r0[j]); x0[2 * j + 1] = pg8::bf_hi(r0[j]); x1[2 * j] = pg8::bf_lo(r1[j]); x1[2 * j + 1] = pg8::bf_hi(r1[j]); }
#pragma unroll
            for (int j = 0; j < 8; ++j) ss += x0[j] * x0[j] + x1[j] * x1[j];
            ss = xrow_sum(ss);
            const float r = (0.125f * 1.44269504f) * rsqf(ss * (1.f / 64.f) + EPS);
            float o0[8], o1[8];
#pragma unroll
            for (int j2 = 0; j2 < 4; ++j2) { const f32x4 cs = qcs[j2];
#pragma unroll
                for (int e = 0; e < 2; ++e) { const int j = 2 * j2 + e; const float cn = e ? cs.z : cs.x, sn = e ? cs.w : cs.y;
                    const float y0 = x0[j] * r * qn[8 * quad + j], y1 = x1[j] * r * qn[32 + 8 * quad + j];
                    o0[j] = y0 * cn - y1 * sn; o1[j] = y1 * cn + y0 * sn; } }
            qf0 = mk8(pk2c(o0[0], o0[1]), pk2c(o0[2], o0[3]), pk2c(o0[4], o0[5]), pk2c(o0[6], o0[7]));
            qf1 = mk8(pk2c(o1[0], o1[1]), pk2c(o1[2], o1[3]), pk2c(o1[4], o1[5]), pk2c(o1[6], o1[7]));
        }
        if (it < 3) AT_QLOAD(it + 1);
        u32x2 gwv[4];
#pragma unroll
        for (int dt = 0; dt < 4; ++dt) gwv[dt] = GLD(u32x2, PROJ + mq0 * PA_LD, (unsigned)(qrel * PA_LD + PC_AG + 64 * hq + 16 * dt + 4 * quad) * 2u);
        f32x4 s[9];
#pragma unroll
        for (int t = 0; t < 9; ++t) { const LAS unsigned char* kp = Ks + (16 * (qt + t) + i16) * AT_KSTR + quad * 16;
            const bf16x8 a0 = *(const LAS bf16x8*)kp, a1 = *(const LAS bf16x8*)(kp + 64);
            f32x4 z = {0.f, 0.f, 0.f, 0.f}; z = MFMA16(a0, qf0, z); s[t] = MFMA16(a1, qf1, z); }
        float mx = sinkl;
        if (jb > 0) {
#pragma unroll
            for (int r = 0; r < 4; ++r) { s[0][r] = (4 * quad + r > i16) ? s[0][r] : -1.0e30f; s[8][r] = (4 * quad + r <= i16) ? s[8][r] : -1.0e30f; }
        } else {
#pragma unroll
            for (int t = 0; t < 9; ++t)
#pragma unroll
                for (int r = 0; r < 4; ++r) { const int kk = 16 * (qt + t) + 4 * quad + r;
                    const bool valid = (kk > qrel) && (kk <= qrel + 128) && (kk >= 128);
                    s[t][r] = valid ? s[t][r] : -1.0e30f; }
        }
#pragma unroll
        for (int t = 0; t < 9; ++t) mx = fmaxf(mx, fmaxf(fmaxf(s[t][0], s[t][1]), fmaxf(s[t][2], s[t][3])));
        mx = xrow_max(mx);
        float lsum = 0.f;
#pragma unroll
        for (int t = 0; t < 9; ++t)
#pragma unroll
            for (int r = 0; r < 4; ++r) { const float p = ex2(s[t][r] - mx); s[t][r] = p; lsum += p; }
        lsum = xrow_sum(lsum) + ex2(sinkl - mx);
        f32x4 o[4];
#pragma unroll
        for (int dt = 0; dt < 4; ++dt) o[dt] = (f32x4){0.f, 0.f, 0.f, 0.f};
#pragma unroll
        for (int st = 0; st < 5; ++st) { const int t0 = 2 * st, t1 = 2 * st + 1;
            bf16x8 pb;
            if (t1 < 9) pb = mk8(pk2c(s[t0][0], s[t0][1]), pk2c(s[t0][2], s[t0][3]), pk2c(s[t1][0], s[t1][1]), pk2c(s[t1][2], s[t1][3]));
            else pb = mk8(pk2c(s[t0][0], s[t0][1]), pk2c(s[t0][2], s[t0][3]), 0u, 0u);
            const int k0 = 16 * (qt + t0) + 4 * quad, k1 = t1 < 9 ? 16 * (qt + t1) + 4 * quad : k0;
#pragma unroll
            for (int dt = 0; dt < 4; ++dt) { const LAS unsigned char* vp = Vt + (16 * dt + i16) * AT_VSTR;
                const u32x2 lo = *(const LAS u32x2*)(vp + k0 * 2), hi = *(const LAS u32x2*)(vp + k1 * 2);
                o[dt] = MFMA16(mk8(lo, hi), pb, o[dt]); } }
        const float inv = __builtin_amdgcn_rcpf(lsum);
#pragma unroll
        for (int dt = 0; dt < 4; ++dt) { const int d0 = 16 * dt + 4 * quad;
            const u32x2 gw = gwv[dt];
            const float g0 = pg8::bf_lo(gw.x), g1 = pg8::bf_hi(gw.x), g2 = pg8::bf_lo(gw.y), g3 = pg8::bf_hi(gw.y);
            u32x2 ow; ow.x = pk2c(o[dt][0] * inv * siluf(g0), o[dt][1] * inv * siluf(g1)); ow.y = pk2c(o[dt][2] * inv * siluf(g2), o[dt][3] * inv * siluf(g3));
            GST(u32x2, YA + mq0 * 512, (unsigned)(qrel * 512 + 64 * hq + d0) * 2u) = ow; }
    }
    LBAR();
}


#undef AT_QLOAD
constexpr int GL_STR = 144;
constexpr int GL_QD = 0, GL_KI = 9216, GL_KET = 18432, GL_VT = 27648, GL_SEG = 46080, GL_BL = 48128, GL_PART = 48384;
__device__ __forceinline__ void gla_unit(int unit, const bf16* PROJ, const bf16* PX, const float* par_g, bf16* YB, LAS unsigned char* lds, int tid) {
    const GAS float* par = (const GAS float*)par_g;
    const int lane = tid & 63, wave = __builtin_amdgcn_readfirstlane(tid >> 6);
    const int b = unit >> 2, h = unit & 3, i16 = lane & 15, quad = lane >> 4;
    const int d = lane, tseg = wave, vA = tid & 127, q4 = wave >> 1, v0 = 16 * wave;
    LAS unsigned char* Qd = lds + GL_QD; LAS unsigned char* Ki = lds + GL_KI; LAS unsigned char* KeT = lds + GL_KET; LAS unsigned char* Vt = lds + GL_VT;
    LAS float* seg = (LAS float*)(lds + GL_SEG); LAS float* bl = (LAS float*)(lds + GL_BL); LAS float* part = (LAS float*)(lds + GL_PART);
    float Wg[16];
#pragma unroll
    for (int r = 0; r < 16; ++r) Wg[r] = par[PG_GWG + r * 256 + 64 * h + d];
    const float bgd = par[PG_GBG + 64 * h + d];
    const float gon = par[PG_GON + v0 + i16];
    f32x4 S[4];
#pragma unroll
    for (int i = 0; i < 4; ++i) S[i] = (f32x4){0.f, 0.f, 0.f, 0.f};
    unsigned gdw; unsigned short qs[8], ks[8], vv[16];
#define GLA_LOADS(mm) do { const bf16* ub_ = PROJ + ((mm) + 8 * tseg) * PG_LD; const bf16* uv_ = PROJ + ((mm) + 16 * q4) * PG_LD; \
        gdw = GLD(unsigned, PX + ((mm) + 8 * tseg) * PX_LD, (unsigned)((lane >> 3) * PX_LD + PC_GD + 2 * (lane & 7)) * 2u); \
        _Pragma("unroll") for (int i = 0; i < 8; ++i) { qs[i] = GLD(unsigned short, ub_ + i * PG_LD, (unsigned)(PC_GQ + 64 * h + d) * 2u); ks[i] = GLD(unsigned short, ub_ + i * PG_LD, (unsigned)(PC_GK + 64 * h + d) * 2u); } \
        _Pragma("unroll") for (int i = 0; i < 16; ++i) vv[i] = GLD(unsigned short, uv_ + i * PG_LD, (unsigned)(PC_GV + 128 * h + vA) * 2u); } while (0)
    GLA_LOADS((size_t)b * SEQ);
    for (int ch = 0; ch < SEQ / 64; ++ch) {
        const size_t m0 = (size_t)b * SEQ + ch * 64;
        float la[8], qv[8], kv[8];
#pragma unroll
        for (int i = 0; i < 8; ++i) { float lg = bgd;
#pragma unroll
            for (int j = 0; j < 8; ++j) { const unsigned w = (unsigned)__builtin_amdgcn_readlane((int)gdw, i * 8 + j); lg += pg8::bf_lo(w) * Wg[2 * j] + pg8::bf_hi(w) * Wg[2 * j + 1]; }
            la[i] = logsigmoidf(lg) * (1.f / 16.f); qv[i] = bf2f(qs[i]); kv[i] = bf2f(ks[i]); }
#pragma unroll
        for (int i = 1; i < 8; ++i) la[i] += la[i - 1];
        seg[tseg * 64 + d] = la[7];
        LBAR();
        float off = 0.f, tot = 0.f;
#pragma unroll
        for (int s = 0; s < 8; ++s) { const float x = seg[s * 64 + d]; tot += x; off += (s < tseg) ? x : 0.f; }
        if (tseg == 0) bl[d] = __expf(tot);
        {
            float ke[8];
#pragma unroll
            for (int i = 0; i < 8; ++i) { const float bc = off + la[i]; const int t = 8 * tseg + i;
                const float qd = qv[i] * 0.125f * __expf(bc), ki = kv[i] * __expf(-bc); ke[i] = kv[i] * __expf(tot - bc);
                *(LAS unsigned short*)(Qd + t * GL_STR + d * 2) = (unsigned short)f2bf(qd);
                *(LAS unsigned short*)(Ki + t * GL_STR + d * 2) = (unsigned short)f2bf(ki); }
            *(LAS v4u*)(KeT + d * GL_STR + 16 * tseg) = (v4u){pk2c(ke[0], ke[1]), pk2c(ke[2], ke[3]), pk2c(ke[4], ke[5]), pk2c(ke[6], ke[7])};
            v4u w0, w1;
#pragma unroll
            for (int j = 0; j < 4; ++j) { w0[j] = (unsigned)vv[2 * j] | ((unsigned)vv[2 * j + 1] << 16); w1[j] = (unsigned)vv[8 + 2 * j] | ((unsigned)vv[8 + 2 * j + 1] << 16); }
            *(LAS v4u*)(Vt + vA * GL_STR + 32 * q4) = w0; *(LAS v4u*)(Vt + vA * GL_STR + 32 * q4 + 16) = w1;
        }
        if (ch + 1 < SEQ / 64) GLA_LOADS(m0 + 64);
        LBAR();
        float gt[4][4];
#pragma unroll
        for (int I = 0; I < 4; ++I)
#pragma unroll
            for (int r = 0; r < 4; ++r) gt[I][r] = bf2f(GLD(unsigned short, PROJ + (m0 + 16 * I + r) * PG_LD, (unsigned)(4 * quad * PG_LD + PC_GG + 128 * h + v0 + i16) * 2u));
        f32x4 oacc[4];
        {
            bf16x8 kiA[4][2], qdB[4][2];
#pragma unroll
            for (int J = 0; J < 4; ++J)
#pragma unroll
                for (int s = 0; s < 2; ++s) { kiA[J][s] = *(const LAS bf16x8*)(Ki + (16 * J + i16) * GL_STR + quad * 16 + 64 * s); qdB[J][s] = *(const LAS bf16x8*)(Qd + (16 * J + i16) * GL_STR + quad * 16 + 64 * s); }
            f32x4 at[4][4];
#pragma unroll
            for (int I = 0; I < 4; ++I)
#pragma unroll
                for (int J = 0; J <= I; ++J) { f32x4 z = {0.f, 0.f, 0.f, 0.f}; z = MFMA16(kiA[J][0], qdB[I][0], z); z = MFMA16(kiA[J][1], qdB[I][1], z);
                    if (J == I) {
#pragma unroll
                        for (int r = 0; r < 4; ++r) z[r] = (4 * quad + r <= i16) ? z[r] : 0.f; }
                    at[J][I] = z; }
            const LAS unsigned char* vrow = Vt + (v0 + i16) * GL_STR;
            const bf16x8 vB01 = mk8(*(const LAS u32x2*)(vrow + (0 + 4 * quad) * 2), *(const LAS u32x2*)(vrow + (16 + 4 * quad) * 2));
            const bf16x8 vB23 = mk8(*(const LAS u32x2*)(vrow + (32 + 4 * quad) * 2), *(const LAS u32x2*)(vrow + (48 + 4 * quad) * 2));
#define PK4(x, y) mk8(pk2c((x)[0], (x)[1]), pk2c((x)[2], (x)[3]), pk2c((y)[0], (y)[1]), pk2c((y)[2], (y)[3]))
#define PK4Z(x) mk8(pk2c((x)[0], (x)[1]), pk2c((x)[2], (x)[3]), 0u, 0u)
            const f32x4 zz = {0.f, 0.f, 0.f, 0.f};
            oacc[0] = MFMA16(PK4Z(at[0][0]), vB01, zz);
            oacc[1] = MFMA16(PK4(at[0][1], at[1][1]), vB01, zz);
            oacc[2] = MFMA16(PK4(at[0][2], at[1][2]), vB01, zz); oacc[2] = MFMA16(PK4Z(at[2][2]), vB23, oacc[2]);
            oacc[3] = MFMA16(PK4(at[0][3], at[1][3]), vB01, zz); oacc[3] = MFMA16(PK4(at[2][3], at[3][3]), vB23, oacc[3]);
        }
        {
            const bf16x8 sB0 = PK4(S[0], S[1]), sB1 = PK4(S[2], S[3]);
#pragma unroll
            for (int I = 0; I < 4; ++I) { const LAS unsigned char* qrow = Qd + (16 * I + i16) * GL_STR;
                const bf16x8 a0 = mk8(*(const LAS u32x2*)(qrow + (0 + 4 * quad) * 2), *(const LAS u32x2*)(qrow + (16 + 4 * quad) * 2));
                const bf16x8 a1 = mk8(*(const LAS u32x2*)(qrow + (32 + 4 * quad) * 2), *(const LAS u32x2*)(qrow + (48 + 4 * quad) * 2));
                oacc[I] = MFMA16(a0, sB0, oacc[I]); oacc[I] = MFMA16(a1, sB1, oacc[I]); }
        }
        {
            const LAS unsigned char* vrow = Vt + (v0 + i16) * GL_STR + quad * 16;
            const bf16x8 vb0 = *(const LAS bf16x8*)vrow, vb1 = *(const LAS bf16x8*)(vrow + 64);
#pragma unroll
            for (int dt = 0; dt < 4; ++dt) { const f32x4 e = *(const LAS f32x4*)(bl + 16 * dt + 4 * quad); const LAS unsigned char* krow = KeT + (16 * dt + i16) * GL_STR + quad * 16;
                f32x4 z = S[dt] * e; z = MFMA16(*(const LAS bf16x8*)krow, vb0, z); S[dt] = MFMA16(*(const LAS bf16x8*)(krow + 64), vb1, z); }
        }
#pragma unroll
        for (int I = 0; I < 4; ++I) { f32x4 q = oacc[I] * oacc[I];
#pragma unroll
            for (int r = 0; r < 4; ++r) q[r] = row16_sum(q[r]);
            if (i16 == 0) *(LAS f32x4*)(part + wave * 64 + 16 * I + 4 * quad) = q; }
        LBAR();
#pragma unroll
        for (int I = 0; I < 4; ++I) { f32x4 tot4 = {0.f, 0.f, 0.f, 0.f};
#pragma unroll
            for (int w = 0; w < 8; ++w) tot4 += *(const LAS f32x4*)(part + w * 64 + 16 * I + 4 * quad);
#pragma unroll
            for (int r = 0; r < 4; ++r) { const float rs = rsqf(tot4[r] * (1.f / 128.f) + EPS);
                GST(unsigned short, YB + (m0 + 16 * I + r) * 512, (unsigned)(4 * quad * 512 + 128 * h + v0 + i16) * 2u) = (unsigned short)f2bf(oacc[I][r] * rs * gon * siluf(gt[I][r])); } }
    }
    LBAR();
#undef PK4
#undef PK4Z
#undef GLA_LOADS
}

constexpr int SD_XT = 0, SD_XW = 36864, SD_BN = 73728, SD_BT = 91136, SD_CN = 109568, SD_GS = 126976, SD_SM = 144384, SD_PART = 148544;
constexpr int SD_XSTR = 144, SD_NSTR = 272;
typedef float f32x2s __attribute__((ext_vector_type(2)));
__device__ __forceinline__ void ssd_unit(int unit, const bf16* PROJ, const bf16* PX, const float* par_g, bf16* YC, LAS unsigned char* lds, int tid) {
    const GAS float* par = (const GAS float*)par_g;
    const int lane = tid & 63, wave = __builtin_amdgcn_readfirstlane(tid >> 6);
    const int b = unit >> 1, g = unit & 1, i16 = lane & 15, quad = lane >> 4;
    const int hl = wave >> 1, ph = wave & 1;
    LAS unsigned char* XT = lds + SD_XT; LAS unsigned char* XW = lds + SD_XW; LAS unsigned char* BN = lds + SD_BN; LAS unsigned char* BT = lds + SD_BT; LAS unsigned char* CN = lds + SD_CN;
    LAS float* GS = (LAS float*)(lds + SD_GS); LAS float* SDT = (LAS float*)(lds + SD_SM); LAS float* SACS = SDT + 256; LAS float* SW = SACS + 256; LAS float* SEA = SW + 256; LAS float* EAL = SEA + 256;
    LAS float* PART = (LAS float*)(lds + SD_PART);
    const int th = wave >> 2, lc0_ = 2 * (tid & 255);
#define SSD_CIDX(lc) ((lc) < 256 ? 256 * g + (lc) : ((lc) < 384 ? 512 + 128 * g + ((lc) - 256) : 768 + 128 * g + ((lc) - 384)))
    const int chb0 = 64 * hl + 32 * ph;
    f32x4 H[8][2];
#pragma unroll
    for (int i = 0; i < 8; ++i) { H[i][0] = (f32x4){0.f, 0.f, 0.f, 0.f}; H[i][1] = (f32x4){0.f, 0.f, 0.f, 0.f}; }
    unsigned raw[35]; unsigned short dtr;
#define SSD_LOADS(mm, first) do { const bf16* ub_ = PROJ + ((long)(mm) + 32 * th - 3) * PS_LD; \
        _Pragma("unroll") for (int i = 0; i < 35; ++i) { raw[i] = 0u; if (!(first) || th > 0 || i >= 3) raw[i] = GLD(unsigned, ub_ + i * PS_LD, (unsigned)(PC_XBC + cidx) * 2u); } \
        dtr = GLD(unsigned short, PX + (mm) * PX_LD, (unsigned)(lane * PX_LD + PC_DT + 4 * g + (wave & 3)) * 2u); } while (0)
    { const int cidx = SSD_CIDX(lc0_); SSD_LOADS((size_t)b * SEQ, true); }
    for (int ch = 0; ch < SEQ / 64; ++ch) {
        const size_t m0 = (size_t)b * SEQ + ch * 64;
        int lc0 = lc0_; asm volatile("" : "+v"(lc0));
        const int cidx = SSD_CIDX(lc0);
        const f32x2s cw0 = *(const GAS f32x2s*)(par + PG_CW + 0 * 1024 + cidx), cw1 = *(const GAS f32x2s*)(par + PG_CW + 1 * 1024 + cidx), cw2 = *(const GAS f32x2s*)(par + PG_CW + 2 * 1024 + cidx),
                      cw3 = *(const GAS f32x2s*)(par + PG_CW + 3 * 1024 + cidx), cbv = *(const GAS f32x2s*)(par + PG_CB + cidx);
        const float wa0 = cw0.x, wb0 = cw0.y, wa1 = cw1.x, wb1 = cw1.y, wa2 = cw2.x, wb2 = cw2.y, wa3 = cw3.x, wb3 = cw3.y, cba = cbv.x, cbb = cbv.y;
        if (wave < 4) {
            const float dtb = par[PG_DTB + 4 * g + wave], negA = -__expf(par[PG_ALOG + 4 * g + wave]);
            const float dt = softplusf(bf2f(dtr) + dtb); float acs = dt * negA;
            acs += dpp_f<0x111>(acs); acs += dpp_f<0x112>(acs); acs += dpp_f<0x114>(acs); acs += dpp_f<0x118>(acs);
            acs += dpp_f<0x142, 0xA>(acs);
            acs += dpp_f<0x143, 0xC>(acs);
            const float alast = __builtin_bit_cast(float, __builtin_amdgcn_readlane(__builtin_bit_cast(int, acs), 63));
            SDT[wave * 64 + lane] = dt; SACS[wave * 64 + lane] = acs; SW[wave * 64 + lane] = dt * __expf(alast - acs); SEA[wave * 64 + lane] = __expf(acs);
            if (lane == 0) EAL[wave] = __expf(alast);
        }
        LBAR();
        {
            float ua0 = pg8::bf_lo(raw[0]), ua1 = pg8::bf_lo(raw[1]), ua2 = pg8::bf_lo(raw[2]), ub0 = pg8::bf_hi(raw[0]), ub1 = pg8::bf_hi(raw[1]), ub2 = pg8::bf_hi(raw[2]);
#pragma unroll
            for (int grp = 0; grp < 4; ++grp) {
                float xa[8], xb[8];
#pragma unroll
                for (int i = 0; i < 8; ++i) { const unsigned wv = raw[3 + 8 * grp + i]; const float ua3 = pg8::bf_lo(wv), ub3 = pg8::bf_hi(wv);
                    const float pa = cba + wa0 * ua0 + wa1 * ua1 + wa2 * ua2 + wa3 * ua3, pb = cbb + wb0 * ub0 + wb1 * ub1 + wb2 * ub2 + wb3 * ub3;
                    xa[i] = pa * __builtin_amdgcn_rcpf(1.f + __expf(-pa)); xb[i] = pb * __builtin_amdgcn_rcpf(1.f + __expf(-pb));
                    ua0 = ua1; ua1 = ua2; ua2 = ua3; ub0 = ub1; ub1 = ub2; ub2 = ub3; }
                const int t0 = 32 * th + 8 * grp;
                const v4u pka = {pk2c(xa[0], xa[1]), pk2c(xa[2], xa[3]), pk2c(xa[4], xa[5]), pk2c(xa[6], xa[7])}, pkb = {pk2c(xb[0], xb[1]), pk2c(xb[2], xb[3]), pk2c(xb[4], xb[5]), pk2c(xb[6], xb[7])};
                if (lc0 < 256) {
                    *(LAS v4u*)(XT + lc0 * SD_XSTR + t0 * 2) = pka; *(LAS v4u*)(XT + (lc0 + 1) * SD_XSTR + t0 * 2) = pkb;
                    const f32x4 wa = *(const LAS f32x4*)(SW + (lc0 >> 6) * 64 + t0), wb = *(const LAS f32x4*)(SW + (lc0 >> 6) * 64 + t0 + 4);
                    *(LAS v4u*)(XW + lc0 * SD_XSTR + t0 * 2) = (v4u){pk2c(xa[0] * wa[0], xa[1] * wa[1]), pk2c(xa[2] * wa[2], xa[3] * wa[3]), pk2c(xa[4] * wb[0], xa[5] * wb[1]), pk2c(xa[6] * wb[2], xa[7] * wb[3])};
                    *(LAS v4u*)(XW + (lc0 + 1) * SD_XSTR + t0 * 2) = (v4u){pk2c(xb[0] * wa[0], xb[1] * wa[1]), pk2c(xb[2] * wa[2], xb[3] * wa[3]), pk2c(xb[4] * wb[0], xb[5] * wb[1]), pk2c(xb[6] * wb[2], xb[7] * wb[3])};
                } else if (lc0 < 384) { const int n = lc0 - 256;
                    *(LAS v4u*)(BT + n * SD_XSTR + t0 * 2) = pka; *(LAS v4u*)(BT + (n + 1) * SD_XSTR + t0 * 2) = pkb;
#pragma unroll
                    for (int i = 0; i < 8; ++i) *(LAS unsigned*)(BN + (t0 + i) * SD_NSTR + n * 2) = pk2c(xa[i], xb[i]);
                } else { const int n = lc0 - 384;
#pragma unroll
                    for (int i = 0; i < 8; ++i) *(LAS unsigned*)(CN + (t0 + i) * SD_NSTR + n * 2) = pk2c(xa[i], xb[i]);
                }
            }
        }
        if (ch + 1 < SEQ / 64) SSD_LOADS(m0 + 64, false);
        LBAR();
        {
#pragma unroll
            for (int rep = 0; rep < 2; ++rep) { const int ti = wave + 8 * rep;
                if (ti < 10) { const int S_ = ti < 4 ? 0 : (ti < 7 ? 1 : (ti < 9 ? 2 : 3)); const int L_ = ti < 4 ? ti : (ti < 7 ? ti - 3 : (ti < 9 ? ti - 5 : 3));
                    f32x4 z = {0.f, 0.f, 0.f, 0.f};
#pragma unroll
                    for (int ks = 0; ks < 4; ++ks) z = MFMA16(*(const LAS bf16x8*)(BN + (16 * S_ + i16) * SD_NSTR + quad * 16 + 64 * ks), *(const LAS bf16x8*)(CN + (16 * L_ + i16) * SD_NSTR + quad * 16 + 64 * ks), z);
#pragma unroll
                    for (int r = 0; r < 4; ++r) GS[(16 * S_ + 4 * quad + r) * 68 + 16 * L_ + i16] = z[r]; } }
        }
        LBAR();
        unsigned zg[4][4];
#pragma unroll
        for (int L = 0; L < 4; ++L)
#pragma unroll
            for (int r = 0; r < 4; ++r) zg[L][r] = GLD(unsigned, PROJ + (m0 + 16 * L + r) * PS_LD, (unsigned)(4 * quad * PS_LD + PC_SZ + 256 * g + chb0 + 2 * i16) * 2u);
        f32x4 yd[4][2];
#define PK4(x, y) mk8(pk2c((x)[0], (x)[1]), pk2c((x)[2], (x)[3]), pk2c((y)[0], (y)[1]), pk2c((y)[2], (y)[3]))
#define PK4Z(x) mk8(pk2c((x)[0], (x)[1]), pk2c((x)[2], (x)[3]), 0u, 0u)
        {
            const f32x4 zz = {0.f, 0.f, 0.f, 0.f};
#pragma unroll
            for (int L = 0; L < 4; ++L) { yd[L][0] = zz; yd[L][1] = zz; }
#pragma unroll
            for (int ks = 0; ks < 4; ++ks) { __builtin_amdgcn_sched_barrier(0); const bf16x8 hB0 = PK4(H[2 * ks][0], H[2 * ks + 1][0]), hB1 = PK4(H[2 * ks][1], H[2 * ks + 1][1]);
#pragma unroll
                for (int L = 0; L < 4; ++L) { const LAS unsigned char* cr = CN + (16 * L + i16) * SD_NSTR + (32 * ks + 4 * quad) * 2;
                    const bf16x8 ca = mk8(*(const LAS u32x2*)cr, *(const LAS u32x2*)(cr + 32));
                    yd[L][0] = MFMA16(ca, hB0, yd[L][0]); yd[L][1] = MFMA16(ca, hB1, yd[L][1]); } }
#pragma unroll
            for (int L = 0; L < 4; ++L) { const f32x4 ea = *(const LAS f32x4*)(SEA + hl * 64 + 16 * L + 4 * quad); yd[L][0] *= ea; yd[L][1] *= ea; }
        }
        __builtin_amdgcn_sched_barrier(0);
        {
            bf16x8 xB01[2], xB23[2];
#pragma unroll
            for (int pt = 0; pt < 2; ++pt) { const LAS unsigned char* xr = XT + (chb0 + 2 * i16 + pt) * SD_XSTR;
                xB01[pt] = mk8(*(const LAS u32x2*)(xr + (0 + 4 * quad) * 2), *(const LAS u32x2*)(xr + (16 + 4 * quad) * 2));
                xB23[pt] = mk8(*(const LAS u32x2*)(xr + (32 + 4 * quad) * 2), *(const LAS u32x2*)(xr + (48 + 4 * quad) * 2)); }
#pragma unroll
            for (int L = 0; L < 4; ++L) { __builtin_amdgcn_sched_barrier(0); const float acs_l = SACS[hl * 64 + 16 * L + i16];
                f32x4 mt[4];
#pragma unroll
                for (int S_ = 0; S_ <= L; ++S_) { const f32x4 acs_s = *(const LAS f32x4*)(SACS + hl * 64 + 16 * S_ + 4 * quad), dt_s = *(const LAS f32x4*)(SDT + hl * 64 + 16 * S_ + 4 * quad);
#pragma unroll
                    for (int r = 0; r < 4; ++r) { const float gv = GS[(16 * S_ + 4 * quad + r) * 68 + 16 * L + i16]; const float v = gv * __expf(acs_l - acs_s[r]) * dt_s[r];
                        mt[S_][r] = (S_ < L || 4 * quad + r <= i16) ? v : 0.f; } }
#pragma unroll
                for (int pt = 0; pt < 2; ++pt) {
                    if (L == 0) yd[L][pt] = MFMA16(PK4Z(mt[0]), xB01[pt], yd[L][pt]);
                    else if (L == 1) yd[L][pt] = MFMA16(PK4(mt[0], mt[1]), xB01[pt], yd[L][pt]);
                    else if (L == 2) { yd[L][pt] = MFMA16(PK4(mt[0], mt[1]), xB01[pt], yd[L][pt]); yd[L][pt] = MFMA16(PK4Z(mt[2]), xB23[pt], yd[L][pt]); }
                    else { yd[L][pt] = MFMA16(PK4(mt[0], mt[1]), xB01[pt], yd[L][pt]); yd[L][pt] = MFMA16(PK4(mt[2], mt[3]), xB23[pt], yd[L][pt]); } } }
        }
        __builtin_amdgcn_sched_barrier(0);
        {
            const float eal = EAL[hl];
            bf16x8 xw[2][2];
#pragma unroll
            for (int pt = 0; pt < 2; ++pt)
#pragma unroll
                for (int k2 = 0; k2 < 2; ++k2) xw[pt][k2] = *(const LAS bf16x8*)(XW + (chb0 + 2 * i16 + pt) * SD_XSTR + quad * 16 + 64 * k2);
#pragma unroll
            for (int nt = 0; nt < 8; ++nt) { if ((nt & 1) == 0) __builtin_amdgcn_sched_barrier(0); const LAS unsigned char* br = BT + (16 * nt + i16) * SD_XSTR + quad * 16;
                const bf16x8 b0 = *(const LAS bf16x8*)br, b1 = *(const LAS bf16x8*)(br + 64);
#pragma unroll
                for (int pt = 0; pt < 2; ++pt) { f32x4 z = H[nt][pt] * eal; z = MFMA16(b0, xw[pt][0], z); H[nt][pt] = MFMA16(b1, xw[pt][1], z); } }
        }
        __builtin_amdgcn_sched_barrier(0);
        const float Dk = par[PG_DSK + 4 * g + hl]; const f32x2s onv = *(const GAS f32x2s*)(par + PG_SON + 256 * g + chb0 + 2 * i16); const float on0 = onv.x, on1 = onv.y;
#pragma unroll
        for (int L = 0; L < 4; ++L) { f32x4 q = {0.f, 0.f, 0.f, 0.f};
#pragma unroll
            for (int pt = 0; pt < 2; ++pt) { const u32x2 xw2 = *(const LAS u32x2*)(XT + (chb0 + 2 * i16 + pt) * SD_XSTR + (16 * L + 4 * quad) * 2);
                const float xv[4] = {pg8::bf_lo(xw2.x), pg8::bf_hi(xw2.x), pg8::bf_lo(xw2.y), pg8::bf_hi(xw2.y)};
#pragma unroll
                for (int r = 0; r < 4; ++r) { const float y = yd[L][pt][r] + Dk * xv[r]; const float u = y * siluf(pt ? pg8::bf_hi(zg[L][r]) : pg8::bf_lo(zg[L][r])); yd[L][pt][r] = u; q[r] += u * u; } }
#pragma unroll
            for (int r = 0; r < 4; ++r) q[r] = row16_sum(q[r]);
            if (i16 == 0) *(LAS f32x4*)(PART + wave * 64 + 16 * L + 4 * quad) = q; }
        LBAR();
#pragma unroll
        for (int L = 0; L < 4; ++L) { f32x4 tot4 = {0.f, 0.f, 0.f, 0.f};
#pragma unroll
            for (int w = 0; w < 8; ++w) tot4 += *(const LAS f32x4*)(PART + w * 64 + 16 * L + 4 * quad);
#pragma unroll
            for (int r = 0; r < 4; ++r) { const float rs = rsqf(tot4[r] * (1.f / 256.f) + EPS); GST(unsigned, YC + (m0 + 16 * L + r) * 512, (unsigned)(4 * quad * 512 + 256 * g + chb0 + 2 * i16) * 2u) = pk2c(yd[L][0][r] * rs * on0, yd[L][1][r] * rs * on1); } }
    }
    LBAR();
#undef PK4
#undef PK4Z
#undef SSD_LOADS
#undef SSD_CIDX
}


struct MgOrder {
    int xcd, nloc, first, stride;
    __device__ __forceinline__ void init(int bx) { xcd = bx & 7; if (bx < 64) { nloc = 9; first = 312 + (bx >> 3); stride = 8; } else { nloc = 13; first = (bx - 64) >> 3; stride = 24; } }
    __device__ __forceinline__ bool next(int i, pg8::Unit& u) const { if (i >= nloc) return false; const int off = first + i * stride, grp = off / 96, w = off % 96; u.pm = (xcd * 4 + grp) * 8 + (w & 7); u.pn = w >> 3; return true; }
    __device__ __forceinline__ void a_ready(const pg8::Unit&) const {}
    __device__ __forceinline__ void done(const pg8::Unit&) const {}
};

struct Merge3Order {
    pg8::StaticOrder S;
    __device__ __forceinline__ bool next(int i, pg8::Unit& u) const { const int j = i / 3, br = i - 3 * j; const int R = S.nwg / S.G; if (!S.next((S.nwg == R * S.G && j < R) ? R - 1 - j : j, u)) return false;
        u.pm += br * 256; u.pn += br * 4; return true; }
    __device__ __forceinline__ void a_ready(const pg8::Unit&) const {}
    __device__ __forceinline__ void done(const pg8::Unit&) const {}
};

__global__ void __launch_bounds__(NTHR, 2) mega_fwd(Args args) {
    extern __shared__ __attribute__((aligned(16))) unsigned char lds_raw[];
    LAS unsigned char* lds = (LAS unsigned char*)lds_raw;
    volatile LAS unsigned* MISC = (volatile LAS unsigned*)(lds + MISC_OFF);
    const int tid = threadIdx.x, lane = tid & 63, wave = __builtin_amdgcn_readfirstlane(tid >> 6);
    const int G = gridDim.x, bx = blockIdx.x;
    unsigned char* ws = args.ws;
    gu32* ctl = (gu32*)(ws + WS_CTL);
    const float* x_in = (const float*)args.in[0];
    float* out = args.out;

    for (int u = tid; u < (LDS_BYTES - LDSCTL_OFF) / 4; u += NTHR) ((LAS unsigned*)(lds + LDSCTL_OFF))[u] = 0u;
    __syncthreads();
    XcdBarrier bar = xcd_barrier_post((unsigned*)(ctl + CW_BAR) + args.li * XCD_BAR_WORDS, MISC + 8);
    const int lo = args.ph_lo, hi = args.ph_hi; (void)lo; (void)hi;
#define IN(k) (lo <= (k) && (k) < hi)
#define OWS() ({ unsigned char* w_ = ws; asm volatile("" : "+s"(w_)); w_; })
#define WIN ((bf16*)(OWS() + WS_WIN))
#define WB ((bf16*)(OWS() + WS_WB))
#define WO ((bf16*)(OWS() + WS_WO))
#define XN ((bf16*)(OWS() + WS_XN))
#define Y ((bf16*)(OWS() + WS_Y))
#define PA ((bf16*)(OWS() + WS_PA))
#define PG ((bf16*)(OWS() + WS_PG))
#define PS ((bf16*)(OWS() + WS_PS))
#define PX ((bf16*)(OWS() + WS_PX))
#define MG ((bf16*)(OWS() + WS_MG))
#define MERGED ((bf16*)(OWS() + WS_MERGED))
#define CS ((float2*)(OWS() + WS_CS))
#define KR ((float*)(OWS() + WS_KR))
#define PAR ((float*)(OWS() + WS_PAR))
#define otid() ({ int t_ = tid; asm volatile("" : "+v"(t_)); t_; })
#define SEAM(k) do { if (IN(k) && IN((k) + 1)) xcd_barrier(bar); } while (0)
    const int gw = bx * NWAVES + wave, NGW = G * NWAVES;

    if (IN(0)) {
        LAS float* scr = (LAS float*)(lds + RING_OFF + wave * 16384);
        constexpr int I_IN = (D / 64) * (NINP / 32), I_B = (512 / 64) * (D / 32), I_O = (D / 64) * (D / 32);
        constexpr int NITEMS = DEPTH * (I_IN + 3 * I_B + I_O);
        for (int it = gw; it < NITEMS; it += NGW) {
            int r = it; const int l = r / (I_IN + 3 * I_B + I_O); r -= l * (I_IN + 3 * I_B + I_O);
            if (r < I_IN) { transpose_item<true>((const float*)args.in[3] + (size_t)l * D * NIN, D, NIN, WIN + (size_t)l * NINP * D, scr, r, NINP / 32, lane, l > 0 ? (const float*)args.in[2] + (size_t)l * D : nullptr); continue; } r -= I_IN;
            if (r < 3 * I_B) { const int n = r / I_B; r -= n * I_B;
                transpose_item<false>((const float*)args.in[16] + (size_t)(l * 3 + n) * 512 * D, 512, D, WB + (size_t)(l * 3 + n) * D * 512, scr, r, D / 32, lane); continue; } r -= 3 * I_B;
            transpose_item<false>((const float*)args.in[17] + (size_t)l * D * D, D, D, WO + (size_t)l * D * D, scr, r, D / 32, lane);
        }
        for (int m = 2 * gw; m < M; m += 2 * NGW) rms_rows2_to_bf16(x_in + (size_t)m * D, x_in + (size_t)(m + 1) * D, (const float*)args.in[2], XN + (size_t)m * D, XN + (size_t)(m + 1) * D, lane);
        for (int e = bx * NTHR + tid; e < M * 32; e += G * NTHR) { const int m = e >> 5, i = e & 31;
            const float inv = exp2f(-(float)(2 * i) * (13.287712379549449f / 64.f)); const float ang = (float)((const int*)args.in[1])[m] * inv; const float rev = ang * 0.15915494309189535f; const float fr = rev - floorf(rev);
            *(GAS f32x2s*)(CS + e) = (f32x2s){__builtin_amdgcn_cosf(fr), __builtin_amdgcn_sinf(fr)}; }
        {
            const int gt = bx * NTHR + tid, GT = G * NTHR;
#define CPY(idx, off, n) for (int e = gt; e < DEPTH * (n); e += GT) *(GAS float*)(PAR + (e / (n)) * PSTRIDE + (off) + e % (n)) = ((const GAS float*)args.in[idx])[e]
            CPY(2, PG_NORM, 1024); CPY(4, PG_QN, 64); CPY(5, PG_KN, 64); CPY(6, PG_SINK, 8); CPY(7, PG_GWG, 4096); CPY(8, PG_GBG, 256); CPY(9, PG_GON, 128);
            CPY(10, PG_CW, 4096); CPY(11, PG_CB, 1024); CPY(12, PG_DTB, 8); CPY(13, PG_ALOG, 8); CPY(14, PG_DSK, 8); CPY(15, PG_SON, 512);
#undef CPY
        }
    }
    SEAM(0);

    for (int l = 0; l < DEPTH; ++l) {
        const int pb = 1 + 7 * l;
        const float* xin = l == 0 ? x_in : out;
        const float* par = PAR + l * PSTRIDE;
        if (IN(pb + 0)) {
            pg8::Gemm g{XN, WIN + (size_t)l * NINP * D, M, NMAIN, D}; pg8::StaticOrder S; S.init(M, NMAIN, G, bx);
            pg8::EpiProj E{PA, PG, PS, PX, l > 0 ? (const float*)(OWS() + WS_RINV) : nullptr};
            pg8::gemm_phase<pg8::EpiProj, pg8::StaticOrder, true, true>(lds + RING_OFF, g, S, E, otid());
        }
        SEAM(pb + 0);
        if (IN(pb + 2)) {
            for (int uu = bx; uu < 192; uu += G) {
            if (uu < 64) ssd_unit(uu, PS, PX, par, Y + (size_t)2 * M * 512, lds, otid());
            else { gla_unit(uu - 64, PG, PX, par, Y + (size_t)1 * M * 512, lds, otid()); if (otid() == 0) __hip_atomic_fetch_add((unsigned*)(ctl + CW_DONE + 64 * l), 1u, __ATOMIC_RELAXED, __HIP_MEMORY_SCOPE_AGENT); }
            }
            unsigned qn = 0; if (otid() == 0) qn = __hip_atomic_fetch_add((unsigned*)(ctl + CW_Q + 64 * l), 1u, __ATOMIC_RELAXED, __HIP_MEMORY_SCOPE_AGENT);
            for (;;) {
                __syncthreads();
                if (otid() == 0) MISC[0] = qn;
                __syncthreads();
                const unsigned item = (unsigned)__builtin_amdgcn_readfirstlane((int)MISC[0]);
                if (item >= 1024u) break;
                if (otid() == 0) qn = __hip_atomic_fetch_add((unsigned*)(ctl + CW_Q + 64 * l), 1u, __ATOMIC_RELAXED, __HIP_MEMORY_SCOPE_AGENT);
                attn_unit((int)item, PA, CS, par, Y, lds, otid());
                if (otid() == 0) __hip_atomic_fetch_add((unsigned*)(ctl + CW_DONE + 64 * l), 1u, __ATOMIC_RELAXED, __HIP_MEMORY_SCOPE_AGENT);
            }
        }
        const bool ovl = (G == 256) && IN(pb + 2) && IN(pb + 3);
        if (!ovl) SEAM(pb + 2);
        if (IN(pb + 3)) {
            pg8::Gemm g{XN, WIN + (size_t)l * NINP * D + (size_t)NMAIN * D, M, NMG, D};
            pg8::EpiGate E{MG, NMG, l > 0 ? (const float*)(OWS() + WS_RINV) : nullptr};
            if (ovl) {
                if (otid() == 0) { unsigned sp_ = 0; while (__hip_atomic_load((unsigned*)(ctl + CW_DONE + 64 * l), __ATOMIC_RELAXED, __HIP_MEMORY_SCOPE_AGENT) < (unsigned)N_AG_UNITS) { __builtin_amdgcn_s_sleep(8);
                        if (++sp_ > (1u << 22)) { __hip_atomic_store((unsigned*)(ctl + CW_TMO), 1u, __ATOMIC_RELAXED, __HIP_MEMORY_SCOPE_AGENT); break; } } }
                __syncthreads();
                MgOrder S; S.init(bx);
                pg8::gemm_phase<pg8::EpiGate, MgOrder, true, true>(lds + RING_OFF, g, S, E, otid());
            } else {
                pg8::StaticOrder S; S.init(M, NMG, G, bx);
                pg8::gemm_phase<pg8::EpiGate, pg8::StaticOrder, true, true>(lds + RING_OFF, g, S, E, otid());
            }
        }
        SEAM(pb + 3);
        if (IN(pb + 4)) {
            pg8::Gemm g{Y, WB + (size_t)(l * 3) * D * 512, M, D, 512}; Merge3Order S; S.S.init(M, D, G, bx);
            pg8::EpiMerge3 E{MG, MERGED};
            pg8::gemm_phase<pg8::EpiMerge3, Merge3Order, true, true>(lds + RING_OFF, g, S, E, otid());
        }
        SEAM(pb + 4);
        if (IN(pb + 5)) {
            pg8::Gemm g{MERGED, WO + (size_t)l * D * D, M, D, D}; pg8::StaticOrder S; S.init(M, D, G, bx);
            if (l + 1 < DEPTH) { pg8::EpiResidA E{xin, XN, (float*)(OWS() + WS_RPART)}; pg8::gemm_phase<pg8::EpiResidA, pg8::StaticOrder, true, true>(lds + RING_OFF, g, S, E, otid()); }
            else { pg8::EpiResidB E{XN, out}; pg8::gemm_phase<pg8::EpiResidB, pg8::StaticOrder, true, true>(lds + RING_OFF, g, S, E, otid()); }
        }
        SEAM(pb + 5);
        if (l + 1 < DEPTH) {
            if (IN(pb + 6)) { const float* rp = (const float*)(OWS() + WS_RPART); float* ri = (float*)(OWS() + WS_RINV);
                for (int r_ = bx * NTHR + otid(); r_ < M; r_ += G * NTHR) { const f32x4 a0 = GLD(f32x4, rp, (unsigned)r_ * 64u), a1 = GLD(f32x4, rp, (unsigned)r_ * 64u + 16u), a2 = GLD(f32x4, rp, (unsigned)r_ * 64u + 32u), a3 = GLD(f32x4, rp, (unsigned)r_ * 64u + 48u);
                    const f32x4 s4 = (a0 + a1) + (a2 + a3); *(GAS float*)(ri + r_) = rsqf(((s4[0] + s4[1]) + (s4[2] + s4[3])) * (1.f / D) + EPS); } }
            SEAM(pb + 6);
        }
    }
#undef IN
#undef WIN
#undef WB
#undef WO
#undef XN
#undef Y
#undef PA
#undef PG
#undef PS
#undef PX
#undef MG
#undef MERGED
#undef CS
#undef KR
#undef PAR
#undef SEAM
}

#ifndef MK_SPLIT
#define MK_SPLIT 1
#endif
extern "C" void kernel_launch(void* const* d_in, const int* in_sizes, int n_in, void* d_out, int out_size, void* d_ws, size_t ws_size, hipStream_t stream) {
    static int grid = 0;
    if (grid == 0) {
        if (n_in != 18 || in_sizes[0] != M * D || out_size != M * D || ws_size < WS_END) { fprintf(stderr, "kernel_launch: unexpected shapes/ws (n_in %d, ws %zu)\n", n_in, ws_size); grid = -1; return; }
        int dev = 0, cus = 0, per_cu = 0;
        if (hipGetDevice(&dev) != hipSuccess || hipDeviceGetAttribute(&cus, hipDeviceAttributeMultiprocessorCount, dev) != hipSuccess) { grid = -1; return; }
        if (hipFuncSetAttribute((const void*)mega_fwd, hipFuncAttributeMaxDynamicSharedMemorySize, LDS_BYTES) != hipSuccess) { grid = -1; return; }
        if (hipOccupancyMaxActiveBlocksPerMultiprocessor(&per_cu, (const void*)mega_fwd, NTHR, LDS_BYTES) != hipSuccess || per_cu < 1) { fprintf(stderr, "kernel_launch: occupancy query says %d\n", per_cu); }
        (void)hipGetLastError();
        grid = cus;
    }
    if (grid < 0) return;
    if (hipMemsetAsync((char*)d_ws + WS_CTL, 0, CTL_ZERO_BYTES, stream) != hipSuccess) return;
    Args a{};
    for (int i = 0; i < 18; ++i) a.in[i] = d_in[i];
    a.out = (float*)d_out; a.ws = (unsigned char*)d_ws;
#if MK_SPLIT
    int li = 0;
    for (int ph = 0; ph < NPHASE; ++ph) {
        a.ph_lo = ph; a.ph_hi = ph + 1; a.li = li++; a.pad = 0;
        hipLaunchKernelGGL(mega_fwd, dim3(grid), dim3(NTHR), LDS_BYTES, stream, a); }
#else
    a.ph_lo = 0; a.ph_hi = NPHASE; a.li = 0; a.pad = 0;
    hipLaunchKernelGGL(mega_fwd, dim3(grid), dim3(NTHR), LDS_BYTES, stream, a);
#endif
}
```

```cpp
#include <hip/hip_runtime.h>
#include <cstdio>
#include <cstdint>
#define MK_SPLIT 0
namespace pg8 {
#define PG8_LAS __attribute__((address_space(3)))
typedef unsigned short bf16_t;
typedef short bf16x8 __attribute__((ext_vector_type(8)));
typedef float f32x4 __attribute__((ext_vector_type(4)));
typedef unsigned u32x4 __attribute__((ext_vector_type(4)));
constexpr int BM = 256, BK = 64, HALF = 128, HTB = HALF * BK * 2  , STAGE_BYTES = 8 * HTB, NXCD = 8, WGM = 8;

__host__ __device__ __forceinline__ int lds_byte(int r, int c) { const int st = (r >> 4) * 2 + (c >> 5), rr = r & 15, cc = c & 31, ob = rr * 64 + cc * 2; return st * 1024 + (ob ^ (((ob >> 9) & 1) << 5)); }
__host__ __device__ __forceinline__ void stage_rc(int b, int& R, int& C) { const int st = b / 1024, sb = b % 1024, swz = sb ^ (((sb >> 9) & 1) << 5); R = (st >> 1) * 16 + swz / 64; C = (st & 1) * 32 + (swz % 64) / 2; }
__host__ __device__ __forceinline__ int perm32(int rho) { const int n = rho >> 4, i = rho & 15; return 8 * (i >> 2) + 4 * n + (i & 3); }

struct Unit { int pm, pn; };
struct Gemm { const bf16_t* A; const bf16_t* Bt; int M, N, K; };

struct StaticOrder {
    int nM, nN, nwg, G, c;
    __host__ __device__ void init(int M, int N, int G_, int c_) { nM = M / BM; nN = N / BM; nwg = nM * nN; G = G_; c = c_; }
    __host__ __device__ bool next(int i, Unit& u) const {
        const long L = (long)i * G + c; if (L >= nwg) return false;
        int wgid = (int)L; { const int q = nwg / NXCD, r = nwg % NXCD, xcd = wgid % NXCD, off = wgid / NXCD; wgid = (xcd < r ? xcd * (q + 1) : r * (q + 1) + (xcd - r) * q) + off; }
        const int nig = WGM * nN, gid = wgid / nig, fm = gid * WGM, gsz = (nM - fm) < WGM ? (nM - fm) : WGM;
        u.pm = fm + ((wgid % nig) % gsz); u.pn = (wgid % nig) / gsz; return true;
    }
    __device__ __forceinline__ void a_ready(const Unit&) const {}
    __device__ __forceinline__ void done(const Unit&) const {}
};

typedef float f32x2c __attribute__((ext_vector_type(2))); typedef __bf16 bf16x2c __attribute__((ext_vector_type(2)));
__device__ __forceinline__ unsigned cvt_pk_bf16(float lo, float hi) { const f32x2c v = {lo, hi}; const bf16x2c b = __builtin_convertvector(v, bf16x2c); return __builtin_bit_cast(unsigned, b); }
typedef float f32x2 __attribute__((ext_vector_type(2)));

#define PG8_GAS __attribute__((address_space(1)))
template <class T> __device__ __forceinline__ T gld_(const void* p) { return *(const PG8_GAS T*)p; }
template <class T> __device__ __forceinline__ void gst_(void* p, T v) { *(PG8_GAS T*)p = v; }
__device__ __forceinline__ float sigmoid_fast(float x) { return __builtin_amdgcn_rcpf(1.f + __builtin_amdgcn_exp2f(-1.44269504f * x)); }
__device__ __forceinline__ float bf_lo(unsigned w) { return __builtin_bit_cast(float, w << 16); }
__device__ __forceinline__ float bf_hi(unsigned w) { return __builtin_bit_cast(float, w & 0xffff0000u); }

__device__ __forceinline__ float xrow_sum_e(float x) { unsigned a = __builtin_bit_cast(unsigned, x), b = a; asm volatile("s_nop 1\n\tv_permlane16_swap_b32 %0, %1" : "+v"(a), "+v"(b));
    const float y = __builtin_bit_cast(float, a) + __builtin_bit_cast(float, b); unsigned c = __builtin_bit_cast(unsigned, y), d = c; asm volatile("s_nop 1\n\tv_permlane32_swap_b32 %0, %1" : "+v"(c), "+v"(d));
    return __builtin_bit_cast(float, c) + __builtin_bit_cast(float, d); }
template <int ACT> struct EpiBf16 {
    static constexpr bool PERM = true, AFTER_DRAIN = false, CHAIN = false, PRE = false;
    bf16_t* O; int ldc; const float* rinv;
    __device__ __forceinline__ void operator()(const f32x4 (&acc)[2][2][4][2], const Unit& u, int wr, int wc, int fr, int fq) const {
        const int row0 = u.pm * BM + wr * 64 + fr; const int col0 = u.pn * BM + wc * 32 + 8 * fq;
        float rs[2][4];
#pragma unroll
        for (int ai = 0; ai < 2; ++ai)
#pragma unroll
            for (int m = 0; m < 4; ++m) rs[ai][m] = rinv ? gld_<float>(rinv + row0 + ai * HALF + m * 16) : 1.f;
#pragma unroll
        for (int ai = 0; ai < 2; ++ai)
#pragma unroll
            for (int m = 0; m < 4; ++m) { bf16_t* rowp = O + (size_t)(row0 + ai * HALF + m * 16) * ldc + col0;
#pragma unroll
                for (int bj = 0; bj < 2; ++bj) { f32x4 v0 = acc[ai][bj][m][0] * rs[ai][m], v1 = acc[ai][bj][m][1] * rs[ai][m];
                    if (ACT == 1) {
#pragma unroll
                        for (int j = 0; j < 4; ++j) { v0[j] = __builtin_amdgcn_rcpf(1.f + __builtin_amdgcn_exp2f(fminf(v0[j], 60.f))); v1[j] = __builtin_amdgcn_rcpf(1.f + __builtin_amdgcn_exp2f(fminf(v1[j], 60.f))); } }
                    u32x4 w; w.x = cvt_pk_bf16(v0[0], v0[1]); w.y = cvt_pk_bf16(v0[2], v0[3]); w.z = cvt_pk_bf16(v1[0], v1[1]); w.w = cvt_pk_bf16(v1[2], v1[3]);
                    gst_<u32x4>(rowp + bj * HALF, w); } }
    }
};
struct EpiGate {
    static constexpr bool PERM = true, AFTER_DRAIN = false, CHAIN = false, PRE = true;
    bf16_t* O; int ldc; const float* rinv;
    __device__ __forceinline__ void pre(const Unit& u, int wr, int fr, PG8_LAS unsigned char* slot) const {
        if (!rinv) return;
        int f_ = fr; asm volatile("" : "+v"(f_));
        const int row0 = u.pm * BM + wr * 64 + f_;
#pragma unroll
        for (int k = 0; k < 8; ++k) __builtin_amdgcn_global_load_lds((const PG8_GAS unsigned*)(rinv + row0 + (k >> 2) * HALF + (k & 3) * 16), (PG8_LAS unsigned*)(slot + k * 256), 4, 0, 0);
    }
    __device__ __forceinline__ void operator()(const f32x4 (&acc)[2][2][4][2], const Unit& u, int wr, int wc, int fr, int fq, const PG8_LAS unsigned char* slot) const {
        float rs[2][4];
        if (rinv) { asm volatile("s_waitcnt vmcnt(0)" ::: "memory");
#pragma unroll
            for (int k = 0; k < 8; ++k) rs[k >> 2][k & 3] = *(const PG8_LAS float*)(slot + k * 256 + (fr + 16 * fq) * 4); }
        else {
#pragma unroll
            for (int k = 0; k < 8; ++k) rs[k >> 2][k & 3] = 1.f; }
        const int row0 = u.pm * BM + wr * 64 + fr;
        if (u.pn < 8) {
            const int colq = u.pn * HALF + wc * 32 + 8 * fq;
#pragma unroll
            for (int ai = 0; ai < 2; ++ai)
#pragma unroll
                for (int m = 0; m < 4; ++m) { bf16_t* rowp = O + (size_t)(row0 + ai * HALF + m * 16) * ldc + colq;
                    float r[8], g[8];
#pragma unroll
                    for (int n = 0; n < 2; ++n)
#pragma unroll
                        for (int j = 0; j < 4; ++j) { const float d0 = 1.f + __builtin_amdgcn_exp2f(fminf(acc[ai][0][m][n][j] * rs[ai][m], 60.f)), d1 = 1.f + __builtin_amdgcn_exp2f(fminf(acc[ai][1][m][n][j] * rs[ai][m], 60.f));
                            g[4 * n + j] = __builtin_amdgcn_rcpf(d1); r[4 * n + j] = d1 * __builtin_amdgcn_rcpf(d0); }
                    u32x4 w; w.x = cvt_pk_bf16(r[0], r[1]); w.y = cvt_pk_bf16(r[2], r[3]); w.z = cvt_pk_bf16(r[4], r[5]); w.w = cvt_pk_bf16(r[6], r[7]);
                    gst_<u32x4>(rowp, w);
                    w.x = cvt_pk_bf16(g[0], g[1]); w.y = cvt_pk_bf16(g[2], g[3]); w.z = cvt_pk_bf16(g[4], g[5]); w.w = cvt_pk_bf16(g[6], g[7]);
                    gst_<u32x4>(rowp + 1024, w); }
        } else {
            const int col0 = u.pn * BM + wc * 32 + 8 * fq;
#pragma unroll
            for (int ai = 0; ai < 2; ++ai)
#pragma unroll
                for (int m = 0; m < 4; ++m) { bf16_t* rowp = O + (size_t)(row0 + ai * HALF + m * 16) * ldc + col0;
#pragma unroll
                    for (int bj = 0; bj < 2; ++bj) { f32x4 v0 = acc[ai][bj][m][0] * rs[ai][m], v1 = acc[ai][bj][m][1] * rs[ai][m];
#pragma unroll
                        for (int j = 0; j < 4; ++j) { v0[j] = __builtin_amdgcn_rcpf(1.f + __builtin_amdgcn_exp2f(fminf(v0[j], 60.f))); v1[j] = __builtin_amdgcn_rcpf(1.f + __builtin_amdgcn_exp2f(fminf(v1[j], 60.f))); }
                        u32x4 w; w.x = cvt_pk_bf16(v0[0], v0[1]); w.y = cvt_pk_bf16(v0[2], v0[3]); w.z = cvt_pk_bf16(v1[0], v1[1]); w.w = cvt_pk_bf16(v1[2], v1[3]);
                        gst_<u32x4>(rowp + bj * HALF, w); } }
        }
    }
};
struct EpiProj {
    static constexpr bool PERM = true, AFTER_DRAIN = false, CHAIN = false, PRE = true;
    bf16_t *pa, *pg, *ps, *px; const float* rinv;
    __device__ __forceinline__ void pre(const Unit& u, int wr, int fr, PG8_LAS unsigned char* slot) const {
        if (!rinv) return;
        int f_ = fr; asm volatile("" : "+v"(f_));
        const int row0 = u.pm * BM + wr * 64 + f_;
#pragma unroll
        for (int k = 0; k < 8; ++k) __builtin_amdgcn_global_load_lds((const PG8_GAS unsigned*)(rinv + row0 + (k >> 2) * HALF + (k & 3) * 16), (PG8_LAS unsigned*)(slot + k * 256), 4, 0, 0);
    }
    __device__ __forceinline__ void operator()(const f32x4 (&acc)[2][2][4][2], const Unit& u, int wr, int wc, int fr, int fq, const PG8_LAS unsigned char* slot) const {
        float rs[2][4];
        if (rinv) { asm volatile("s_waitcnt vmcnt(0)" ::: "memory");
#pragma unroll
            for (int k = 0; k < 8; ++k) rs[k >> 2][k & 3] = *(const PG8_LAS float*)(slot + k * 256 + (fr + 16 * fq) * 4); }
        else {
#pragma unroll
            for (int k = 0; k < 8; ++k) rs[k >> 2][k & 3] = 1.f; }
        bf16_t* O; int ldc, ct;
        if (u.pn < 5) { O = pa; ldc = 1280; ct = u.pn; } else if (u.pn < 11) { O = pg; ldc = 1536; ct = u.pn - 5; } else if (u.pn < 17) { O = ps; ldc = 1536; ct = u.pn - 11; } else { O = px; ldc = 32; ct = 0; }
        const int row0 = u.pm * BM + wr * 64 + fr; const int col0 = ct * BM + wc * 32 + 8 * fq;
#pragma unroll
        for (int ai = 0; ai < 2; ++ai)
#pragma unroll
            for (int m = 0; m < 4; ++m) { bf16_t* rowp = O + (size_t)(row0 + ai * HALF + m * 16) * ldc + col0;
#pragma unroll
                for (int bj = 0; bj < 2; ++bj) { const f32x4 v0 = acc[ai][bj][m][0] * rs[ai][m], v1 = acc[ai][bj][m][1] * rs[ai][m];
                    u32x4 w; w.x = cvt_pk_bf16(v0[0], v0[1]); w.y = cvt_pk_bf16(v0[2], v0[3]); w.z = cvt_pk_bf16(v1[0], v1[1]); w.w = cvt_pk_bf16(v1[2], v1[3]);
                    if (u.pn < 17 || (bj == 0 && wc == 0)) gst_<u32x4>(rowp + bj * HALF, w); } }
    }
};
struct EpiMerge {
    static constexpr bool PERM = true, AFTER_DRAIN = false, CHAIN = false, PRE = false;
    const bf16_t* Gt; int ldg; bf16_t* Mg; int ldm; int first;
    __device__ __forceinline__ void operator()(const f32x4 (&acc)[2][2][4][2], const Unit& u, int wr, int wc, int fr, int fq) const {
        const int row0 = u.pm * BM + wr * 64 + fr; const int col0 = u.pn * BM + wc * 32 + 8 * fq;
#pragma unroll
        for (int ai = 0; ai < 2; ++ai) {
            u32x4 g[4][2], p[4][2];
#pragma unroll
            for (int m = 0; m < 4; ++m) { const size_t row = (size_t)(row0 + ai * HALF + m * 16);
#pragma unroll
                for (int bj = 0; bj < 2; ++bj) { g[m][bj] = gld_<u32x4>(Gt + row * ldg + col0 + bj * HALF);
                    p[m][bj] = (u32x4){0u, 0u, 0u, 0u}; if (!first) p[m][bj] = gld_<u32x4>(Mg + row * ldm + col0 + bj * HALF); } }
#pragma unroll
            for (int m = 0; m < 4; ++m) { const size_t row = (size_t)(row0 + ai * HALF + m * 16);
#pragma unroll
                for (int bj = 0; bj < 2; ++bj) { const f32x4 a0 = acc[ai][bj][m][0], a1 = acc[ai][bj][m][1]; const u32x4 gg = g[m][bj], pp = p[m][bj];
                    u32x4 w;
                    w.x = cvt_pk_bf16(bf_lo(pp.x) + bf_lo(gg.x) * a0[0], bf_hi(pp.x) + bf_hi(gg.x) * a0[1]);
                    w.y = cvt_pk_bf16(bf_lo(pp.y) + bf_lo(gg.y) * a0[2], bf_hi(pp.y) + bf_hi(gg.y) * a0[3]);
                    w.z = cvt_pk_bf16(bf_lo(pp.z) + bf_lo(gg.z) * a1[0], bf_hi(pp.z) + bf_hi(gg.z) * a1[1]);
                    w.w = cvt_pk_bf16(bf_lo(pp.w) + bf_lo(gg.w) * a1[2], bf_hi(pp.w) + bf_hi(gg.w) * a1[3]);
                    gst_<u32x4>(Mg + row * ldm + col0 + bj * HALF, w); } }
        }
    }
};
struct EpiMerge3 {
    static constexpr bool PERM = true, AFTER_DRAIN = false, CHAIN = true, PRE = false;
    static constexpr int LDG = 3072, LDM = 1024;
    const bf16_t* Gt; bf16_t* Mg;
    template <class T> static __device__ __forceinline__ T ldo(const bf16_t* base, int cdisp, unsigned off) { return *(const PG8_GAS T*)((const PG8_GAS unsigned char*)(base + cdisp) + (size_t)off); }
    template <int BR> __device__ __forceinline__ void run(f32x4 (&acc)[2][2][4][2], const Unit& u, int wr, int wc, int fr, int fq) const {
        const int row0 = (u.pm & 255) * BM + wr * 64 + fr; const int col0 = (u.pn & 3) * BM + wc * 32 + 8 * fq;
        const unsigned og = ((unsigned)row0 * LDG + col0) * 2u, om = ((unsigned)row0 * LDM + col0) * 2u;
        if constexpr (BR == 0) {
            u32x4 a[2][4][2];
#pragma unroll
            for (int ai = 0; ai < 2; ++ai)
#pragma unroll
                for (int m = 0; m < 4; ++m)
#pragma unroll
                    for (int bj = 0; bj < 2; ++bj) a[ai][m][bj] = ldo<u32x4>(Gt, (ai * HALF + m * 16) * LDG + bj * HALF, og);
#pragma unroll
            for (int ai = 0; ai < 2; ++ai)
#pragma unroll
                for (int m = 0; m < 4; ++m)
#pragma unroll
                    for (int bj = 0; bj < 2; ++bj) { const u32x4 aa = a[ai][m][bj];
                        acc[ai][bj][m][0] *= (f32x4){bf_lo(aa.x), bf_hi(aa.x), bf_lo(aa.y), bf_hi(aa.y)}; acc[ai][bj][m][1] *= (f32x4){bf_lo(aa.z), bf_hi(aa.z), bf_lo(aa.w), bf_hi(aa.w)};
                        asm volatile("" : "+v"(acc[ai][bj][m][0]), "+v"(acc[ai][bj][m][1])); }
        } else if constexpr (BR == 1) {
#pragma unroll
            for (int ai = 0; ai < 2; ++ai) {
                __builtin_amdgcn_sched_barrier(0);
                u32x4 a[4][2], d[4][2];
#pragma unroll
                for (int m = 0; m < 4; ++m)
#pragma unroll
                    for (int bj = 0; bj < 2; ++bj) { a[m][bj] = ldo<u32x4>(Gt, 1024 + (ai * HALF + m * 16) * LDG + bj * HALF, og); d[m][bj] = ldo<u32x4>(Gt, 2048 + (ai * HALF + m * 16) * LDG + bj * HALF, og); }
#pragma unroll
                for (int m = 0; m < 4; ++m)
#pragma unroll
                    for (int bj = 0; bj < 2; ++bj) { const u32x4 aa = a[m][bj], dd = d[m][bj];
                        const f32x4 r0 = {bf_lo(aa.x) * __builtin_amdgcn_rcpf(bf_lo(dd.x)), bf_hi(aa.x) * __builtin_amdgcn_rcpf(bf_hi(dd.x)), bf_lo(aa.y) * __builtin_amdgcn_rcpf(bf_lo(dd.y)), bf_hi(aa.y) * __builtin_amdgcn_rcpf(bf_hi(dd.y))};
                        const f32x4 r1 = {bf_lo(aa.z) * __builtin_amdgcn_rcpf(bf_lo(dd.z)), bf_hi(aa.z) * __builtin_amdgcn_rcpf(bf_hi(dd.z)), bf_lo(aa.w) * __builtin_amdgcn_rcpf(bf_lo(dd.w)), bf_hi(aa.w) * __builtin_amdgcn_rcpf(bf_hi(dd.w))};
                        acc[ai][bj][m][0] *= r0; acc[ai][bj][m][1] *= r1; asm volatile("" : "+v"(acc[ai][bj][m][0]), "+v"(acc[ai][bj][m][1])); }
            }
        } else {
            u32x4 g[2][4][2];
#pragma unroll
            for (int ai = 0; ai < 2; ++ai)
#pragma unroll
                for (int m = 0; m < 4; ++m)
#pragma unroll
                    for (int bj = 0; bj < 2; ++bj) g[ai][m][bj] = ldo<u32x4>(Gt, 2048 + (ai * HALF + m * 16) * LDG + bj * HALF, og);
#pragma unroll
            for (int ai = 0; ai < 2; ++ai)
#pragma unroll
                for (int m = 0; m < 4; ++m)
#pragma unroll
                    for (int bj = 0; bj < 2; ++bj) { const f32x4 a0 = acc[ai][bj][m][0], a1 = acc[ai][bj][m][1]; const u32x4 gg = g[ai][m][bj];
                        u32x4 w;
                        w.x = cvt_pk_bf16(bf_lo(gg.x) * a0[0], bf_hi(gg.x) * a0[1]); w.y = cvt_pk_bf16(bf_lo(gg.y) * a0[2], bf_hi(gg.y) * a0[3]);
                        w.z = cvt_pk_bf16(bf_lo(gg.z) * a1[0], bf_hi(gg.z) * a1[1]); w.w = cvt_pk_bf16(bf_lo(gg.w) * a1[2], bf_hi(gg.w) * a1[3]);
                        *(PG8_GAS u32x4*)((PG8_GAS unsigned char*)(Mg + (ai * HALF + m * 16) * LDM + bj * HALF) + (size_t)om) = w; }
        }
    }
};
template <class T> __device__ __forceinline__ T ldo_(const void* base, unsigned off) { return *(const PG8_GAS T*)((const PG8_GAS unsigned char*)base + (size_t)off); }
template <class T> __device__ __forceinline__ void sto_(void* base, unsigned off, T v) { *(PG8_GAS T*)((PG8_GAS unsigned char*)base + (size_t)off) = v; }
struct EpiResidA {
    static constexpr bool PERM = true, AFTER_DRAIN = false, CHAIN = false, PRE = false;
    static constexpr int LD = 1024;
    const float* base; bf16_t* xb; float* rpart;
    __device__ __forceinline__ void operator()(const f32x4 (&acc)[2][2][4][2], const Unit& u, int wr, int wc, int fr, int fq) const {
        const int row0 = u.pm * BM + wr * 64 + fr, col0 = u.pn * BM + wc * 32 + 8 * fq;
        const unsigned o4 = ((unsigned)row0 * LD + col0) * 4u, o2 = ((unsigned)row0 * LD + col0) * 2u;
#pragma unroll
        for (int ai = 0; ai < 2; ++ai) {
            __builtin_amdgcn_sched_barrier(0);
            f32x4 bs[4][2][2];
#pragma unroll
            for (int m = 0; m < 4; ++m)
#pragma unroll
                for (int bj = 0; bj < 2; ++bj)
#pragma unroll
                    for (int n = 0; n < 2; ++n) bs[m][bj][n] = ldo_<f32x4>(base + (ai * HALF + m * 16) * LD + bj * HALF + 4 * n, o4);
#pragma unroll
            for (int m = 0; m < 4; ++m) { float ss = 0.f;
#pragma unroll
                for (int bj = 0; bj < 2; ++bj) { const f32x4 p0 = bs[m][bj][0] + acc[ai][bj][m][0], p1 = bs[m][bj][1] + acc[ai][bj][m][1];
                    ss += ((p0[0] * p0[0] + p0[1] * p0[1]) + (p0[2] * p0[2] + p0[3] * p0[3])) + ((p1[0] * p1[0] + p1[1] * p1[1]) + (p1[2] * p1[2] + p1[3] * p1[3]));
                    u32x4 w; w.x = cvt_pk_bf16(p0[0], p0[1]); w.y = cvt_pk_bf16(p0[2], p0[3]); w.z = cvt_pk_bf16(p1[0], p1[1]); w.w = cvt_pk_bf16(p1[2], p1[3]);
                    sto_<u32x4>(xb + (ai * HALF + m * 16) * LD + bj * HALF, o2, w); }
                ss = xrow_sum_e(ss); if (fq == 0) gst_<float>(rpart + (size_t)(row0 + ai * HALF + m * 16) * 16 + u.pn * 4 + wc, ss); }
        }
    }
};
struct EpiResidB {
    static constexpr bool PERM = true, AFTER_DRAIN = false, CHAIN = false, PRE = false;
    static constexpr int LD = 1024;
    const bf16_t* xb; float* out;
    __device__ __forceinline__ void operator()(const f32x4 (&acc)[2][2][4][2], const Unit& u, int wr, int wc, int fr, int fq) const {
        const int row0 = u.pm * BM + wr * 64 + fr, col0 = u.pn * BM + wc * 32 + 8 * fq;
        const unsigned o4 = ((unsigned)row0 * LD + col0) * 4u, o2 = ((unsigned)row0 * LD + col0) * 2u;
        u32x4 b[2][4][2];
#pragma unroll
        for (int ai = 0; ai < 2; ++ai)
#pragma unroll
            for (int m = 0; m < 4; ++m)
#pragma unroll
                for (int bj = 0; bj < 2; ++bj) b[ai][m][bj] = ldo_<u32x4>(xb + (ai * HALF + m * 16) * LD + bj * HALF, o2);
#pragma unroll
        for (int ai = 0; ai < 2; ++ai)
#pragma unroll
            for (int m = 0; m < 4; ++m)
#pragma unroll
                for (int bj = 0; bj < 2; ++bj) { const u32x4 bb = b[ai][m][bj];
                    sto_<f32x4>(out + (ai * HALF + m * 16) * LD + bj * HALF, o4, (f32x4){bf_lo(bb.x), bf_hi(bb.x), bf_lo(bb.y), bf_hi(bb.y)} + acc[ai][bj][m][0]);
                    sto_<f32x4>(out + (ai * HALF + m * 16) * LD + bj * HALF + 4, o4, (f32x4){bf_lo(bb.z), bf_hi(bb.z), bf_lo(bb.w), bf_hi(bb.w)} + acc[ai][bj][m][1]); }
    }
};


template <int V> struct IC { static constexpr int value = V; };
template <class Epi, class Sched, bool ALIGN_EPI = false, bool SP2 = false>
__device__ __forceinline__ void gemm_phase(PG8_LAS unsigned char* lds, const Gemm g, const Sched& S, const Epi& E, const int tid) {
    const int wid = __builtin_amdgcn_readfirstlane(tid >> 6), lane = tid & 63, wr = wid >> 2, wc = wid & 3, fr = lane & 15, fq = lane >> 4;
    const int K = g.K, nt = K / BK;
    unsigned voffA[2], voffB[2];
#pragma unroll
    for (int i = 0; i < 2; ++i) { int R, C; stage_rc(tid * 16 + i * 8192, R, C); const int Rb = Epi::PERM ? ((R & ~31) + perm32(R & 31)) : R;
        voffA[i] = (unsigned)(R * K + C) * 2u; voffB[i] = (unsigned)(Rb * K + C) * 2u; }
    const size_t kstep = (size_t)(BK * 2);
    const size_t hstep = (size_t)HALF * K * 2;
    const size_t tstep = 2 * hstep;
    const unsigned ldsw = (unsigned)wid * 1024u;
    const int aoff = lds_byte(wr * 64 + fr, fq * 8), boff = lds_byte(wc * 32 + fr, fq * 8);
#define PG8_SA(b, h) (((b) * 2 + (h)) * HTB)
#define PG8_SB(b, h) ((4 + (b) * 2 + (h)) * HTB)
#define PG8_STAGE(bufoff, gbase, voff) do { _Pragma("unroll") for (int _i = 0; _i < 2; ++_i) \
        __builtin_amdgcn_global_load_lds((const unsigned*)((const char*)(gbase) + (voff)[_i]), (PG8_LAS unsigned*)(lds + (bufoff) + ldsw + _i * 8192), 16, 0, 0); } while (0)
#define PG8_LDA(dst, b, h) do { _Pragma("unroll") for (int m = 0; m < 4; ++m) _Pragma("unroll") for (int k = 0; k < 2; ++k) dst[m][k] = *(const PG8_LAS bf16x8*)(lds + PG8_SA(b, h) + aoff + m * 2048 + k * 1024); } while (0)
#define PG8_LDB(dst, b, h) do { _Pragma("unroll") for (int n = 0; n < 2; ++n) _Pragma("unroll") for (int k = 0; k < 2; ++k) dst[n][k] = *(const PG8_LAS bf16x8*)(lds + PG8_SB(b, h) + boff + n * 2048 + k * 1024); } while (0)
#define PG8_MMA(ai, bj, At, Bt) do { __builtin_amdgcn_s_setprio(1); _Pragma("unroll") for (int m = 0; m < 4; ++m) _Pragma("unroll") for (int n = 0; n < 2; ++n) _Pragma("unroll") for (int k = 0; k < 2; ++k) \
        acc[ai][bj][m][n] = __builtin_amdgcn_mfma_f32_16x16x32_bf16(Bt[n][k], At[m][k], acc[ai][bj][m][n], 0, 0, 0); __builtin_amdgcn_s_setprio(0); } while (0)
#define PG8_WAIT_V(n) asm volatile("s_waitcnt vmcnt(" #n ")" ::: "memory")
#define PG8_WAIT_L(n) asm volatile("s_waitcnt lgkmcnt(" #n ")" ::: "memory")
#define PG8_BAR __builtin_amdgcn_s_barrier()
#define PG8_SCHED __builtin_amdgcn_sched_barrier(0)
    Unit cur, nxt; int ui = 0;
    if (!S.next(0, cur)) return;
    f32x4 acc[2][2][4][2];
#pragma unroll
    for (int a = 0; a < 2; ++a)
#pragma unroll
        for (int b = 0; b < 2; ++b)
#pragma unroll
            for (int m = 0; m < 4; ++m)
#pragma unroll
                for (int n = 0; n < 2; ++n) acc[a][b][m][n] = (f32x4){0.f, 0.f, 0.f, 0.f};
    bf16x8 At[4][2], B0[2][2], B1[2][2];
    const char* cA = (const char*)g.A + (size_t)cur.pm * tstep; const char* cB = (const char*)g.Bt + (size_t)cur.pn * tstep;
    S.a_ready(cur);
    if constexpr (SP2) {
        PG8_STAGE(PG8_SB(0, 0), cB, voffB); PG8_STAGE(PG8_SB(0, 1), cB + hstep, voffB); PG8_STAGE(PG8_SA(0, 0), cA, voffA); PG8_STAGE(PG8_SA(0, 1), cA + hstep, voffA);
        if (wr == 1) PG8_BAR;
        PG8_WAIT_V(2); PG8_BAR;
        PG8_STAGE(PG8_SB(1, 0), cB + kstep, voffB); PG8_STAGE(PG8_SA(1, 0), cA + kstep, voffA); PG8_STAGE(PG8_SB(1, 1), cB + hstep + kstep, voffB);
        PG8_WAIT_V(6); PG8_BAR;
    } else {
        PG8_STAGE(PG8_SB(0, 0), cB, voffB); PG8_STAGE(PG8_SA(0, 0), cA, voffA); PG8_STAGE(PG8_SB(0, 1), cB + hstep, voffB); PG8_STAGE(PG8_SA(0, 1), cA + hstep, voffA);
        if (wr == 1) PG8_BAR;
        PG8_WAIT_V(4); PG8_BAR;
        PG8_STAGE(PG8_SB(1, 0), cB + kstep, voffB); PG8_STAGE(PG8_SA(1, 0), cA + kstep, voffA); PG8_STAGE(PG8_SB(1, 1), cB + hstep + kstep, voffB);
        PG8_WAIT_V(6); PG8_BAR;
    }
    auto unit = [&](auto BRC) __attribute__((always_inline)) -> bool {
        constexpr int BR = decltype(BRC)::value;
        const bool has_next = S.next(ui + 1, nxt);
        const char* nA = has_next ? (const char*)g.A + (size_t)nxt.pm * tstep : cA; const char* nB = has_next ? (const char*)g.Bt + (size_t)nxt.pn * tstep : cB;
        asm volatile("" : "+s"(nA), "+s"(nB));
        for (int t = 0; t < nt; t += 2) {
            const bool last = (t == nt - 2);
            const char* a1 = cA + (size_t)(t + 1) * kstep;
            const char* a2 = last ? nA : cA + (size_t)(t + 2) * kstep; const char* b2 = last ? nB : cB + (size_t)(t + 2) * kstep;
            const char* a3 = a2 + kstep; const char* b3 = b2 + kstep;
            if (last && has_next) S.a_ready(nxt);
            if constexpr (SP2) {
            PG8_LDB(B0, 0, 0); PG8_LDB(B1, 0, 1); PG8_SCHED; PG8_LDA(At, 0, 0); PG8_STAGE(PG8_SA(1, 1), a1 + hstep, voffA);
            PG8_WAIT_V(8); PG8_WAIT_L(0); PG8_BAR; PG8_MMA(0, 0, At, B0); PG8_MMA(0, 1, At, B1); PG8_BAR; PG8_SCHED;
            PG8_LDA(At, 0, 1); PG8_STAGE(PG8_SB(0, 0), b2, voffB); PG8_STAGE(PG8_SB(0, 1), b2 + hstep, voffB); PG8_STAGE(PG8_SA(0, 0), a2, voffA);
            PG8_WAIT_V(8); PG8_WAIT_L(0); PG8_BAR; PG8_MMA(1, 0, At, B0); PG8_MMA(1, 1, At, B1); PG8_BAR; PG8_SCHED;
            PG8_LDB(B0, 1, 0); PG8_LDB(B1, 1, 1); PG8_SCHED; PG8_LDA(At, 1, 0); PG8_STAGE(PG8_SA(0, 1), a2 + hstep, voffA);
            PG8_WAIT_V(8); PG8_WAIT_L(0); PG8_BAR; PG8_MMA(0, 0, At, B0); PG8_MMA(0, 1, At, B1); PG8_BAR; PG8_SCHED;
            PG8_LDA(At, 1, 1); PG8_STAGE(PG8_SB(1, 0), b3, voffB); PG8_STAGE(PG8_SB(1, 1), b3 + hstep, voffB); PG8_STAGE(PG8_SA(1, 0), a3, voffA);
            PG8_WAIT_V(8);
            if constexpr (Epi::PRE) { if (last) E.pre(cur, wr, fr, lds + STAGE_BYTES + wid * 2048); }
            PG8_WAIT_L(0); PG8_BAR; PG8_MMA(1, 0, At, B0); PG8_MMA(1, 1, At, B1); PG8_BAR; PG8_SCHED;
            } else {
            PG8_LDB(B0, 0, 0); PG8_SCHED; PG8_LDA(At, 0, 0); PG8_STAGE(PG8_SA(1, 1), a1 + hstep, voffA);
            PG8_WAIT_L(8); PG8_BAR; PG8_WAIT_L(0); PG8_MMA(0, 0, At, B0); PG8_BAR; PG8_SCHED;
            PG8_LDB(B1, 0, 1); PG8_STAGE(PG8_SB(0, 0), b2, voffB);
            PG8_BAR; PG8_WAIT_L(0); PG8_MMA(0, 1, At, B1); PG8_BAR;
            PG8_LDA(At, 0, 1); PG8_STAGE(PG8_SA(0, 0), a2, voffA);
            PG8_BAR; PG8_WAIT_L(0); PG8_MMA(1, 0, At, B0); PG8_BAR; PG8_SCHED;
            PG8_STAGE(PG8_SB(0, 1), b2 + hstep, voffB);
            PG8_WAIT_V(6); PG8_BAR; PG8_MMA(1, 1, At, B1); PG8_BAR;
            PG8_LDB(B0, 1, 0); PG8_SCHED; PG8_LDA(At, 1, 0); PG8_STAGE(PG8_SA(0, 1), a2 + hstep, voffA);
            PG8_WAIT_L(8); PG8_BAR; PG8_WAIT_L(0); PG8_MMA(0, 0, At, B0); PG8_BAR; PG8_SCHED;
            PG8_LDB(B1, 1, 1); PG8_STAGE(PG8_SB(1, 0), b3, voffB);
            PG8_BAR; PG8_WAIT_L(0); PG8_MMA(0, 1, At, B1); PG8_BAR;
            PG8_LDA(At, 1, 1); PG8_STAGE(PG8_SA(1, 0), a3, voffA);
            PG8_BAR; PG8_WAIT_L(0); PG8_MMA(1, 0, At, B0); PG8_BAR; PG8_SCHED;
            PG8_STAGE(PG8_SB(1, 1), b3 + hstep, voffB);
            PG8_WAIT_V(6); PG8_BAR; PG8_MMA(1, 1, At, B1); PG8_BAR;
            }
        }
        if constexpr (ALIGN_EPI) { if (wr == 0) PG8_BAR; }
        if constexpr (Epi::CHAIN) { E.template run<BR>(acc, cur, wr, wc, fr, fq); S.done(cur); }
        else if constexpr (Epi::PRE) { E(acc, cur, wr, wc, fr, fq, lds + STAGE_BYTES + wid * 2048); S.done(cur); }
        else if constexpr (!Epi::AFTER_DRAIN) { E(acc, cur, wr, wc, fr, fq); S.done(cur); }
        if (!has_next) return false;
        if constexpr (!Epi::CHAIN || BR == 2) {
#pragma unroll
        for (int a = 0; a < 2; ++a)
#pragma unroll
            for (int b = 0; b < 2; ++b)
#pragma unroll
                for (int m = 0; m < 4; ++m)
#pragma unroll
                    for (int n = 0; n < 2; ++n) acc[a][b][m][n] = (f32x4){0.f, 0.f, 0.f, 0.f};
        }
        cur = nxt; cA = nA; cB = nB; ++ui;
        if constexpr (ALIGN_EPI) { if (wr == 1) PG8_BAR; }
        return true;
    };
    if constexpr (Epi::CHAIN) { for (;;) { if (!unit(IC<0>{})) break; if (!unit(IC<1>{})) break; if (!unit(IC<2>{})) break; } }
    else { for (;;) if (!unit(IC<0>{})) break; }
    PG8_WAIT_V(0);
    if constexpr (!ALIGN_EPI) { if (wr == 0) PG8_BAR; }
    PG8_BAR;
    if constexpr (Epi::AFTER_DRAIN) { E.fused(acc, cur, wr, wc, fr, fq, lds, wid, lane); S.done(cur); }
#undef PG8_SA
#undef PG8_SB
#undef PG8_STAGE
#undef PG8_LDA
#undef PG8_LDB
#undef PG8_MMA
#undef PG8_WAIT_V
#undef PG8_WAIT_L
#undef PG8_BAR
#undef PG8_SCHED
}
}
#define GAS __attribute__((address_space(1)))
#define LAS __attribute__((address_space(3)))
typedef unsigned short bf16;
typedef unsigned v4u __attribute__((ext_vector_type(4)));
typedef float f32x4 __attribute__((ext_vector_type(4)));
typedef short bf16x8 __attribute__((ext_vector_type(8)));
typedef GAS unsigned gu32;
typedef GAS unsigned long long gu64;
#define RLX_AGENT __ATOMIC_RELAXED, __HIP_MEMORY_SCOPE_AGENT
#define LDS_WAIT() asm volatile("s_waitcnt lgkmcnt(0)" ::: "memory")
#define VM_WAIT() asm volatile("s_waitcnt vmcnt(0)" ::: "memory")
__device__ __forceinline__ unsigned long long rt() { return __builtin_amdgcn_s_memrealtime(); }
__device__ __forceinline__ unsigned f2bf(float f) { unsigned u = __builtin_bit_cast(unsigned, f); return (u + 0x7fffu + ((u >> 16) & 1u)) >> 16; }
__device__ __forceinline__ unsigned pk2(float lo, float hi) { return f2bf(lo) | (f2bf(hi) << 16); }

#define XB_TMO      128
#define XB_XCNT(j)  (256  + 64 * (j))
#define XB_XSUB(j)  (1280 + 64 * (j))
#define XB_XGEN(j)  (2304 + 64 * (j))
#define XB_TOP      3328
#define XB_TOPGEN   3392
#define XCD_BAR_WORDS 3456
#define XB_SPIN_CAP (1u << 18)

__device__ __forceinline__ unsigned xb_ld(unsigned* p)              { return __hip_atomic_load(p, __ATOMIC_RELAXED, __HIP_MEMORY_SCOPE_AGENT); }
__device__ __forceinline__ unsigned xb_add(unsigned* p, unsigned v) { return __hip_atomic_fetch_add(p, v, __ATOMIC_RELAXED, __HIP_MEMORY_SCOPE_AGENT); }
__device__ __forceinline__ unsigned xb_xcc_id() { return (unsigned)__builtin_amdgcn_s_getreg((3 << 11) | 20) & 0xFu; }
#define XB_SPIN(cond, bar) do { unsigned _sp = 0; while (cond) { __builtin_amdgcn_s_sleep(1); \
    if ((++_sp & 255u) == 0u) { if (xb_ld(&(bar)[XB_TMO])) break; if (_sp > XB_SPIN_CAP) { atomicAdd(&(bar)[XB_TMO], 1u); break; } } } } while (0)

struct XcdBarrier {
    unsigned* bar; unsigned x;
    volatile LAS unsigned* st;
};

__device__ __forceinline__ XcdBarrier xcd_barrier_post(unsigned* bar, volatile LAS unsigned* st) {
    XcdBarrier b; b.bar = bar; b.x = xb_xcc_id(); b.st = st;
    if (threadIdx.x == 0) (void)xb_add(&bar[XB_XCNT(b.x)], 1u);
    return b;
}
__device__ __forceinline__ void xcd_barrier_complete(unsigned* bar, unsigned x, unsigned& nloc, unsigned& nx) {
    const unsigned G = gridDim.x * gridDim.y * gridDim.z;
    unsigned sum, cnt, mine, sp = 0u;
    for (;;) {
        sum = 0u; cnt = 0u; mine = 0u;
#pragma unroll
        for (unsigned j = 0; j < 16; ++j) { const unsigned c = xb_ld(&bar[XB_XCNT(j)]); sum += c; cnt += (c > 0u) ? 1u : 0u; mine = (j == x) ? c : mine; }
        if (sum == G) break;
        __builtin_amdgcn_s_sleep(1);
        if ((++sp & 255u) == 0u) { if (xb_ld(&bar[XB_TMO])) break; if (sp > XB_SPIN_CAP) { atomicAdd(&bar[XB_TMO], 1u); break; } }
    }
    nloc = mine > 0u ? mine : 1u; nx = cnt > 0u ? cnt : 1u;
}

__device__ __forceinline__ void xcd_barrier(const XcdBarrier& b) {
    asm volatile("s_waitcnt vmcnt(0)" ::: "memory");
    __syncthreads();
    if (threadIdx.x == 0) {
        unsigned* bar = b.bar;
        __builtin_amdgcn_s_waitcnt(0);
        unsigned nloc = b.st[0], nx = b.st[1];
        if (nloc == 0u) { xcd_barrier_complete(bar, b.x, nloc, nx); b.st[0] = nloc; b.st[1] = nx; }
        const unsigned old = xb_add(&bar[XB_XSUB(b.x)], 1u);
        const unsigned gen = old / nloc;
        if (old + 1u == (gen + 1u) * nloc) {
            __builtin_amdgcn_fence(__ATOMIC_RELEASE, "agent");
            asm volatile("s_waitcnt vmcnt(0)" ::: "memory");
            const unsigned og = xb_add(&bar[XB_TOP], 1u);
            const unsigned tg = og / nx;
            if (og + 1u == (tg + 1u) * nx) xb_add(&bar[XB_TOPGEN], 1u);
            else XB_SPIN(xb_ld(&bar[XB_TOPGEN]) == tg, bar);
            __builtin_amdgcn_fence(__ATOMIC_ACQUIRE, "agent");
            xb_add(&bar[XB_XGEN(b.x)], 1u);
            asm volatile("s_waitcnt vmcnt(0)" ::: "memory");
        } else {
            XB_SPIN(xb_ld(&bar[XB_XGEN(b.x)]) == gen, bar);
            __builtin_amdgcn_fence(__ATOMIC_ACQUIRE, "agent");
            asm volatile("s_waitcnt vmcnt(0)" ::: "memory");
        }
    }
    __syncthreads();
}


constexpr int BATCH = 32, SEQ = 2048, D = 1024, M = BATCH * SEQ, DEPTH = 2;
constexpr int NIN = 7448, NMAIN = 4608, NMG = 3072, NINP = NMAIN + NMG;
constexpr float EPS = 1e-6f;
constexpr int PA_LD = 1280, PG_LD = 1536, PS_LD = 1536, PX_LD = 32;
constexpr int PC_AQ = 0, PC_AK = 512, PC_AV = 640, PC_AG = 768, PC_GQ = 0, PC_GK = 256, PC_GV = 512, PC_GG = 1024, PC_XBC = 0, PC_SZ = 1024, PC_GD = 0, PC_DT = 16;
__host__ __device__ __forceinline__ int src_col(int d) {
    if (d < 2816) return d;
    if (d < 3840) return d + 16;
    if (d < 4352) return d + 24;
    if (d < 4368) return 2816 + (d - 4352);
    if (d < 4376) return 3856 + (d - 4368);
    if (d < NMAIN) return -1;
    const int e = d - NMAIN, t = e >> 8, w = e & 255;
    return 4376 + (t < 8 ? (w >> 7) * 1024 + 128 * t + (w & 127) : e);
}
constexpr size_t MiB = 1u << 20;
constexpr size_t WS_CTL = 0, CTL_ZERO_BYTES = 1 * MiB;
constexpr size_t WS_WIN = 1 * MiB;
constexpr size_t WS_WB = 31 * MiB;
constexpr size_t WS_WO = 37 * MiB;
constexpr size_t WS_PAR = 41 * MiB;
constexpr int PG_NORM = 0, PG_QN = 1024, PG_KN = 1088, PG_SINK = 1152, PG_GWG = 1160, PG_GBG = 5256, PG_GON = 5512, PG_CW = 5640, PG_CB = 9736, PG_DTB = 10760, PG_ALOG = 10768, PG_DSK = 10776, PG_SON = 10784, PSTRIDE = 11296;
constexpr size_t WS_RPART = 42 * MiB;
constexpr size_t WS_RINV = 46 * MiB;
constexpr size_t WS_XN = 48 * MiB;
constexpr size_t WS_Y = 176 * MiB;
constexpr size_t WS_PA = 368 * MiB, WS_PG = 528 * MiB, WS_SPARE = 720 * MiB, WS_PS = 752 * MiB, WS_PX = 960 * MiB;
constexpr size_t WS_MG = 368 * MiB;
constexpr size_t WS_MERGED = 752 * MiB;
constexpr size_t WS_CS = 944 * MiB;
constexpr size_t WS_END = 1024 * MiB;
static_assert(WS_PA + (size_t)M * PA_LD * 2 == WS_PG && WS_PG + (size_t)M * PG_LD * 2 == WS_SPARE && WS_MG + (size_t)M * NMG * 2 == WS_PS && WS_PS + (size_t)M * PS_LD * 2 == WS_CS && WS_MERGED + (size_t)M * D * 2 <= WS_CS && WS_PX + (size_t)M * PX_LD * 2 <= WS_END, "ws map");
constexpr int CW_TMO = 0, CW_CODE = 1;
constexpr int CW_Q = 64;
constexpr int CW_DONE = 256;
constexpr int N_AG_UNITS = 128 + 1024;
constexpr int CW_BAR = 4096;
constexpr int NPHASE = 14, MAX_LAUNCH = 16;
constexpr int RING_OFF = 0, RING_BYTES = 131072;
constexpr int LDS_BYTES = 163840;
constexpr int LDSCTL_OFF = LDS_BYTES - 1024, MISC_OFF = LDSCTL_OFF + 320;
constexpr int NWAVES = 8, NTHR = 512;

struct Args { const void* in[18]; float* out; unsigned char* ws; int ph_lo, ph_hi, li, pad; };

template <int CTRL, int ROWMASK = 0xF> __device__ __forceinline__ float dpp_f(float x) { return __builtin_bit_cast(float, __builtin_amdgcn_update_dpp(0, __builtin_bit_cast(int, x), CTRL, ROWMASK, 0xF, ROWMASK == 0xF)); }
__device__ __forceinline__ float quad_sum(float x) { x += dpp_f<0xB1>(x); x += dpp_f<0x4E>(x); return x; }
__device__ __forceinline__ float row16_sum(float x) { x = quad_sum(x); x += dpp_f<0x141>(x); x += dpp_f<0x140>(x); return x; }
typedef unsigned u32x2p __attribute__((ext_vector_type(2)));
__device__ __forceinline__ void swap16(unsigned& a, unsigned& b) { asm volatile("s_nop 1\n\tv_permlane16_swap_b32 %0, %1" : "+v"(a), "+v"(b)); }
__device__ __forceinline__ void swap32(unsigned& a, unsigned& b) { asm volatile("s_nop 1\n\tv_permlane32_swap_b32 %0, %1" : "+v"(a), "+v"(b)); }
__device__ __forceinline__ float xrow_sum(float x) { unsigned a = __builtin_bit_cast(unsigned, x), b = a; swap16(a, b); const float y = __builtin_bit_cast(float, a) + __builtin_bit_cast(float, b);
    unsigned c = __builtin_bit_cast(unsigned, y), d = c; swap32(c, d); return __builtin_bit_cast(float, c) + __builtin_bit_cast(float, d); }
__device__ __forceinline__ float xrow_max(float x) { unsigned a = __builtin_bit_cast(unsigned, x), b = a; swap16(a, b); const float y = fmaxf(__builtin_bit_cast(float, a), __builtin_bit_cast(float, b));
    unsigned c = __builtin_bit_cast(unsigned, y), d = c; swap32(c, d); return fmaxf(__builtin_bit_cast(float, c), __builtin_bit_cast(float, d)); }
__device__ __forceinline__ float wave_sum(float v) {
    v = row16_sum(v);
    return ((__builtin_bit_cast(float, __builtin_amdgcn_readlane(__builtin_bit_cast(int, v), 0)) + __builtin_bit_cast(float, __builtin_amdgcn_readlane(__builtin_bit_cast(int, v), 16)))
         + (__builtin_bit_cast(float, __builtin_amdgcn_readlane(__builtin_bit_cast(int, v), 32)) + __builtin_bit_cast(float, __builtin_amdgcn_readlane(__builtin_bit_cast(int, v), 48))));
}
__device__ __forceinline__ float bf2f(bf16 b) { return __builtin_bit_cast(float, ((unsigned)b) << 16); }
__device__ __forceinline__ float siluf(float x) { return x * __builtin_amdgcn_rcpf(1.f + __builtin_amdgcn_exp2f(-1.44269504f * x)); }
__device__ __forceinline__ float softplusf(float x) { return x > 20.f ? x : __logf(1.f + __expf(x)); }
__device__ __forceinline__ float logsigmoidf(float x) { return fminf(x, 0.f) - __logf(1.f + __expf(-fabsf(x))); }
__device__ __forceinline__ float rsqf(float x) { return __builtin_amdgcn_rsqf(x); }

template <bool MAPPED>
__device__ __forceinline__ void transpose_item(const float* W, int K, int N, bf16* WT, LAS float* scr, int item, int nblk, int lane, const float* gk = nullptr) {
    const int kb = item / nblk, nb = item % nblk, k0 = 64 * kb, n0 = 32 * nb;
    const int nd = n0 + (lane & 31); const int sc = MAPPED ? src_col(nd) : nd;
    const float wmul = (MAPPED && nd >= NMAIN) ? -1.44269504f : 1.f;
#pragma unroll 8
    for (int i = 0; i < 32; ++i) { const int kk = 2 * i + (lane >> 5); scr[kk * 33 + (lane & 31)] = sc >= 0 ? W[(size_t)(k0 + kk) * N + sc] * (gk ? wmul * gk[k0 + kk] : wmul) : 0.f; }
    LDS_WAIT(); asm volatile("" ::: "memory");
    const int c = lane & 7;
#pragma unroll
    for (int j = 0; j < 4; ++j) { const int n = (lane >> 3) + 8 * j; const LAS float* s = scr + (8 * c) * 33 + n;
        v4u o; o.x = pk2(s[0 * 33], s[1 * 33]); o.y = pk2(s[2 * 33], s[3 * 33]); o.z = pk2(s[4 * 33], s[5 * 33]); o.w = pk2(s[6 * 33], s[7 * 33]);
        *(GAS v4u*)(WT + (size_t)(n0 + n) * K + k0 + 8 * c) = o; }
    LDS_WAIT(); asm volatile("" ::: "memory");
}
__device__ __forceinline__ void rms_rows2_to_bf16(const float* xrow0, const float* xrow1, const float* g, bf16* orow0, bf16* orow1, int lane) {
    const GAS f32x4* xr0 = (const GAS f32x4*)xrow0 + lane; const GAS f32x4* xr1 = (const GAS f32x4*)xrow1 + lane; const GAS f32x4* gr = (const GAS f32x4*)g + lane;
    f32x4 v[4], w[4]; float s = 0.f, t = 0.f;
#pragma unroll
    for (int j = 0; j < 4; ++j) { v[j] = xr0[64 * j]; w[j] = xr1[64 * j]; }
#pragma unroll
    for (int j = 0; j < 4; ++j) { s += (v[j].x * v[j].x + v[j].y * v[j].y) + (v[j].z * v[j].z + v[j].w * v[j].w); t += (w[j].x * w[j].x + w[j].y * w[j].y) + (w[j].z * w[j].z + w[j].w * w[j].w); }
    const float r = 1.f / sqrtf(wave_sum(s) * (1.f / D) + EPS), q = 1.f / sqrtf(wave_sum(t) * (1.f / D) + EPS);
    GAS unsigned long long* o0 = (GAS unsigned long long*)orow0 + lane; GAS unsigned long long* o1 = (GAS unsigned long long*)orow1 + lane;
#pragma unroll
    for (int j = 0; j < 4; ++j) { const f32x4 gg = gr[64 * j];
        o0[64 * j] = (unsigned long long)pk2(v[j].x * r * gg.x, v[j].y * r * gg.y) | ((unsigned long long)pk2(v[j].z * r * gg.z, v[j].w * r * gg.w) << 32);
        o1[64 * j] = (unsigned long long)pk2(w[j].x * q * gg.x, w[j].y * q * gg.y) | ((unsigned long long)pk2(w[j].z * q * gg.z, w[j].w * q * gg.w) << 32); }
}

typedef unsigned long long u64;
typedef unsigned u32x2 __attribute__((ext_vector_type(2)));
#define LBAR() do { asm volatile("s_waitcnt lgkmcnt(0)" ::: "memory"); __builtin_amdgcn_s_barrier(); asm volatile("" ::: "memory"); } while (0)
#define GLD(T, base, off) (*(const GAS T*)((const GAS unsigned char*)(base) + (size_t)(unsigned)(off)))
#define GST(T, base, off) (*(GAS T*)((GAS unsigned char*)(base) + (size_t)(unsigned)(off)))
#define MFMA16(a, b, c) __builtin_amdgcn_mfma_f32_16x16x32_bf16((a), (b), (c), 0, 0, 0)
__device__ __forceinline__ unsigned pk2c(float lo, float hi) { return pg8::cvt_pk_bf16(lo, hi); }
__device__ __forceinline__ bf16x8 mk8(unsigned a, unsigned b, unsigned c, unsigned d) { const v4u t = {a, b, c, d}; return __builtin_bit_cast(bf16x8, t); }
__device__ __forceinline__ bf16x8 mk8(u32x2 lo, u32x2 hi) { const v4u t = {lo.x, lo.y, hi.x, hi.y}; return __builtin_bit_cast(bf16x8, t); }
__device__ __forceinline__ float ex2(float x) { return __builtin_amdgcn_exp2f(x); }

constexpr int AT_KS = 0, AT_KSTR = 144, AT_VT = 36864, AT_VSTR = 528;
__device__ __forceinline__ void attn_unit(int unit, const bf16* PROJ, const float2* CS, const float* par_g, bf16* YA, LAS unsigned char* lds, int tid) {
    const GAS float* par = (const GAS float*)par_g;
    const int lane = tid & 63, wave = __builtin_amdgcn_readfirstlane(tid >> 6);
    const int jb = unit & 15, kvh = (unit >> 4) & 1, b = unit >> 5;
    const long mq0 = (long)b * SEQ + jb * 128, mk0 = mq0 - 128;
    LAS unsigned char* Ks = lds + AT_KS; LAS unsigned char* Vt = lds + AT_VT;
    const GAS float* kn = par + PG_KN; const GAS float* qn = par + PG_QN;
    const int g = wave >> 1, hq = 4 * kvh + g, i16 = lane & 15, quad = lane >> 4;
    v4u qr0, qr1; f32x4 qcs[4];
#define AT_QLOAD(itn) do { const int qrel_ = 16 * ((wave & 1) * 4 + (itn)) + i16; const unsigned qo_ = (unsigned)(qrel_ * PA_LD + PC_AQ + 64 * hq + 8 * quad) * 2u, cso_ = (unsigned)(qrel_ * 32 + 8 * quad) * 8u; \
        qr0 = GLD(v4u, PROJ + mq0 * PA_LD, qo_); qr1 = GLD(v4u, PROJ + mq0 * PA_LD, qo_ + 64u); \
        _Pragma("unroll") for (int j2 = 0; j2 < 4; ++j2) qcs[j2] = GLD(f32x4, CS + mq0 * 32, cso_ + 16u * j2); } while (0)
    AT_QLOAD(0);
#pragma unroll
    for (int it = 0; it < 2; ++it) {
        const int task = tid + it * NTHR, kk = task >> 2, c = task & 3;
        v4u w0 = {0u, 0u, 0u, 0u}, w1 = {0u, 0u, 0u, 0u};
        if (jb > 0 || kk >= 128) {
            const unsigned ko = (unsigned)(kk * PA_LD + PC_AK + 64 * kvh + 8 * c) * 2u;
            const v4u r0 = GLD(v4u, PROJ + mk0 * PA_LD, ko), r1 = GLD(v4u, PROJ + mk0 * PA_LD, ko + 64u);
            float x0[8], x1[8]; float ss = 0.f;
#pragma unroll
            for (int j = 0; j < 4; ++j) { x0[2 * j] = pg8::bf_lo(r0[j]); x0[2 * j + 1] = pg8::bf_hi(r0[j]); x1[2 * j] = pg8::bf_lo(r1[j]); x1[2 * j + 1] = pg8::bf_hi(r1[j]); }
#pragma unroll
            for (int j = 0; j < 8; ++j) ss += x0[j] * x0[j] + x1[j] * x1[j];
            ss = quad_sum(ss);
            const float r = rsqf(ss * (1.f / 64.f) + EPS);
            const unsigned cso = (unsigned)(kk * 32 + 8 * c) * 8u;
            float o0[8], o1[8];
#pragma unroll
            for (int j2 = 0; j2 < 4; ++j2) { const f32x4 cs = GLD(f32x4, CS + mk0 * 32, cso + 16u * j2);
#pragma unroll
                for (int e = 0; e < 2; ++e) { const int j = 2 * j2 + e; const float cn = e ? cs.z : cs.x, sn = e ? cs.w : cs.y;
                    const float y0 = x0[j] * r * kn[8 * c + j], y1 = x1[j] * r * kn[32 + 8 * c + j];
                    o0[j] = y0 * cn - y1 * sn; o1[j] = y1 * cn + y0 * sn; } }
            w0 = (v4u){pk2c(o0[0], o0[1]), pk2c(o0[2], o0[3]), pk2c(o0[4], o0[5]), pk2c(o0[6], o0[7])};
            w1 = (v4u){pk2c(o1[0], o1[1]), pk2c(o1[2], o1[3]), pk2c(o1[4], o1[5]), pk2c(o1[6], o1[7])};
        }
        *(LAS v4u*)(Ks + kk * AT_KSTR + c * 16) = w0; *(LAS v4u*)(Ks + kk * AT_KSTR + 64 + c * 16) = w1;
    }
    {
        const int kk = tid & 255, dh = tid >> 8;
        v4u r[4] = {{0u, 0u, 0u, 0u}, {0u, 0u, 0u, 0u}, {0u, 0u, 0u, 0u}, {0u, 0u, 0u, 0u}};
        if (jb > 0 || kk >= 128) { const unsigned vo = (unsigned)(kk * PA_LD + PC_AV + 64 * kvh + 32 * dh) * 2u;
#pragma unroll
            for (int j = 0; j < 4; ++j) r[j] = GLD(v4u, PROJ + mk0 * PA_LD, vo + 16u * j); }
#pragma unroll
        for (int j = 0; j < 4; ++j)
#pragma unroll
            for (int e = 0; e < 4; ++e) { const unsigned w = r[j][e]; const int d = 32 * dh + 8 * j + 2 * e;
                *(LAS unsigned short*)(Vt + d * AT_VSTR + kk * 2) = (unsigned short)(w & 0xffffu);
                *(LAS unsigned short*)(Vt + (d + 1) * AT_VSTR + kk * 2) = (unsigned short)(w >> 16); }
    }
    LBAR();
    const float sinkl = par[PG_SINK + hq] * 1.44269504f;
    for (int it = 0; it < 4; ++it) {
        const int qt = (wave & 1) * 4 + it, qrel = 16 * qt + i16;
        bf16x8 qf0, qf1;
        {
            const v4u r0 = qr0, r1 = qr1;
            float x0[8], x1[8]; float ss = 0.f;
#pragma unroll
            for (int j = 0; j < 4; ++j) { x0[2 * j] = pg8::bf_lo(r0[j]); x0[2 * j + 1] = pg8::bf_hi(r0[j]); x1[2 * j] = pg8::bf_lo(r1[j]); x1[2 * j + 1] = pg8::bf_hi(r1[j]); }
#pragma unroll
            for (int j = 0; j < 8; ++j) ss += x0[j] * x0[j] + x1[j] * x1[j];
            ss = xrow_sum(ss);
            const float r = (0.125f * 1.44269504f) * rsqf(ss * (1.f / 64.f) + EPS);
            float o0[8], o1[8];
#pragma unroll
            for (int j2 = 0; j2 < 4; ++j2) { const f32x4 cs = qcs[j2];
#pragma unroll
                for (int e = 0; e < 2; ++e) { const int j = 2 * j2 + e; const float cn = e ? cs.z : cs.x, sn = e ? cs.w : cs.y;
                    const float y0 = x0[j] * r * qn[8 * quad + j], y1 = x1[j] * r * qn[32 + 8 * quad + j];
                    o0[j] = y0 * cn - y1 * sn; o1[j] = y1 * cn + y0 * sn; } }
            qf0 = mk8(pk2c(o0[0], o0[1]), pk2c(o0[2], o0[3]), pk2c(o0[4], o0[5]), pk2c(o0[6], o0[7]));
            qf1 = mk8(pk2c(o1[0], o1[1]), pk2c(o1[2], o1[3]), pk2c(o1[4], o1[5]), pk2c(o1[6], o1[7]));
        }
        if (it < 3) AT_QLOAD(it + 1);
        u32x2 gwv[4];
#pragma unroll
        for (int dt = 0; dt < 4; ++dt) gwv[dt] = GLD(u32x2, PROJ + mq0 * PA_LD, (unsigned)(qrel * PA_LD + PC_AG + 64 * hq + 16 * dt + 4 * quad) * 2u);
        f32x4 s[9];
#pragma unroll
        for (int t = 0; t < 9; ++t) { const LAS unsigned char* kp = Ks + (16 * (qt + t) + i16) * AT_KSTR + quad * 16;
            const bf16x8 a0 = *(const LAS bf16x8*)kp, a1 = *(const LAS bf16x8*)(kp + 64);
            f32x4 z = {0.f, 0.f, 0.f, 0.f}; z = MFMA16(a0, qf0, z); s[t] = MFMA16(a1, qf1, z); }
        float mx = sinkl;
        if (jb > 0) {
#pragma unroll
            for (int r = 0; r < 4; ++r) { s[0][r] = (4 * quad + r > i16) ? s[0][r] : -1.0e30f; s[8][r] = (4 * quad + r <= i16) ? s[8][r] : -1.0e30f; }
        } else {
#pragma unroll
            for (int t = 0; t < 9; ++t)
#pragma unroll
                for (int r = 0; r < 4; ++r) { const int kk = 16 * (qt + t) + 4 * quad + r;
                    const bool valid = (kk > qrel) && (kk <= qrel + 128) && (kk >= 128);
                    s[t][r] = valid ? s[t][r] : -1.0e30f; }
        }
#pragma unroll
        for (int t = 0; t < 9; ++t) mx = fmaxf(mx, fmaxf(fmaxf(s[t][0], s[t][1]), fmaxf(s[t][2], s[t][3])));
        mx = xrow_max(mx);
        float lsum = 0.f;
#pragma unroll
        for (int t = 0; t < 9; ++t)
#pragma unroll
            for (int r = 0; r < 4; ++r) { const float p = ex2(s[t][r] - mx); s[t][r] = p; lsum += p; }
        lsum = xrow_sum(lsum) + ex2(sinkl - mx);
        f32x4 o[4];
#pragma unroll
        for (int dt = 0; dt < 4; ++dt) o[dt] = (f32x4){0.f, 0.f, 0.f, 0.f};
#pragma unroll
        for (int st = 0; st < 5; ++st) { const int t0 = 2 * st, t1 = 2 * st + 1;
            bf16x8 pb;
            if (t1 < 9) pb = mk8(pk2c(s[t0][0], s[t0][1]), pk2c(s[t0][2], s[t0][3]), pk2c(s[t1][0], s[t1][1]), pk2c(s[t1][2], s[t1][3]));
            else pb = mk8(pk2c(s[t0][0], s[t0][1]), pk2c(s[t0][2], s[t0][3]), 0u, 0u);
            const int k0 = 16 * (qt + t0) + 4 * quad, k1 = t1 < 9 ? 16 * (qt + t1) + 4 * quad : k0;
#pragma unroll
            for (int dt = 0; dt < 4; ++dt) { const LAS unsigned char* vp = Vt + (16 * dt + i16) * AT_VSTR;
                const u32x2 lo = *(const LAS u32x2*)(vp + k0 * 2), hi = *(const LAS u32x2*)(vp + k1 * 2);
                o[dt] = MFMA16(mk8(lo, hi), pb, o[dt]); } }
        const float inv = __builtin_amdgcn_rcpf(lsum);
#pragma unroll
        for (int dt = 0; dt < 4; ++dt) { const int d0 = 16 * dt + 4 * quad;
            const u32x2 gw = gwv[dt];
            const float g0 = pg8::bf_lo(gw.x), g1 = pg8::bf_hi(gw.x), g2 = pg8::bf_lo(gw.y), g3 = pg8::bf_hi(gw.y);
            u32x2 ow; ow.x = pk2c(o[dt][0] * inv * siluf(g0), o[dt][1] * inv * siluf(g1)); ow.y = pk2c(o[dt][2] * inv * siluf(g2), o[dt][3] * inv * siluf(g3));
            GST(u32x2, YA + mq0 * 512, (unsigned)(qrel * 512 + 64 * hq + d0) * 2u) = ow; }
    }
    LBAR();
}


#undef AT_QLOAD
constexpr int GL_STR = 144;
constexpr int GL_QD = 0, GL_KI = 9216, GL_KET = 18432, GL_VT = 27648, GL_SEG = 46080, GL_BL = 48128, GL_PART = 48384;
__device__ __forceinline__ void gla_unit(int unit, const bf16* PROJ, const bf16* PX, const float* par_g, bf16* YB, LAS unsigned char* lds, int tid) {
    const GAS float* par = (const GAS float*)par_g;
    const int lane = tid & 63, wave = __builtin_amdgcn_readfirstlane(tid >> 6);
    const int b = unit >> 2, h = unit & 3, i16 = lane & 15, quad = lane >> 4;
    const int d = lane, tseg = wave, vA = tid & 127, q4 = wave >> 1, v0 = 16 * wave;
    LAS unsigned char* Qd = lds + GL_QD; LAS unsigned char* Ki = lds + GL_KI; LAS unsigned char* KeT = lds + GL_KET; LAS unsigned char* Vt = lds + GL_VT;
    LAS float* seg = (LAS float*)(lds + GL_SEG); LAS float* bl = (LAS float*)(lds + GL_BL); LAS float* part = (LAS float*)(lds + GL_PART);
    float Wg[16];
#pragma unroll
    for (int r = 0; r < 16; ++r) Wg[r] = par[PG_GWG + r * 256 + 64 * h + d];
    const float bgd = par[PG_GBG + 64 * h + d];
    const float gon = par[PG_GON + v0 + i16];
    f32x4 S[4];
#pragma unroll
    for (int i = 0; i < 4; ++i) S[i] = (f32x4){0.f, 0.f, 0.f, 0.f};
    unsigned gdw; unsigned short qs[8], ks[8], vv[16];
#define GLA_LOADS(mm) do { const bf16* ub_ = PROJ + ((mm) + 8 * tseg) * PG_LD; const bf16* uv_ = PROJ + ((mm) + 16 * q4) * PG_LD; \
        gdw = GLD(unsigned, PX + ((mm) + 8 * tseg) * PX_LD, (unsigned)((lane >> 3) * PX_LD + PC_GD + 2 * (lane & 7)) * 2u); \
        _Pragma("unroll") for (int i = 0; i < 8; ++i) { qs[i] = GLD(unsigned short, ub_ + i * PG_LD, (unsigned)(PC_GQ + 64 * h + d) * 2u); ks[i] = GLD(unsigned short, ub_ + i * PG_LD, (unsigned)(PC_GK + 64 * h + d) * 2u); } \
        _Pragma("unroll") for (int i = 0; i < 16; ++i) vv[i] = GLD(unsigned short, uv_ + i * PG_LD, (unsigned)(PC_GV + 128 * h + vA) * 2u); } while (0)
    GLA_LOADS((size_t)b * SEQ);
    for (int ch = 0; ch < SEQ / 64; ++ch) {
        const size_t m0 = (size_t)b * SEQ + ch * 64;
        float la[8], qv[8], kv[8];
#pragma unroll
        for (int i = 0; i < 8; ++i) { float lg = bgd;
#pragma unroll
            for (int j = 0; j < 8; ++j) { const unsigned w = (unsigned)__builtin_amdgcn_readlane((int)gdw, i * 8 + j); lg += pg8::bf_lo(w) * Wg[2 * j] + pg8::bf_hi(w) * Wg[2 * j + 1]; }
            la[i] = logsigmoidf(lg) * (1.f / 16.f); qv[i] = bf2f(qs[i]); kv[i] = bf2f(ks[i]); }
#pragma unroll
        for (int i = 1; i < 8; ++i) la[i] += la[i - 1];
        seg[tseg * 64 + d] = la[7];
        LBAR();
        float off = 0.f, tot = 0.f;
#pragma unroll
        for (int s = 0; s < 8; ++s) { const float x = seg[s * 64 + d]; tot += x; off += (s < tseg) ? x : 0.f; }
        if (tseg == 0) bl[d] = __expf(tot);
        {
            float ke[8];
#pragma unroll
            for (int i = 0; i < 8; ++i) { const float bc = off + la[i]; const int t = 8 * tseg + i;
                const float qd = qv[i] * 0.125f * __expf(bc), ki = kv[i] * __expf(-bc); ke[i] = kv[i] * __expf(tot - bc);
                *(LAS unsigned short*)(Qd + t * GL_STR + d * 2) = (unsigned short)f2bf(qd);
                *(LAS unsigned short*)(Ki + t * GL_STR + d * 2) = (unsigned short)f2bf(ki); }
            *(LAS v4u*)(KeT + d * GL_STR + 16 * tseg) = (v4u){pk2c(ke[0], ke[1]), pk2c(ke[2], ke[3]), pk2c(ke[4], ke[5]), pk2c(ke[6], ke[7])};
            v4u w0, w1;
#pragma unroll
            for (int j = 0; j < 4; ++j) { w0[j] = (unsigned)vv[2 * j] | ((unsigned)vv[2 * j + 1] << 16); w1[j] = (unsigned)vv[8 + 2 * j] | ((unsigned)vv[8 + 2 * j + 1] << 16); }
            *(LAS v4u*)(Vt + vA * GL_STR + 32 * q4) = w0; *(LAS v4u*)(Vt + vA * GL_STR + 32 * q4 + 16) = w1;
        }
        if (ch + 1 < SEQ / 64) GLA_LOADS(m0 + 64);
        LBAR();
        float gt[4][4];
#pragma unroll
        for (int I = 0; I < 4; ++I)
#pragma unroll
            for (int r = 0; r < 4; ++r) gt[I][r] = bf2f(GLD(unsigned short, PROJ + (m0 + 16 * I + r) * PG_LD, (unsigned)(4 * quad * PG_LD + PC_GG + 128 * h + v0 + i16) * 2u));
        f32x4 oacc[4];
        {
            bf16x8 kiA[4][2], qdB[4][2];
#pragma unroll
            for (int J = 0; J < 4; ++J)
#pragma unroll
                for (int s = 0; s < 2; ++s) { kiA[J][s] = *(const LAS bf16x8*)(Ki + (16 * J + i16) * GL_STR + quad * 16 + 64 * s); qdB[J][s] = *(const LAS bf16x8*)(Qd + (16 * J + i16) * GL_STR + quad * 16 + 64 * s); }
            f32x4 at[4][4];
#pragma unroll
            for (int I = 0; I < 4; ++I)
#pragma unroll
                for (int J = 0; J <= I; ++J) { f32x4 z = {0.f, 0.f, 0.f, 0.f}; z = MFMA16(kiA[J][0], qdB[I][0], z); z = MFMA16(kiA[J][1], qdB[I][1], z);
                    if (J == I) {
#pragma unroll
                        for (int r = 0; r < 4; ++r) z[r] = (4 * quad + r <= i16) ? z[r] : 0.f; }
                    at[J][I] = z; }
            const LAS unsigned char* vrow = Vt + (v0 + i16) * GL_STR;
            const bf16x8 vB01 = mk8(*(const LAS u32x2*)(vrow + (0 + 4 * quad) * 2), *(const LAS u32x2*)(vrow + (16 + 4 * quad) * 2));
            const bf16x8 vB23 = mk8(*(const LAS u32x2*)(vrow + (32 + 4 * quad) * 2), *(const LAS u32x2*)(vrow + (48 + 4 * quad) * 2));
#define PK4(x, y) mk8(pk2c((x)[0], (x)[1]), pk2c((x)[2], (x)[3]), pk2c((y)[0], (y)[1]), pk2c((y)[2], (y)[3]))
#define PK4Z(x) mk8(pk2c((x)[0], (x)[1]), pk2c((x)[2], (x)[3]), 0u, 0u)
            const f32x4 zz = {0.f, 0.f, 0.f, 0.f};
            oacc[0] = MFMA16(PK4Z(at[0][0]), vB01, zz);
            oacc[1] = MFMA16(PK4(at[0][1], at[1][1]), vB01, zz);
            oacc[2] = MFMA16(PK4(at[0][2], at[1][2]), vB01, zz); oacc[2] = MFMA16(PK4Z(at[2][2]), vB23, oacc[2]);
            oacc[3] = MFMA16(PK4(at[0][3], at[1][3]), vB01, zz); oacc[3] = MFMA16(PK4(at[2][3], at[3][3]), vB23, oacc[3]);
        }
        {
            const bf16x8 sB0 = PK4(S[0], S[1]), sB1 = PK4(S[2], S[3]);
#pragma unroll
            for (int I = 0; I < 4; ++I) { const LAS unsigned char* qrow = Qd + (16 * I + i16) * GL_STR;
                const bf16x8 a0 = mk8(*(const LAS u32x2*)(qrow + (0 + 4 * quad) * 2), *(const LAS u32x2*)(qrow + (16 + 4 * quad) * 2));
                const bf16x8 a1 = mk8(*(const LAS u32x2*)(qrow + (32 + 4 * quad) * 2), *(const LAS u32x2*)(qrow + (48 + 4 * quad) * 2));
                oacc[I] = MFMA16(a0, sB0, oacc[I]); oacc[I] = MFMA16(a1, sB1, oacc[I]); }
        }
        {
            const LAS unsigned char* vrow = Vt + (v0 + i16) * GL_STR + quad * 16;
            const bf16x8 vb0 = *(const LAS bf16x8*)vrow, vb1 = *(const LAS bf16x8*)(vrow + 64);
#pragma unroll
            for (int dt = 0; dt < 4; ++dt) { const f32x4 e = *(const LAS f32x4*)(bl + 16 * dt + 4 * quad); const LAS unsigned char* krow = KeT + (16 * dt + i16) * GL_STR + quad * 16;
                f32x4 z = S[dt] * e; z = MFMA16(*(const LAS bf16x8*)krow, vb0, z); S[dt] = MFMA16(*(const LAS bf16x8*)(krow + 64), vb1, z); }
        }
#pragma unroll
        for (int I = 0; I < 4; ++I) { f32x4 q = oacc[I] * oacc[I];
#pragma unroll
            for (int r = 0; r < 4; ++r) q[r] = row16_sum(q[r]);
            if (i16 == 0) *(LAS f32x4*)(part + wave * 64 + 16 * I + 4 * quad) = q; }
        LBAR();
#pragma unroll
        for (int I = 0; I < 4; ++I) { f32x4 tot4 = {0.f, 0.f, 0.f, 0.f};
#pragma unroll
            for (int w = 0; w < 8; ++w) tot4 += *(const LAS f32x4*)(part + w * 64 + 16 * I + 4 * quad);
#pragma unroll
            for (int r = 0; r < 4; ++r) { const float rs = rsqf(tot4[r] * (1.f / 128.f) + EPS);
                GST(unsigned short, YB + (m0 + 16 * I + r) * 512, (unsigned)(4 * quad * 512 + 128 * h + v0 + i16) * 2u) = (unsigned short)f2bf(oacc[I][r] * rs * gon * siluf(gt[I][r])); } }
    }
    LBAR();
#undef PK4
#undef PK4Z
#undef GLA_LOADS
}

constexpr int SD_XT = 0, SD_XW = 36864, SD_BN = 73728, SD_BT = 91136, SD_CN = 109568, SD_GS = 126976, SD_SM = 144384, SD_PART = 148544;
constexpr int SD_XSTR = 144, SD_NSTR = 272;
typedef float f32x2s __attribute__((ext_vector_type(2)));
__device__ __forceinline__ void ssd_unit(int unit, const bf16* PROJ, const bf16* PX, const float* par_g, bf16* YC, LAS unsigned char* lds, int tid) {
    const GAS float* par = (const GAS float*)par_g;
    const int lane = tid & 63, wave = __builtin_amdgcn_readfirstlane(tid >> 6);
    const int b = unit >> 1, g = unit & 1, i16 = lane & 15, quad = lane >> 4;
    const int hl = wave >> 1, ph = wave & 1;
    LAS unsigned char* XT = lds + SD_XT; LAS unsigned char* XW = lds + SD_XW; LAS unsigned char* BN = lds + SD_BN; LAS unsigned char* BT = lds + SD_BT; LAS unsigned char* CN = lds + SD_CN;
    LAS float* GS = (LAS float*)(lds + SD_GS); LAS float* SDT = (LAS float*)(lds + SD_SM); LAS float* SACS = SDT + 256; LAS float* SW = SACS + 256; LAS float* SEA = SW + 256; LAS float* EAL = SEA + 256;
    LAS float* PART = (LAS float*)(lds + SD_PART);
    const int th = wave >> 2, lc0_ = 2 * (tid & 255);
#define SSD_CIDX(lc) ((lc) < 256 ? 256 * g + (lc) : ((lc) < 384 ? 512 + 128 * g + ((lc) - 256) : 768 + 128 * g + ((lc) - 384)))
    const int chb0 = 64 * hl + 32 * ph;
    f32x4 H[8][2];
#pragma unroll
    for (int i = 0; i < 8; ++i) { H[i][0] = (f32x4){0.f, 0.f, 0.f, 0.f}; H[i][1] = (f32x4){0.f, 0.f, 0.f, 0.f}; }
    unsigned raw[35]; unsigned short dtr;
#define SSD_LOADS(mm, first) do { const bf16* ub_ = PROJ + ((long)(mm) + 32 * th - 3) * PS_LD; \
        _Pragma("unroll") for (int i = 0; i < 35; ++i) { raw[i] = 0u; if (!(first) || th > 0 || i >= 3) raw[i] = GLD(unsigned, ub_ + i * PS_LD, (unsigned)(PC_XBC + cidx) * 2u); } \
        dtr = GLD(unsigned short, PX + (mm) * PX_LD, (unsigned)(lane * PX_LD + PC_DT + 4 * g + (wave & 3)) * 2u); } while (0)
    { const int cidx = SSD_CIDX(lc0_); SSD_LOADS((size_t)b * SEQ, true); }
    for (int ch = 0; ch < SEQ / 64; ++ch) {
        const size_t m0 = (size_t)b * SEQ + ch * 64;
        int lc0 = lc0_; asm volatile("" : "+v"(lc0));
        const int cidx = SSD_CIDX(lc0);
        const f32x2s cw0 = *(const GAS f32x2s*)(par + PG_CW + 0 * 1024 + cidx), cw1 = *(const GAS f32x2s*)(par + PG_CW + 1 * 1024 + cidx), cw2 = *(const GAS f32x2s*)(par + PG_CW + 2 * 1024 + cidx),
                      cw3 = *(const GAS f32x2s*)(par + PG_CW + 3 * 1024 + cidx), cbv = *(const GAS f32x2s*)(par + PG_CB + cidx);
        const float wa0 = cw0.x, wb0 = cw0.y, wa1 = cw1.x, wb1 = cw1.y, wa2 = cw2.x, wb2 = cw2.y, wa3 = cw3.x, wb3 = cw3.y, cba = cbv.x, cbb = cbv.y;
        if (wave < 4) {
            const float dtb = par[PG_DTB + 4 * g + wave], negA = -__expf(par[PG_ALOG + 4 * g + wave]);
            const float dt = softplusf(bf2f(dtr) + dtb); float acs = dt * negA;
            acs += dpp_f<0x111>(acs); acs += dpp_f<0x112>(acs); acs += dpp_f<0x114>(acs); acs += dpp_f<0x118>(acs);
            acs += dpp_f<0x142, 0xA>(acs);
            acs += dpp_f<0x143, 0xC>(acs);
            const float alast = __builtin_bit_cast(float, __builtin_amdgcn_readlane(__builtin_bit_cast(int, acs), 63));
            SDT[wave * 64 + lane] = dt; SACS[wave * 64 + lane] = acs; SW[wave * 64 + lane] = dt * __expf(alast - acs); SEA[wave * 64 + lane] = __expf(acs);
            if (lane == 0) EAL[wave] = __expf(alast);
        }
        LBAR();
        {
            float ua0 = pg8::bf_lo(raw[0]), ua1 = pg8::bf_lo(raw[1]), ua2 = pg8::bf_lo(raw[2]), ub0 = pg8::bf_hi(raw[0]), ub1 = pg8::bf_hi(raw[1]), ub2 = pg8::bf_hi(raw[2]);
#pragma unroll
            for (int grp = 0; grp < 4; ++grp) {
                float xa[8], xb[8];
#pragma unroll
                for (int i = 0; i < 8; ++i) { const unsigned wv = raw[3 + 8 * grp + i]; const float ua3 = pg8::bf_lo(wv), ub3 = pg8::bf_hi(wv);
                    const float pa = cba + wa0 * ua0 + wa1 * ua1 + wa2 * ua2 + wa3 * ua3, pb = cbb + wb0 * ub0 + wb1 * ub1 + wb2 * ub2 + wb3 * ub3;
                    xa[i] = pa * __builtin_amdgcn_rcpf(1.f + __expf(-pa)); xb[i] = pb * __builtin_amdgcn_rcpf(1.f + __expf(-pb));
                    ua0 = ua1; ua1 = ua2; ua2 = ua3; ub0 = ub1; ub1 = ub2; ub2 = ub3; }
                const int t0 = 32 * th + 8 * grp;
                const v4u pka = {pk2c(xa[0], xa[1]), pk2c(xa[2], xa[3]), pk2c(xa[4], xa[5]), pk2c(xa[6], xa[7])}, pkb = {pk2c(xb[0], xb[1]), pk2c(xb[2], xb[3]), pk2c(xb[4], xb[5]), pk2c(xb[6], xb[7])};
                if (lc0 < 256) {
                    *(LAS v4u*)(XT + lc0 * SD_XSTR + t0 * 2) = pka; *(LAS v4u*)(XT + (lc0 + 1) * SD_XSTR + t0 * 2) = pkb;
                    const f32x4 wa = *(const LAS f32x4*)(SW + (lc0 >> 6) * 64 + t0), wb = *(const LAS f32x4*)(SW + (lc0 >> 6) * 64 + t0 + 4);
                    *(LAS v4u*)(XW + lc0 * SD_XSTR + t0 * 2) = (v4u){pk2c(xa[0] * wa[0], xa[1] * wa[1]), pk2c(xa[2] * wa[2], xa[3] * wa[3]), pk2c(xa[4] * wb[0], xa[5] * wb[1]), pk2c(xa[6] * wb[2], xa[7] * wb[3])};
                    *(LAS v4u*)(XW + (lc0 + 1) * SD_XSTR + t0 * 2) = (v4u){pk2c(xb[0] * wa[0], xb[1] * wa[1]), pk2c(xb[2] * wa[2], xb[3] * wa[3]), pk2c(xb[4] * wb[0], xb[5] * wb[1]), pk2c(xb[6] * wb[2], xb[7] * wb[3])};
                } else if (lc0 < 384) { const int n = lc0 - 256;
                    *(LAS v4u*)(BT + n * SD_XSTR + t0 * 2) = pka; *(LAS v4u*)(BT + (n + 1) * SD_XSTR + t0 * 2) = pkb;
#pragma unroll
                    for (int i = 0; i < 8; ++i) *(LAS unsigned*)(BN + (t0 + i) * SD_NSTR + n * 2) = pk2c(xa[i], xb[i]);
                } else { const int n = lc0 - 384;
#pragma unroll
                    for (int i = 0; i < 8; ++i) *(LAS unsigned*)(CN + (t0 + i) * SD_NSTR + n * 2) = pk2c(xa[i], xb[i]);
                }
            }
        }
        if (ch + 1 < SEQ / 64) SSD_LOADS(m0 + 64, false);
        LBAR();
        {
#pragma unroll
            for (int rep = 0; rep < 2; ++rep) { const int ti = wave + 8 * rep;
                if (ti < 10) { const int S_ = ti < 4 ? 0 : (ti < 7 ? 1 : (ti < 9 ? 2 : 3)); const int L_ = ti < 4 ? ti : (ti < 7 ? ti - 3 : (ti < 9 ? ti - 5 : 3));
                    f32x4 z = {0.f, 0.f, 0.f, 0.f};
#pragma unroll
                    for (int ks = 0; ks < 4; ++ks) z = MFMA16(*(const LAS bf16x8*)(BN + (16 * S_ + i16) * SD_NSTR + quad * 16 + 64 * ks), *(const LAS bf16x8*)(CN + (16 * L_ + i16) * SD_NSTR + quad * 16 + 64 * ks), z);
#pragma unroll
                    for (int r = 0; r < 4; ++r) GS[(16 * S_ + 4 * quad + r) * 68 + 16 * L_ + i16] = z[r]; } }
        }
        LBAR();
        unsigned zg[4][4];
#pragma unroll
        for (int L = 0; L < 4; ++L)
#pragma unroll
            for (int r = 0; r < 4; ++r) zg[L][r] = GLD(unsigned, PROJ + (m0 + 16 * L + r) * PS_LD, (unsigned)(4 * quad * PS_LD + PC_SZ + 256 * g + chb0 + 2 * i16) * 2u);
        f32x4 yd[4][2];
#define PK4(x, y) mk8(pk2c((x)[0], (x)[1]), pk2c((x)[2], (x)[3]), pk2c((y)[0], (y)[1]), pk2c((y)[2], (y)[3]))
#define PK4Z(x) mk8(pk2c((x)[0], (x)[1]), pk2c((x)[2], (x)[3]), 0u, 0u)
        {
            const f32x4 zz = {0.f, 0.f, 0.f, 0.f};
#pragma unroll
            for (int L = 0; L < 4; ++L) { yd[L][0] = zz; yd[L][1] = zz; }
#pragma unroll
            for (int ks = 0; ks < 4; ++ks) { __builtin_amdgcn_sched_barrier(0); const bf16x8 hB0 = PK4(H[2 * ks][0], H[2 * ks + 1][0]), hB1 = PK4(H[2 * ks][1], H[2 * ks + 1][1]);
#pragma unroll
                for (int L = 0; L < 4; ++L) { const LAS unsigned char* cr = CN + (16 * L + i16) * SD_NSTR + (32 * ks + 4 * quad) * 2;
                    const bf16x8 ca = mk8(*(const LAS u32x2*)cr, *(const LAS u32x2*)(cr + 32));
                    yd[L][0] = MFMA16(ca, hB0, yd[L][0]); yd[L][1] = MFMA16(ca, hB1, yd[L][1]); } }
#pragma unroll
            for (int L = 0; L < 4; ++L) { const f32x4 ea = *(const LAS f32x4*)(SEA + hl * 64 + 16 * L + 4 * quad); yd[L][0] *= ea; yd[L][1] *= ea; }
        }
        __builtin_amdgcn_sched_barrier(0);
        {
            bf16x8 xB01[2], xB23[2];
#pragma unroll
            for (int pt = 0; pt < 2; ++pt) { const LAS unsigned char* xr = XT + (chb0 + 2 * i16 + pt) * SD_XSTR;
                xB01[pt] = mk8(*(const LAS u32x2*)(xr + (0 + 4 * quad) * 2), *(const LAS u32x2*)(xr + (16 + 4 * quad) * 2));
                xB23[pt] = mk8(*(const LAS u32x2*)(xr + (32 + 4 * quad) * 2), *(const LAS u32x2*)(xr + (48 + 4 * quad) * 2)); }
#pragma unroll
            for (int L = 0; L < 4; ++L) { __builtin_amdgcn_sched_barrier(0); const float acs_l = SACS[hl * 64 + 16 * L + i16];
                f32x4 mt[4];
#pragma unroll
                for (int S_ = 0; S_ <= L; ++S_) { const f32x4 acs_s = *(const LAS f32x4*)(SACS + hl * 64 + 16 * S_ + 4 * quad), dt_s = *(const LAS f32x4*)(SDT + hl * 64 + 16 * S_ + 4 * quad);
#pragma unroll
                    for (int r = 0; r < 4; ++r) { const float gv = GS[(16 * S_ + 4 * quad + r) * 68 + 16 * L + i16]; const float v = gv * __expf(acs_l - acs_s[r]) * dt_s[r];
                        mt[S_][r] = (S_ < L || 4 * quad + r <= i16) ? v : 0.f; } }
#pragma unroll
                for (int pt = 0; pt < 2; ++pt) {
                    if (L == 0) yd[L][pt] = MFMA16(PK4Z(mt[0]), xB01[pt], yd[L][pt]);
                    else if (L == 1) yd[L][pt] = MFMA16(PK4(mt[0], mt[1]), xB01[pt], yd[L][pt]);
                    else if (L == 2) { yd[L][pt] = MFMA16(PK4(mt[0], mt[1]), xB01[pt], yd[L][pt]); yd[L][pt] = MFMA16(PK4Z(mt[2]), xB23[pt], yd[L][pt]); }
                    else { yd[L][pt] = MFMA16(PK4(mt[0], mt[1]), xB01[pt], yd[L][pt]); yd[L][pt] = MFMA16(PK4(mt[2], mt[3]), xB23[pt], yd[L][pt]); } } }
        }
        __builtin_amdgcn_sched_barrier(0);
        {
            const float eal = EAL[hl];
            bf16x8 xw[2][2];
#pragma unroll
            for (int pt = 0; pt < 2; ++pt)
#pragma unroll
                for (int k2 = 0; k2 < 2; ++k2) xw[pt][k2] = *(const LAS bf16x8*)(XW + (chb0 + 2 * i16 + pt) * SD_XSTR + quad * 16 + 64 * k2);
#pragma unroll
            for (int nt = 0; nt < 8; ++nt) { if ((nt & 1) == 0) __builtin_amdgcn_sched_barrier(0); const LAS unsigned char* br = BT + (16 * nt + i16) * SD_XSTR + quad * 16;
                const bf16x8 b0 = *(const LAS bf16x8*)br, b1 = *(const LAS bf16x8*)(br + 64);
#pragma unroll
                for (int pt = 0; pt < 2; ++pt) { f32x4 z = H[nt][pt] * eal; z = MFMA16(b0, xw[pt][0], z); H[nt][pt] = MFMA16(b1, xw[pt][1], z); } }
        }
        __builtin_amdgcn_sched_barrier(0);
        const float Dk = par[PG_DSK + 4 * g + hl]; const f32x2s onv = *(const GAS f32x2s*)(par + PG_SON + 256 * g + chb0 + 2 * i16); const float on0 = onv.x, on1 = onv.y;
#pragma unroll
        for (int L = 0; L < 4; ++L) { f32x4 q = {0.f, 0.f, 0.f, 0.f};
#pragma unroll
            for (int pt = 0; pt < 2; ++pt) { const u32x2 xw2 = *(const LAS u32x2*)(XT + (chb0 + 2 * i16 + pt) * SD_XSTR + (16 * L + 4 * quad) * 2);
                const float xv[4] = {pg8::bf_lo(xw2.x), pg8::bf_hi(xw2.x), pg8::bf_lo(xw2.y), pg8::bf_hi(xw2.y)};
#pragma unroll
                for (int r = 0; r < 4; ++r) { const float y = yd[L][pt][r] + Dk * xv[r]; const float u = y * siluf(pt ? pg8::bf_hi(zg[L][r]) : pg8::bf_lo(zg[L][r])); yd[L][pt][r] = u; q[r] += u * u; } }
#pragma unroll
            for (int r = 0; r < 4; ++r) q[r] = row16_sum(q[r]);
            if (i16 == 0) *(LAS f32x4*)(PART + wave * 64 + 16 * L + 4 * quad) = q; }
        LBAR();
#pragma unroll
        for (int L = 0; L < 4; ++L) { f32x4 tot4 = {0.f, 0.f, 0.f, 0.f};
#pragma unroll
            for (int w = 0; w < 8; ++w) tot4 += *(const LAS f32x4*)(PART + w * 64 + 16 * L + 4 * quad);
#pragma unroll
            for (int r = 0; r < 4; ++r) { const float rs = rsqf(tot4[r] * (1.f / 256.f) + EPS); GST(unsigned, YC + (m0 + 16 * L + r) * 512, (unsigned)(4 * quad * 512 + 256 * g + chb0 + 2 * i16) * 2u) = pk2c(yd[L][0][r] * rs * on0, yd[L][1][r] * rs * on1); } }
    }
    LBAR();
#undef PK4
#undef PK4Z
#undef SSD_LOADS
#undef SSD_CIDX
}


struct MgOrder {
    int xcd, nloc, first, stride;
    __device__ __forceinline__ void init(int bx) { xcd = bx & 7; if (bx < 64) { nloc = 9; first = 312 + (bx >> 3); stride = 8; } else { nloc = 13; first = (bx - 64) >> 3; stride = 24; } }
    __device__ __forceinline__ bool next(int i, pg8::Unit& u) const { if (i >= nloc) return false; const int off = first + i * stride, grp = off / 96, w = off % 96; u.pm = (xcd * 4 + grp) * 8 + (w & 7); u.pn = w >> 3; return true; }
    __device__ __forceinline__ void a_ready(const pg8::Unit&) const {}
    __device__ __forceinline__ void done(const pg8::Unit&) const {}
};

struct Merge3Order {
    pg8::StaticOrder S;
    __device__ __forceinline__ bool next(int i, pg8::Unit& u) const { const int j = i / 3, br = i - 3 * j; const int R = S.nwg / S.G; if (!S.next((S.nwg == R * S.G && j < R) ? R - 1 - j : j, u)) return false;
        u.pm += br * 256; u.pn += br * 4; return true; }
    __device__ __forceinline__ void a_ready(const pg8::Unit&) const {}
    __device__ __forceinline__ void done(const pg8::Unit&) const {}
};

__global__ void __launch_bounds__(NTHR, 2) mega_fwd(Args args) {
    extern __shared__ __attribute__((aligned(16))) unsigned char lds_raw[];
    LAS unsigned char* lds = (LAS unsigned char*)lds_raw;
    volatile LAS unsigned* MISC = (volatile LAS unsigned*)(lds + MISC_OFF);
    const int tid = threadIdx.x, lane = tid & 63, wave = __builtin_amdgcn_readfirstlane(tid >> 6);
    const int G = gridDim.x, bx = blockIdx.x;
    unsigned char* ws = args.ws;
    gu32* ctl = (gu32*)(ws + WS_CTL);
    const float* x_in = (const float*)args.in[0];
    float* out = args.out;

    for (int u = tid; u < (LDS_BYTES - LDSCTL_OFF) / 4; u += NTHR) ((LAS unsigned*)(lds + LDSCTL_OFF))[u] = 0u;
    __syncthreads();
    XcdBarrier bar = xcd_barrier_post((unsigned*)(ctl + CW_BAR) + args.li * XCD_BAR_WORDS, MISC + 8);
    const int lo = args.ph_lo, hi = args.ph_hi; (void)lo; (void)hi;
#define IN(k) (lo <= (k) && (k) < hi)
#define OWS() ({ unsigned char* w_ = ws; asm volatile("" : "+s"(w_)); w_; })
#define WIN ((bf16*)(OWS() + WS_WIN))
#define WB ((bf16*)(OWS() + WS_WB))
#define WO ((bf16*)(OWS() + WS_WO))
#define XN ((bf16*)(OWS() + WS_XN))
#define Y ((bf16*)(OWS() + WS_Y))
#define PA ((bf16*)(OWS() + WS_PA))
#define PG ((bf16*)(OWS() + WS_PG))
#define PS ((bf16*)(OWS() + WS_PS))
#define PX ((bf16*)(OWS() + WS_PX))
#define MG ((bf16*)(OWS() + WS_MG))
#define MERGED ((bf16*)(OWS() + WS_MERGED))
#define CS ((float2*)(OWS() + WS_CS))
#define KR ((float*)(OWS() + WS_KR))
#define PAR ((float*)(OWS() + WS_PAR))
#define otid() ({ int t_ = tid; asm volatile("" : "+v"(t_)); t_; })
#define SEAM(k) do { if (IN(k) && IN((k) + 1)) xcd_barrier(bar); } while (0)
    const int gw = bx * NWAVES + wave, NGW = G * NWAVES;

    if (IN(0)) {
        LAS float* scr = (LAS float*)(lds + RING_OFF + wave * 16384);
        constexpr int I_IN = (D / 64) * (NINP / 32), I_B = (512 / 64) * (D / 32), I_O = (D / 64) * (D / 32);
        constexpr int NITEMS = DEPTH * (I_IN + 3 * I_B + I_O);
        for (int it = gw; it < NITEMS; it += NGW) {
            int r = it; const int l = r / (I_IN + 3 * I_B + I_O); r -= l * (I_IN + 3 * I_B + I_O);
            if (r < I_IN) { transpose_item<true>((const float*)args.in[3] + (size_t)l * D * NIN, D, NIN, WIN + (size_t)l * NINP * D, scr, r, NINP / 32, lane, l > 0 ? (const float*)args.in[2] + (size_t)l * D : nullptr); continue; } r -= I_IN;
            if (r < 3 * I_B) { const int n = r / I_B; r -= n * I_B;
                transpose_item<false>((const float*)args.in[16] + (size_t)(l * 3 + n) * 512 * D, 512, D, WB + (size_t)(l * 3 + n) * D * 512, scr, r, D / 32, lane); continue; } r -= 3 * I_B;
            transpose_item<false>((const float*)args.in[17] + (size_t)l * D * D, D, D, WO + (size_t)l * D * D, scr, r, D / 32, lane);
        }
        for (int m = 2 * gw; m < M; m += 2 * NGW) rms_rows2_to_bf16(x_in + (size_t)m * D, x_in + (size_t)(m + 1) * D, (const float*)args.in[2], XN + (size_t)m * D, XN + (size_t)(m + 1) * D, lane);
        for (int e = bx * NTHR + tid; e < M * 32; e += G * NTHR) { const int m = e >> 5, i = e & 31;
            const float inv = exp2f(-(float)(2 * i) * (13.287712379549449f / 64.f)); const float ang = (float)((const int*)args.in[1])[m] * inv; const float rev = ang * 0.15915494309189535f; const float fr = rev - floorf(rev);
            *(GAS f32x2s*)(CS + e) = (f32x2s){__builtin_amdgcn_cosf(fr), __builtin_amdgcn_sinf(fr)}; }
        {
            const int gt = bx * NTHR + tid, GT = G * NTHR;
#define CPY(idx, off, n) for (int e = gt; e < DEPTH * (n); e += GT) *(GAS float*)(PAR + (e / (n)) * PSTRIDE + (off) + e % (n)) = ((const GAS float*)args.in[idx])[e]
            CPY(2, PG_NORM, 1024); CPY(4, PG_QN, 64); CPY(5, PG_KN, 64); CPY(6, PG_SINK, 8); CPY(7, PG_GWG, 4096); CPY(8, PG_GBG, 256); CPY(9, PG_GON, 128);
            CPY(10, PG_CW, 4096); CPY(11, PG_CB, 1024); CPY(12, PG_DTB, 8); CPY(13, PG_ALOG, 8); CPY(14, PG_DSK, 8); CPY(15, PG_SON, 512);
#undef CPY
        }
    }
    SEAM(0);

    for (int l = 0; l < DEPTH; ++l) {
        const int pb = 1 + 7 * l;
        const float* xin = l == 0 ? x_in : out;
        const float* par = PAR + l * PSTRIDE;
        if (IN(pb + 0)) {
            pg8::Gemm g{XN, WIN + (size_t)l * NINP * D, M, NMAIN, D}; pg8::StaticOrder S; S.init(M, NMAIN, G, bx);
            pg8::EpiProj E{PA, PG, PS, PX, l > 0 ? (const float*)(OWS() + WS_RINV) : nullptr};
            pg8::gemm_phase<pg8::EpiProj, pg8::StaticOrder, true, true>(lds + RING_OFF, g, S, E, otid());
        }
        SEAM(pb + 0);
        if (IN(pb + 2)) {
            for (int uu = bx; uu < 192; uu += G) {
            if (uu < 64) ssd_unit(uu, PS, PX, par, Y + (size_t)2 * M * 512, lds, otid());
            else { gla_unit(uu - 64, PG, PX, par, Y + (size_t)1 * M * 512, lds, otid()); if (otid() == 0) __hip_atomic_fetch_add((unsigned*)(ctl + CW_DONE + 64 * l), 1u, __ATOMIC_RELAXED, __HIP_MEMORY_SCOPE_AGENT); }
            }
            unsigned qn = 0; if (otid() == 0) qn = __hip_atomic_fetch_add((unsigned*)(ctl + CW_Q + 64 * l), 1u, __ATOMIC_RELAXED, __HIP_MEMORY_SCOPE_AGENT);
            for (;;) {
                __syncthreads();
                if (otid() == 0) MISC[0] = qn;
                __syncthreads();
                const unsigned item = (unsigned)__builtin_amdgcn_readfirstlane((int)MISC[0]);
                if (item >= 1024u) break;
                if (otid() == 0) qn = __hip_atomic_fetch_add((unsigned*)(ctl + CW_Q + 64 * l), 1u, __ATOMIC_RELAXED, __HIP_MEMORY_SCOPE_AGENT);
                attn_unit((int)item, PA, CS, par, Y, lds, otid());
                if (otid() == 0) __hip_atomic_fetch_add((unsigned*)(ctl + CW_DONE + 64 * l), 1u, __ATOMIC_RELAXED, __HIP_MEMORY_SCOPE_AGENT);
            }
        }
        const bool ovl = (G == 256) && IN(pb + 2) && IN(pb + 3);
        if (!ovl) SEAM(pb + 2);
        if (IN(pb + 3)) {
            pg8::Gemm g{XN, WIN + (size_t)l * NINP * D + (size_t)NMAIN * D, M, NMG, D};
            pg8::EpiGate E{MG, NMG, l > 0 ? (const float*)(OWS() + WS_RINV) : nullptr};
            if (ovl) {
                if (otid() == 0) { unsigned sp_ = 0; while (__hip_atomic_load((unsigned*)(ctl + CW_DONE + 64 * l), __ATOMIC_RELAXED, __HIP_MEMORY_SCOPE_AGENT) < (unsigned)N_AG_UNITS) { __builtin_amdgcn_s_sleep(8);
                        if (++sp_ > (1u << 22)) { __hip_atomic_store((unsigned*)(ctl + CW_TMO), 1u, __ATOMIC_RELAXED, __HIP_MEMORY_SCOPE_AGENT); break; } } }
                __syncthreads();
                MgOrder S; S.init(bx);
                pg8::gemm_phase<pg8::EpiGate, MgOrder, true, true>(lds + RING_OFF, g, S, E, otid());
            } else {
                pg8::StaticOrder S; S.init(M, NMG, G, bx);
                pg8::gemm_phase<pg8::EpiGate, pg8::StaticOrder, true, true>(lds + RING_OFF, g, S, E, otid());
            }
        }
        SEAM(pb + 3);
        if (IN(pb + 4)) {
            pg8::Gemm g{Y, WB + (size_t)(l * 3) * D * 512, M, D, 512}; Merge3Order S; S.S.init(M, D, G, bx);
            pg8::EpiMerge3 E{MG, MERGED};
            pg8::gemm_phase<pg8::EpiMerge3, Merge3Order, true, true>(lds + RING_OFF, g, S, E, otid());
        }
        SEAM(pb + 4);
        if (IN(pb + 5)) {
            pg8::Gemm g{MERGED, WO + (size_t)l * D * D, M, D, D}; pg8::StaticOrder S; S.init(M, D, G, bx);
            if (l + 1 < DEPTH) { pg8::EpiResidA E{xin, XN, (float*)(OWS() + WS_RPART)}; pg8::gemm_phase<pg8::EpiResidA, pg8::StaticOrder, true, true>(lds + RING_OFF, g, S, E, otid()); }
            else { pg8::EpiResidB E{XN, out}; pg8::gemm_phase<pg8::EpiResidB, pg8::StaticOrder, true, true>(lds + RING_OFF, g, S, E, otid()); }
        }
        SEAM(pb + 5);
        if (l + 1 < DEPTH) {
            if (IN(pb + 6)) { const float* rp = (const float*)(OWS() + WS_RPART); float* ri = (float*)(OWS() + WS_RINV);
                for (int r_ = bx * NTHR + otid(); r_ < M; r_ += G * NTHR) { const f32x4 a0 = GLD(f32x4, rp, (unsigned)r_ * 64u), a1 = GLD(f32x4, rp, (unsigned)r_ * 64u + 16u), a2 = GLD(f32x4, rp, (unsigned)r_ * 64u + 32u), a3 = GLD(f32x4, rp, (unsigned)r_ * 64u + 48u);
                    const f32x4 s4 = (a0 + a1) + (a2 + a3); *(GAS float*)(ri + r_) = rsqf(((s4[0] + s4[1]) + (s4[2] + s4[3])) * (1.f / D) + EPS); } }
            SEAM(pb + 6);
        }
    }
#undef IN
#undef WIN
#undef WB
#undef WO
#undef XN
#undef Y
#undef PA
#undef PG
#undef PS
#undef PX
#undef MG
#undef MERGED
#undef CS
#undef KR
#undef PAR
#undef SEAM
}

#ifndef MK_SPLIT
#define MK_SPLIT 1
#endif
extern "C" void kernel_launch(void* const* d_in, const int* in_sizes, int n_in, void* d_out, int out_size, void* d_ws, size_t ws_size, hipStream_t stream) {
    static int grid = 0;
    if (grid == 0) {
        if (n_in != 18 || in_sizes[0] != M * D || out_size != M * D || ws_size < WS_END) { fprintf(stderr, "kernel_launch: unexpected shapes/ws (n_in %d, ws %zu)\n", n_in, ws_size); grid = -1; return; }
        int dev = 0, cus = 0, per_cu = 0;
        if (hipGetDevice(&dev) != hipSuccess || hipDeviceGetAttribute(&cus, hipDeviceAttributeMultiprocessorCount, dev) != hipSuccess) { grid = -1; return; }
        if (hipFuncSetAttribute((const void*)mega_fwd, hipFuncAttributeMaxDynamicSharedMemorySize, LDS_BYTES) != hipSuccess) { grid = -1; return; }
        if (hipOccupancyMaxActiveBlocksPerMultiprocessor(&per_cu, (const void*)mega_fwd, NTHR, LDS_BYTES) != hipSuccess || per_cu < 1) { fprintf(stderr, "kernel_launch: occupancy query says %d\n", per_cu); }
        (void)hipGetLastError();
        grid = cus;
    }
    if (grid < 0) return;
    if (hipMemsetAsync((char*)d_ws + WS_CTL, 0, CTL_ZERO_BYTES, stream) != hipSuccess) return;
    Args a{};
    for (int i = 0; i < 18; ++i) a.in[i] = d_in[i];
    a.out = (float*)d_out; a.ws = (unsigned char*)d_ws;
#if MK_SPLIT
    int li = 0;
    for (int ph = 0; ph < NPHASE; ++ph) {
        a.ph_lo = ph; a.ph_hi = ph + 1; a.li = li++; a.pad = 0;
        hipLaunchKernelGGL(mega_fwd, dim3(grid), dim3(NTHR), LDS_BYTES, stream, a); }
#else
    a.ph_lo = 0; a.ph_hi = NPHASE; a.li = 0; a.pad = 0;
    hipLaunchKernelGGL(mega_fwd, dim3(grid), dim3(NTHR), LDS_BYTES, stream, a);
#endif
}
```

```cpp
#include <hip/hip_runtime.h>
#include <cstdio>
#include <cstdint>
#define MK_SPLIT 0
namespace pg8 {
#define PG8_LAS __attribute__((address_space(3)))
typedef unsigned short bf16_t;
typedef short bf16x8 __attribute__((ext_vector_type(8)));
typedef float f32x4 __attribute__((ext_vector_type(4)));
typedef unsigned u32x4 __attribute__((ext_vector_type(4)));
constexpr int BM = 256, BK = 64, HALF = 128, HTB = HALF * BK * 2  , STAGE_BYTES = 8 * HTB, NXCD = 8, WGM = 8;

__host__ __device__ __forceinline__ int lds_byte(int r, int c) { const int st = (r >> 4) * 2 + (c >> 5), rr = r & 15, cc = c & 31, ob = rr * 64 + cc * 2; return st * 1024 + (ob ^ (((ob >> 9) & 1) << 5)); }
__host__ __device__ __forceinline__ void stage_rc(int b, int& R, int& C) { const int st = b / 1024, sb = b % 1024, swz = sb ^ (((sb >> 9) & 1) << 5); R = (st >> 1) * 16 + swz / 64; C = (st & 1) * 32 + (swz % 64) / 2; }
__host__ __device__ __forceinline__ int perm32(int rho) { const int n = rho >> 4, i = rho & 15; return 8 * (i >> 2) + 4 * n + (i & 3); }

struct Unit { int pm, pn; };
struct Gemm { const bf16_t* A; const bf16_t* Bt; int M, N, K; };

struct StaticOrder {
    int nM, nN, nwg, G, c;
    __host__ __device__ void init(int M, int N, int G_, int c_) { nM = M / BM; nN = N / BM; nwg = nM * nN; G = G_; c = c_; }
    __host__ __device__ bool next(int i, Unit& u) const {
        const long L = (long)i * G + c; if (L >= nwg) return false;
        int wgid = (int)L; { const int q = nwg / NXCD, r = nwg % NXCD, xcd = wgid % NXCD, off = wgid / NXCD; wgid = (xcd < r ? xcd * (q + 1) : r * (q + 1) + (xcd - r) * q) + off; }
        const int nig = WGM * nN, gid = wgid / nig, fm = gid * WGM, gsz = (nM - fm) < WGM ? (nM - fm) : WGM;
        u.pm = fm + ((wgid % nig) % gsz); u.pn = (wgid % nig) / gsz; return true;
    }
    __device__ __forceinline__ void a_ready(const Unit&) const {}
    __device__ __forceinline__ void done(const Unit&) const {}
};

typedef float f32x2c __attribute__((ext_vector_type(2))); typedef __bf16 bf16x2c __attribute__((ext_vector_type(2)));
__device__ __forceinline__ unsigned cvt_pk_bf16(float lo, float hi) { const f32x2c v = {lo, hi}; const bf16x2c b = __builtin_convertvector(v, bf16x2c); return __builtin_bit_cast(unsigned, b); }
typedef float f32x2 __attribute__((ext_vector_type(2)));

#define PG8_GAS __attribute__((address_space(1)))
template <class T> __device__ __forceinline__ T gld_(const void* p) { return *(const PG8_GAS T*)p; }
template <class T> __device__ __forceinline__ void gst_(void* p, T v) { *(PG8_GAS T*)p = v; }
__device__ __forceinline__ float sigmoid_fast(float x) { return __builtin_amdgcn_rcpf(1.f + __builtin_amdgcn_exp2f(-1.44269504f * x)); }
__device__ __forceinline__ float bf_lo(unsigned w) { return __builtin_bit_cast(float, w << 16); }
__device__ __forceinline__ float bf_hi(unsigned w) { return __builtin_bit_cast(float, w & 0xffff0000u); }

__device__ __forceinline__ float xrow_sum_e(float x) { unsigned a = __builtin_bit_cast(unsigned, x), b = a; asm volatile("s_nop 1\n\tv_permlane16_swap_b32 %0, %1" : "+v"(a), "+v"(b));
    const float y = __builtin_bit_cast(float, a) + __builtin_bit_cast(float, b); unsigned c = __builtin_bit_cast(unsigned, y), d = c; asm volatile("s_nop 1\n\tv_permlane32_swap_b32 %0, %1" : "+v"(c), "+v"(d));
    return __builtin_bit_cast(float, c) + __builtin_bit_cast(float, d); }
template <int ACT> struct EpiBf16 {
    static constexpr bool PERM = true, AFTER_DRAIN = false, CHAIN = false, PRE = false;
    bf16_t* O; int ldc; const float* rinv;
    __device__ __forceinline__ void operator()(const f32x4 (&acc)[2][2][4][2], const Unit& u, int wr, int wc, int fr, int fq) const {
        const int row0 = u.pm * BM + wr * 64 + fr; const int col0 = u.pn * BM + wc * 32 + 8 * fq;
        float rs[2][4];
#pragma unroll
        for (int ai = 0; ai < 2; ++ai)
#pragma unroll
            for (int m = 0; m < 4; ++m) rs[ai][m] = rinv ? gld_<float>(rinv + row0 + ai * HALF + m * 16) : 1.f;
#pragma unroll
        for (int ai = 0; ai < 2; ++ai)
#pragma unroll
            for (int m = 0; m < 4; ++m) { bf16_t* rowp = O + (size_t)(row0 + ai * HALF + m * 16) * ldc + col0;
#pragma unroll
                for (int bj = 0; bj < 2; ++bj) { f32x4 v0 = acc[ai][bj][m][0] * rs[ai][m], v1 = acc[ai][bj][m][1] * rs[ai][m];
                    if (ACT == 1) {
#pragma unroll
                        for (int j = 0; j < 4; ++j) { v0[j] = __builtin_amdgcn_rcpf(1.f + __builtin_amdgcn_exp2f(fminf(v0[j], 60.f))); v1[j] = __builtin_amdgcn_rcpf(1.f + __builtin_amdgcn_exp2f(fminf(v1[j], 60.f))); } }
                    u32x4 w; w.x = cvt_pk_bf16(v0[0], v0[1]); w.y = cvt_pk_bf16(v0[2], v0[3]); w.z = cvt_pk_bf16(v1[0], v1[1]); w.w = cvt_pk_bf16(v1[2], v1[3]);
                    gst_<u32x4>(rowp + bj * HALF, w); } }
    }
};
struct EpiGate {
    static constexpr bool PERM = true, AFTER_DRAIN = false, CHAIN = false, PRE = true;
    bf16_t* O; int ldc; const float* rinv;
    __device__ __forceinline__ void pre(const Unit& u, int wr, int fr, PG8_LAS unsigned char* slot) const {
        if (!rinv) return;
        int f_ = fr; asm volatile("" : "+v"(f_));
        const int row0 = u.pm * BM + wr * 64 + f_;
#pragma unroll
        for (int k = 0; k < 8; ++k) __builtin_amdgcn_global_load_lds((const PG8_GAS unsigned*)(rinv + row0 + (k >> 2) * HALF + (k & 3) * 16), (PG8_LAS unsigned*)(slot + k * 256), 4, 0, 0);
    }
    __device__ __forceinline__ void operator()(const f32x4 (&acc)[2][2][4][2], const Unit& u, int wr, int wc, int fr, int fq, const PG8_LAS unsigned char* slot) const {
        float rs[2][4];
        if (rinv) { asm volatile("s_waitcnt vmcnt(0)" ::: "memory");
#pragma unroll
            for (int k = 0; k < 8; ++k) rs[k >> 2][k & 3] = *(const PG8_LAS float*)(slot + k * 256 + (fr + 16 * fq) * 4); }
        else {
#pragma unroll
            for (int k = 0; k < 8; ++k) rs[k >> 2][k & 3] = 1.f; }
        const int row0 = u.pm * BM + wr * 64 + fr;
        if (u.pn < 8) {
            const int colq = u.pn * HALF + wc * 32 + 8 * fq;
#pragma unroll
            for (int ai = 0; ai < 2; ++ai)
#pragma unroll
                for (int m = 0; m < 4; ++m) { bf16_t* rowp = O + (size_t)(row0 + ai * HALF + m * 16) * ldc + colq;
                    float r[8], g[8];
#pragma unroll
                    for (int n = 0; n < 2; ++n)
#pragma unroll
                        for (int j = 0; j < 4; ++j) { const float d0 = 1.f + __builtin_amdgcn_exp2f(fminf(acc[ai][0][m][n][j] * rs[ai][m], 60.f)), d1 = 1.f + __builtin_amdgcn_exp2f(fminf(acc[ai][1][m][n][j] * rs[ai][m], 60.f));
                            g[4 * n + j] = __builtin_amdgcn_rcpf(d1); r[4 * n + j] = d1 * __builtin_amdgcn_rcpf(d0); }
                    u32x4 w; w.x = cvt_pk_bf16(r[0], r[1]); w.y = cvt_pk_bf16(r[2], r[3]); w.z = cvt_pk_bf16(r[4], r[5]); w.w = cvt_pk_bf16(r[6], r[7]);
                    gst_<u32x4>(rowp, w);
                    w.x = cvt_pk_bf16(g[0], g[1]); w.y = cvt_pk_bf16(g[2], g[3]); w.z = cvt_pk_bf16(g[4], g[5]); w.w = cvt_pk_bf16(g[6], g[7]);
                    gst_<u32x4>(rowp + 1024, w); }
        } else {
            const int col0 = u.pn * BM + wc * 32 + 8 * fq;
#pragma unroll
            for (int ai = 0; ai < 2; ++ai)
#pragma unroll
                for (int m = 0; m < 4; ++m) { bf16_t* rowp = O + (size_t)(row0 + ai * HALF + m * 16) * ldc + col0;
#pragma unroll
                    for (int bj = 0; bj < 2; ++bj) { f32x4 v0 = acc[ai][bj][m][0] * rs[ai][m], v1 = acc[ai][bj][m][1] * rs[ai][m];
#pragma unroll
                        for (int j = 0; j < 4; ++j) { v0[j] = __builtin_amdgcn_rcpf(1.f + __builtin_amdgcn_exp2f(fminf(v0[j], 60.f))); v1[j] = __builtin_amdgcn_rcpf(1.f + __builtin_amdgcn_exp2f(fminf(v1[j], 60.f))); }
                        u32x4 w; w.x = cvt_pk_bf16(v0[0], v0[1]); w.y = cvt_pk_bf16(v0[2], v0[3]); w.z = cvt_pk_bf16(v1[0], v1[1]); w.w = cvt_pk_bf16(v1[2], v1[3]);
                        gst_<u32x4>(rowp + bj * HALF, w); } }
        }
    }
};
struct EpiProj {
    static constexpr bool PERM = true, AFTER_DRAIN = false, CHAIN = false, PRE = true;
    bf16_t *pa, *pg, *ps, *px; const float* rinv;
    __device__ __forceinline__ void pre(const Unit& u, int wr, int fr, PG8_LAS unsigned char* slot) const {
        if (!rinv) return;
        int f_ = fr; asm volatile("" : "+v"(f_));
        const int row0 = u.pm * BM + wr * 64 + f_;
#pragma unroll
        for (int k = 0; k < 8; ++k) __builtin_amdgcn_global_load_lds((const PG8_GAS unsigned*)(rinv + row0 + (k >> 2) * HALF + (k & 3) * 16), (PG8_LAS unsigned*)(slot + k * 256), 4, 0, 0);
    }
    __device__ __forceinline__ void operator()(const f32x4 (&acc)[2][2][4][2], const Unit& u, int wr, int wc, int fr, int fq, const PG8_LAS unsigned char* slot) const {
        float rs[2][4];
        if (rinv) { asm volatile("s_waitcnt vmcnt(0)" ::: "memory");
#pragma unroll
            for (int k = 0; k < 8; ++k) rs[k >> 2][k & 3] = *(const PG8_LAS float*)(slot + k * 256 + (fr + 16 * fq) * 4); }
        else {
#pragma unroll
            for (int k = 0; k < 8; ++k) rs[k >> 2][k & 3] = 1.f; }
        bf16_t* O; int ldc, ct;
        if (u.pn < 5) { O = pa; ldc = 1280; ct = u.pn; } else if (u.pn < 11) { O = pg; ldc = 1536; ct = u.pn - 5; } else if (u.pn < 17) { O = ps; ldc = 1536; ct = u.pn - 11; } else { O = px; ldc = 32; ct = 0; }
        const int row0 = u.pm * BM + wr * 64 + fr; const int col0 = ct * BM + wc * 32 + 8 * fq;
#pragma unroll
        for (int ai = 0; ai < 2; ++ai)
#pragma unroll
            for (int m = 0; m < 4; ++m) { bf16_t* rowp = O + (size_t)(row0 + ai * HALF + m * 16) * ldc + col0;
#pragma unroll
                for (int bj = 0; bj < 2; ++bj) { const f32x4 v0 = acc[ai][bj][m][0] * rs[ai][m], v1 = acc[ai][bj][m][1] * rs[ai][m];
                    u32x4 w; w.x = cvt_pk_bf16(v0[0], v0[1]); w.y = cvt_pk_bf16(v0[2], v0[3]); w.z = cvt_pk_bf16(v1[0], v1[1]); w.w = cvt_pk_bf16(v1[2], v1[3]);
                    if (u.pn < 17 || (bj == 0 && wc == 0)) gst_<u32x4>(rowp + bj * HALF, w); } }
    }
};
struct EpiMerge {
    static constexpr bool PERM = true, AFTER_DRAIN = false, CHAIN = false, PRE = false;
    const bf16_t* Gt; int ldg; bf16_t* Mg; int ldm; int first;
    __device__ __forceinline__ void operator()(const f32x4 (&acc)[2][2][4][2], const Unit& u, int wr, int wc, int fr, int fq) const {
        const int row0 = u.pm * BM + wr * 64 + fr; const int col0 = u.pn * BM + wc * 32 + 8 * fq;
#pragma unroll
        for (int ai = 0; ai < 2; ++ai) {
            u32x4 g[4][2], p[4][2];
#pragma unroll
            for (int m = 0; m < 4; ++m) { const size_t row = (size_t)(row0 + ai * HALF + m * 16);
#pragma unroll
                for (int bj = 0; bj < 2; ++bj) { g[m][bj] = gld_<u32x4>(Gt + row * ldg + col0 + bj * HALF);
                    p[m][bj] = (u32x4){0u, 0u, 0u, 0u}; if (!first) p[m][bj] = gld_<u32x4>(Mg + row * ldm + col0 + bj * HALF); } }
#pragma unroll
            for (int m = 0; m < 4; ++m) { const size_t row = (size_t)(row0 + ai * HALF + m * 16);
#pragma unroll
                for (int bj = 0; bj < 2; ++bj) { const f32x4 a0 = acc[ai][bj][m][0], a1 = acc[ai][bj][m][1]; const u32x4 gg = g[m][bj], pp = p[m][bj];
                    u32x4 w;
                    w.x = cvt_pk_bf16(bf_lo(pp.x) + bf_lo(gg.x) * a0[0], bf_hi(pp.x) + bf_hi(gg.x) * a0[1]);
                    w.y = cvt_pk_bf16(bf_lo(pp.y) + bf_lo(gg.y) * a0[2], bf_hi(pp.y) + bf_hi(gg.y) * a0[3]);
                    w.z = cvt_pk_bf16(bf_lo(pp.z) + bf_lo(gg.z) * a1[0], bf_hi(pp.z) + bf_hi(gg.z) * a1[1]);
                    w.w = cvt_pk_bf16(bf_lo(pp.w) + bf_lo(gg.w) * a1[2], bf_hi(pp.w) + bf_hi(gg.w) * a1[3]);
                    gst_<u32x4>(Mg + row * ldm + col0 + bj * HALF, w); } }
        }
    }
};
struct EpiMerge3 {
    static constexpr bool PERM = true, AFTER_DRAIN = false, CHAIN = true, PRE = false;
    static constexpr int LDG = 3072, LDM = 1024;
    const bf16_t* Gt; bf16_t* Mg;
    template <class T> static __device__ __forceinline__ T ldo(const bf16_t* base, int cdisp, unsigned off) { return *(const PG8_GAS T*)((const PG8_GAS unsigned char*)(base + cdisp) + (size_t)off); }
    template <int BR> __device__ __forceinline__ void run(f32x4 (&acc)[2][2][4][2], const Unit& u, int wr, int wc, int fr, int fq) const {
        const int row0 = (u.pm & 255) * BM + wr * 64 + fr; const int col0 = (u.pn & 3) * BM + wc * 32 + 8 * fq;
        const unsigned og = ((unsigned)row0 * LDG + col0) * 2u, om = ((unsigned)row0 * LDM + col0) * 2u;
        if constexpr (BR == 0) {
            u32x4 a[2][4][2];
#pragma unroll
            for (int ai = 0; ai < 2; ++ai)
#pragma unroll
                for (int m = 0; m < 4; ++m)
#pragma unroll
                    for (int bj = 0; bj < 2; ++bj) a[ai][m][bj] = ldo<u32x4>(Gt, (ai * HALF + m * 16) * LDG + bj * HALF, og);
#pragma unroll
            for (int ai = 0; ai < 2; ++ai)
#pragma unroll
                for (int m = 0; m < 4; ++m)
#pragma unroll
                    for (int bj = 0; bj < 2; ++bj) { const u32x4 aa = a[ai][m][bj];
                        acc[ai][bj][m][0] *= (f32x4){bf_lo(aa.x), bf_hi(aa.x), bf_lo(aa.y), bf_hi(aa.y)}; acc[ai][bj][m][1] *= (f32x4){bf_lo(aa.z), bf_hi(aa.z), bf_lo(aa.w), bf_hi(aa.w)};
                        asm volatile("" : "+v"(acc[ai][bj][m][0]), "+v"(acc[ai][bj][m][1])); }
        } else if constexpr (BR == 1) {
#pragma unroll
            for (int ai = 0; ai < 2; ++ai) {
                __builtin_amdgcn_sched_barrier(0);
                u32x4 a[4][2], d[4][2];
#pragma unroll
                for (int m = 0; m < 4; ++m)
#pragma unroll
                    for (int bj = 0; bj < 2; ++bj) { a[m][bj] = ldo<u32x4>(Gt, 1024 + (ai * HALF + m * 16) * LDG + bj * HALF, og); d[m][bj] = ldo<u32x4>(Gt, 2048 + (ai * HALF + m * 16) * LDG + bj * HALF, og); }
#pragma unroll
                for (int m = 0; m < 4; ++m)
#pragma unroll
                    for (int bj = 0; bj < 2; ++bj) { const u32x4 aa = a[m][bj], dd = d[m][bj];
                        const f32x4 r0 = {bf_lo(aa.x) * __builtin_amdgcn_rcpf(bf_lo(dd.x)), bf_hi(aa.x) * __builtin_amdgcn_rcpf(bf_hi(dd.x)), bf_lo(aa.y) * __builtin_amdgcn_rcpf(bf_lo(dd.y)), bf_hi(aa.y) * __builtin_amdgcn_rcpf(bf_hi(dd.y))};
                        const f32x4 r1 = {bf_lo(aa.z) * __builtin_amdgcn_rcpf(bf_lo(dd.z)), bf_hi(aa.z) * __builtin_amdgcn_rcpf(bf_hi(dd.z)), bf_lo(aa.w) * __builtin_amdgcn_rcpf(bf_lo(dd.w)), bf_hi(aa.w) * __builtin_amdgcn_rcpf(bf_hi(dd.w))};
                        acc[ai][bj][m][0] *= r0; acc[ai][bj][m][1] *= r1; asm volatile("" : "+v"(acc[ai][bj][m][0]), "+v"(acc[ai][bj][m][1])); }
            }
        } else {
            u32x4 g[2][4][2];
#pragma unroll
            for (int ai = 0; ai < 2; ++ai)
#pragma unroll
                for (int m = 0; m < 4; ++m)
#pragma unroll
                    for (int bj = 0; bj < 2; ++bj) g[ai][m][bj] = ldo<u32x4>(Gt, 2048 + (ai * HALF + m * 16) * LDG + bj * HALF, og);
#pragma unroll
            for (int ai = 0; ai < 2; ++ai)
#pragma unroll
                for (int m = 0; m < 4; ++m)
#pragma unroll
                    for (int bj = 0; bj < 2; ++bj) { const f32x4 a0 = acc[ai][bj][m][0], a1 = acc[ai][bj][m][1]; const u32x4 gg = g[ai][m][bj];
                        u32x4 w;
                        w.x = cvt_pk_bf16(bf_lo(gg.x) * a0[0], bf_hi(gg.x) * a0[1]); w.y = cvt_pk_bf16(bf_lo(gg.y) * a0[2], bf_hi(gg.y) * a0[3]);
                        w.z = cvt_pk_bf16(bf_lo(gg.z) * a1[0], bf_hi(gg.z) * a1[1]); w.w = cvt_pk_bf16(bf_lo(gg.w) * a1[2], bf_hi(gg.w) * a1[3]);
                        *(PG8_GAS u32x4*)((PG8_GAS unsigned char*)(Mg + (ai * HALF + m * 16) * LDM + bj * HALF) + (size_t)om) = w; }
        }
    }
};
template <class T> __device__ __forceinline__ T ldo_(const void* base, unsigned off) { return *(const PG8_GAS T*)((const PG8_GAS unsigned char*)base + (size_t)off); }
template <class T> __device__ __forceinline__ void sto_(void* base, unsigned off, T v) { *(PG8_GAS T*)((PG8_GAS unsigned char*)base + (size_t)off) = v; }
struct EpiResidA {
    static constexpr bool PERM = true, AFTER_DRAIN = false, CHAIN = false, PRE = false;
    static constexpr int LD = 1024;
    const float* base; bf16_t* xb; float* rpart;
    __device__ __forceinline__ void operator()(const f32x4 (&acc)[2][2][4][2], const Unit& u, int wr, int wc, int fr, int fq) const {
        const int row0 = u.pm * BM + wr * 64 + fr, col0 = u.pn * BM + wc * 32 + 8 * fq;
        const unsigned o4 = ((unsigned)row0 * LD + col0) * 4u, o2 = ((unsigned)row0 * LD + col0) * 2u;
#pragma unroll
        for (int ai = 0; ai < 2; ++ai) {
            __builtin_amdgcn_sched_barrier(0);
            f32x4 bs[4][2][2];
#pragma unroll
            for (int m = 0; m < 4; ++m)
#pragma unroll
                for (int bj = 0; bj < 2; ++bj)
#pragma unroll
                    for (int n = 0; n < 2; ++n) bs[m][bj][n] = ldo_<f32x4>(base + (ai * HALF + m * 16) * LD + bj * HALF + 4 * n, o4);
#pragma unroll
            for (int m = 0; m < 4; ++m) { float ss = 0.f;
#pragma unroll
                for (int bj = 0; bj < 2; ++bj) { const f32x4 p0 = bs[m][bj][0] + acc[ai][bj][m][0], p1 = bs[m][bj][1] + acc[ai][bj][m][1];
                    ss += ((p0[0] * p0[0] + p0[1] * p0[1]) + (p0[2] * p0[2] + p0[3] * p0[3])) + ((p1[0] * p1[0] + p1[1] * p1[1]) + (p1[2] * p1[2] + p1[3] * p1[3]));
                    u32x4 w; w.x = cvt_pk_bf16(p0[0], p0[1]); w.y = cvt_pk_bf16(p0[2], p0[3]); w.z = cvt_pk_bf16(p1[0], p1[1]); w.w = cvt_pk_bf16(p1[2], p1[3]);
                    sto_<u32x4>(xb + (ai * HALF + m * 16) * LD + bj * HALF, o2, w); }
                ss = xrow_sum_e(ss); if (fq == 0) gst_<float>(rpart + (size_t)(row0 + ai * HALF + m * 16) * 16 + u.pn * 4 + wc, ss); }
        }
    }
};
struct EpiResidB {
    static constexpr bool PERM = true, AFTER_DRAIN = false, CHAIN = false, PRE = false;
    static constexpr int LD = 1024;
    const bf16_t* xb; float* out;
    __device__ __forceinline__ void operator()(const f32x4 (&acc)[2][2][4][2], const Unit& u, int wr, int wc, int fr, int fq) const {
        const int row0 = u.pm * BM + wr * 64 + fr, col0 = u.pn * BM + wc * 32 + 8 * fq;
        const unsigned o4 = ((unsigned)row0 * LD + col0) * 4u, o2 = ((unsigned)row0 * LD + col0) * 2u;
        u32x4 b[2][4][2];
#pragma unroll
        for (int ai = 0; ai < 2; ++ai)
#pragma unroll
            for (int m = 0; m < 4; ++m)
#pragma unroll
                for (int bj = 0; bj < 2; ++bj) b[ai][m][bj] = ldo_<u32x4>(xb + (ai * HALF + m * 16) * LD + bj * HALF, o2);
#pragma unroll
        for (int ai = 0; ai < 2; ++ai)
#pragma unroll
            for (int m = 0; m < 4; ++m)
#pragma unroll
                for (int bj = 0; bj < 2; ++bj) { const u32x4 bb = b[ai][m][bj];
                    sto_<f32x4>(out + (ai * HALF + m * 16) * LD + bj * HALF, o4, (f32x4){bf_lo(bb.x), bf_hi(bb.x), bf_lo(bb.y), bf_hi(bb.y)} + acc[ai][bj][m][0]);
                    sto_<f32x4>(out + (ai * HALF + m * 16) * LD + bj * HALF + 4, o4, (f32x4){bf_lo(bb.z), bf_hi(bb.z), bf_lo(bb.w), bf_hi(bb.w)} + acc[ai][bj][m][1]); }
    }
};


template <int V> struct IC { static constexpr int value = V; };
template <class Epi, class Sched, bool ALIGN_EPI = false, bool SP2 = false>
__device__ __forceinline__ void gemm_phase(PG8_LAS unsigned char* lds, const Gemm g, const Sched& S, const Epi& E, const int tid) {
    const int wid = __builtin_amdgcn_readfirstlane(tid >> 6), lane = tid & 63, wr = wid >> 2, wc = wid & 3, fr = lane & 15, fq = lane >> 4;
    const int K = g.K, nt = K / BK;
    unsigned voffA[2], voffB[2];
#pragma unroll
    for (int i = 0; i < 2; ++i) { int R, C; stage_rc(tid * 16 + i * 8192, R, C); const int Rb = Epi::PERM ? ((R & ~31) + perm32(R & 31)) : R;
        voffA[i] = (unsigned)(R * K + C) * 2u; voffB[i] = (unsigned)(Rb * K + C) * 2u; }
    const size_t kstep = (size_t)(BK * 2);
    const size_t hstep = (size_t)HALF * K * 2;
    const size_t tstep = 2 * hstep;
    const unsigned ldsw = (unsigned)wid * 1024u;
    const int aoff = lds_byte(wr * 64 + fr, fq * 8), boff = lds_byte(wc * 32 + fr, fq * 8);
#define PG8_SA(b, h) (((b) * 2 + (h)) * HTB)
#define PG8_SB(b, h) ((4 + (b) * 2 + (h)) * HTB)
#define PG8_STAGE(bufoff, gbase, voff) do { _Pragma("unroll") for (int _i = 0; _i < 2; ++_i) \
        __builtin_amdgcn_global_load_lds((const unsigned*)((const char*)(gbase) + (voff)[_i]), (PG8_LAS unsigned*)(lds + (bufoff) + ldsw + _i * 8192), 16, 0, 0); } while (0)
#define PG8_LDA(dst, b, h) do { _Pragma("unroll") for (int m = 0; m < 4; ++m) _Pragma("unroll") for (int k = 0; k < 2; ++k) dst[m][k] = *(const PG8_LAS bf16x8*)(lds + PG8_SA(b, h) + aoff + m * 2048 + k * 1024); } while (0)
#define PG8_LDB(dst, b, h) do { _Pragma("unroll") for (int n = 0; n < 2; ++n) _Pragma("unroll") for (int k = 0; k < 2; ++k) dst[n][k] = *(const PG8_LAS bf16x8*)(lds + PG8_SB(b, h) + boff + n * 2048 + k * 1024); } while (0)
#define PG8_MMA(ai, bj, At, Bt) do { __builtin_amdgcn_s_setprio(1); _Pragma("unroll") for (int m = 0; m < 4; ++m) _Pragma("unroll") for (int n = 0; n < 2; ++n) _Pragma("unroll") for (int k = 0; k < 2; ++k) \
        acc[ai][bj][m][n] = __builtin_amdgcn_mfma_f32_16x16x32_bf16(Bt[n][k], At[m][k], acc[ai][bj][m][n], 0, 0, 0); __builtin_amdgcn_s_setprio(0); } while (0)
#define PG8_WAIT_V(n) asm volatile("s_waitcnt vmcnt(" #n ")" ::: "memory")
#define PG8_WAIT_L(n) asm volatile("s_waitcnt lgkmcnt(" #n ")" ::: "memory")
#define PG8_BAR __builtin_amdgcn_s_barrier()
#define PG8_SCHED __builtin_amdgcn_sched_barrier(0)
    Unit cur, nxt; int ui = 0;
    if (!S.next(0, cur)) return;
    f32x4 acc[2][2][4][2];
#pragma unroll
    for (int a = 0; a < 2; ++a)
#pragma unroll
        for (int b = 0; b < 2; ++b)
#pragma unroll
            for (int m = 0; m < 4; ++m)
#pragma unroll
                for (int n = 0; n < 2; ++n) acc[a][b][m][n] = (f32x4){0.f, 0.f, 0.f, 0.f};
    bf16x8 At[4][2], B0[2][2], B1[2][2];
    const char* cA = (const char*)g.A + (size_t)cur.pm * tstep; const char* cB = (const char*)g.Bt + (size_t)cur.pn * tstep;
    S.a_ready(cur);
    if constexpr (SP2) {
        PG8_STAGE(PG8_SB(0, 0), cB, voffB); PG8_STAGE(PG8_SB(0, 1), cB + hstep, voffB); PG8_STAGE(PG8_SA(0, 0), cA, voffA); PG8_STAGE(PG8_SA(0, 1), cA + hstep, voffA);
        if (wr == 1) PG8_BAR;
        PG8_WAIT_V(2); PG8_BAR;
        PG8_STAGE(PG8_SB(1, 0), cB + kstep, voffB); PG8_STAGE(PG8_SA(1, 0), cA + kstep, voffA); PG8_STAGE(PG8_SB(1, 1), cB + hstep + kstep, voffB);
        PG8_WAIT_V(6); PG8_BAR;
    } else {
        PG8_STAGE(PG8_SB(0, 0), cB, voffB); PG8_STAGE(PG8_SA(0, 0), cA, voffA); PG8_STAGE(PG8_SB(0, 1), cB + hstep, voffB); PG8_STAGE(PG8_SA(0, 1), cA + hstep, voffA);
        if (wr == 1) PG8_BAR;
        PG8_WAIT_V(4); PG8_BAR;
        PG8_STAGE(PG8_SB(1, 0), cB + kstep, voffB); PG8_STAGE(PG8_SA(1, 0), cA + kstep, voffA); PG8_STAGE(PG8_SB(1, 1), cB + hstep + kstep, voffB);
        PG8_WAIT_V(6); PG8_BAR;
    }
    auto unit = [&](auto BRC) __attribute__((always_inline)) -> bool {
        constexpr int BR = decltype(BRC)::value;
        const bool has_next = S.next(ui + 1, nxt);
        const char* nA = has_next ? (const char*)g.A + (size_t)nxt.pm * tstep : cA; const char* nB = has_next ? (const char*)g.Bt + (size_t)nxt.pn * tstep : cB;
        asm volatile("" : "+s"(nA), "+s"(nB));
        for (int t = 0; t < nt; t += 2) {
            const bool last = (t == nt - 2);
            const char* a1 = cA + (size_t)(t + 1) * kstep;
            const char* a2 = last ? nA : cA + (size_t)(t + 2) * kstep; const char* b2 = last ? nB : cB + (size_t)(t + 2) * kstep;
            const char* a3 = a2 + kstep; const char* b3 = b2 + kstep;
            if (last && has_next) S.a_ready(nxt);
            if constexpr (SP2) {
            PG8_LDB(B0, 0, 0); PG8_LDB(B1, 0, 1); PG8_SCHED; PG8_LDA(At, 0, 0); PG8_STAGE(PG8_SA(1, 1), a1 + hstep, voffA);
            PG8_WAIT_V(8); PG8_WAIT_L(0); PG8_BAR; PG8_MMA(0, 0, At, B0); PG8_MMA(0, 1, At, B1); PG8_BAR; PG8_SCHED;
            PG8_LDA(At, 0, 1); PG8_STAGE(PG8_SB(0, 0), b2, voffB); PG8_STAGE(PG8_SB(0, 1), b2 + hstep, voffB); PG8_STAGE(PG8_SA(0, 0), a2, voffA);
            PG8_WAIT_V(8); PG8_WAIT_L(0); PG8_BAR; PG8_MMA(1, 0, At, B0); PG8_MMA(1, 1, At, B1); PG8_BAR; PG8_SCHED;
            PG8_LDB(B0, 1, 0); PG8_LDB(B1, 1, 1); PG8_SCHED; PG8_LDA(At, 1, 0); PG8_STAGE(PG8_SA(0, 1), a2 + hstep, voffA);
            PG8_WAIT_V(8); PG8_WAIT_L(0); PG8_BAR; PG8_MMA(0, 0, At, B0); PG8_MMA(0, 1, At, B1); PG8_BAR; PG8_SCHED;
            PG8_LDA(At, 1, 1); PG8_STAGE(PG8_SB(1, 0), b3, voffB); PG8_STAGE(PG8_SB(1, 1), b3 + hstep, voffB); PG8_STAGE(PG8_SA(1, 0), a3, voffA);
            PG8_WAIT_V(8);
            if constexpr (Epi::PRE) { if (last) E.pre(cur, wr, fr, lds + STAGE_BYTES + wid * 2048); }
            PG8_WAIT_L(0); PG8_BAR; PG8_MMA(1, 0, At, B0); PG8_MMA(1, 1, At, B1); PG8_BAR; PG8_SCHED;
            } else {
            PG8_LDB(B0, 0, 0); PG8_SCHED; PG8_LDA(At, 0, 0); PG8_STAGE(PG8_SA(1, 1), a1 + hstep, voffA);
            PG8_WAIT_L(8); PG8_BAR; PG8_WAIT_L(0); PG8_MMA(0, 0, At, B0); PG8_BAR; PG8_SCHED;
            PG8_LDB(B1, 0, 1); PG8_STAGE(PG8_SB(0, 0), b2, voffB);
            PG8_BAR; PG8_WAIT_L(0); PG8_MMA(0, 1, At, B1); PG8_BAR;
            PG8_LDA(At, 0, 1); PG8_STAGE(PG8_SA(0, 0), a2, voffA);
            PG8_BAR; PG8_WAIT_L(0); PG8_MMA(1, 0, At, B0); PG8_BAR; PG8_SCHED;
            PG8_STAGE(PG8_SB(0, 1), b2 + hstep, voffB);
            PG8_WAIT_V(6); PG8_BAR; PG8_MMA(1, 1, At, B1); PG8_BAR;
            PG8_LDB(B0, 1, 0); PG8_SCHED; PG8_LDA(At, 1, 0); PG8_STAGE(PG8_SA(0, 1), a2 + hstep, voffA);
            PG8_WAIT_L(8); PG8_BAR; PG8_WAIT_L(0); PG8_MMA(0, 0, At, B0); PG8_BAR; PG8_SCHED;
            PG8_LDB(B1, 1, 1); PG8_STAGE(PG8_SB(1, 0), b3, voffB);
            PG8_BAR; PG8_WAIT_L(0); PG8_MMA(0, 1, At, B1); PG8_BAR;
            PG8_LDA(At, 1, 1); PG8_STAGE(PG8_SA(1, 0), a3, voffA);
            PG8_BAR; PG8_WAIT_L(0); PG8_MMA(1, 0, At, B0); PG8_BAR; PG8_SCHED;
            PG8_STAGE(PG8_SB(1, 1), b3 + hstep, voffB);
            PG8_WAIT_V(6); PG8_BAR; PG8_MMA(1, 1, At, B1); PG8_BAR;
            }
        }
        if constexpr (ALIGN_EPI) { if (wr == 0) PG8_BAR; }
        if constexpr (Epi::CHAIN) { E.template run<BR>(acc, cur, wr, wc, fr, fq); S.done(cur); }
        else if constexpr (Epi::PRE) { E(acc, cur, wr, wc, fr, fq, lds + STAGE_BYTES + wid * 2048); S.done(cur); }
        else if constexpr (!Epi::AFTER_DRAIN) { E(acc, cur, wr, wc, fr, fq); S.done(cur); }
        if (!has_next) return false;
        if constexpr (!Epi::CHAIN || BR == 2) {
#pragma unroll
        for (int a = 0; a < 2; ++a)
#pragma unroll
            for (int b = 0; b < 2; ++b)
#pragma unroll
                for (int m = 0; m < 4; ++m)
#pragma unroll
                    for (int n = 0; n < 2; ++n) acc[a][b][m][n] = (f32x4){0.f, 0.f, 0.f, 0.f};
        }
        cur = nxt; cA = nA; cB = nB; ++ui;
        if constexpr (ALIGN_EPI) { if (wr == 1) PG8_BAR; }
        return true;
    };
    if constexpr (Epi::CHAIN) { for (;;) { if (!unit(IC<0>{})) break; if (!unit(IC<1>{})) break; if (!unit(IC<2>{})) break; } }
    else { for (;;) if (!unit(IC<0>{})) break; }
    PG8_WAIT_V(0);
    if constexpr (!ALIGN_EPI) { if (wr == 0) PG8_BAR; }
    PG8_BAR;
    if constexpr (Epi::AFTER_DRAIN) { E.fused(acc, cur, wr, wc, fr, fq, lds, wid, lane); S.done(cur); }
#undef PG8_SA
#undef PG8_SB
#undef PG8_STAGE
#undef PG8_LDA
#undef PG8_LDB
#undef PG8_MMA
#undef PG8_WAIT_V
#undef PG8_WAIT_L
#undef PG8_BAR
#undef PG8_SCHED
}
}
#define GAS __attribute__((address_space(1)))
#define LAS __attribute__((address_space(3)))
typedef unsigned short bf16;
typedef unsigned v4u __attribute__((ext_vector_type(4)));
typedef float f32x4 __attribute__((ext_vector_type(4)));
typedef short bf16x8 __attribute__((ext_vector_type(8)));
typedef GAS unsigned gu32;
typedef GAS unsigned long long gu64;
#define RLX_AGENT __ATOMIC_RELAXED, __HIP_MEMORY_SCOPE_AGENT
#define LDS_WAIT() asm volatile("s_waitcnt lgkmcnt(0)" ::: "memory")
#define VM_WAIT() asm volatile("s_waitcnt vmcnt(0)" ::: "memory")
__device__ __forceinline__ unsigned long long rt() { return __builtin_amdgcn_s_memrealtime(); }
__device__ __forceinline__ unsigned f2bf(float f) { unsigned u = __builtin_bit_cast(unsigned, f); return (u + 0x7fffu + ((u >> 16) & 1u)) >> 16; }
__device__ __forceinline__ unsigned pk2(float lo, float hi) { return f2bf(lo) | (f2bf(hi) << 16); }

#define XB_TMO      128
#define XB_XCNT(j)  (256  + 64 * (j))
#define XB_XSUB(j)  (1280 + 64 * (j))
#define XB_XGEN(j)  (2304 + 64 * (j))
#define XB_TOP      3328
#define XB_TOPGEN   3392
#define XCD_BAR_WORDS 3456
#define XB_SPIN_CAP (1u << 18)

__device__ __forceinline__ unsigned xb_ld(unsigned* p)              { return __hip_atomic_load(p, __ATOMIC_RELAXED, __HIP_MEMORY_SCOPE_AGENT); }
__device__ __forceinline__ unsigned xb_add(unsigned* p, unsigned v) { return __hip_atomic_fetch_add(p, v, __ATOMIC_RELAXED, __HIP_MEMORY_SCOPE_AGENT); }
__device__ __forceinline__ unsigned xb_xcc_id() { return (unsigned)__builtin_amdgcn_s_getreg((3 << 11) | 20) & 0xFu; }
#define XB_SPIN(cond, bar) do { unsigned _sp = 0; while (cond) { __builtin_amdgcn_s_sleep(1); \
    if ((++_sp & 255u) == 0u) { if (xb_ld(&(bar)[XB_TMO])) break; if (_sp > XB_SPIN_CAP) { atomicAdd(&(bar)[XB_TMO], 1u); break; } } } } while (0)

struct XcdBarrier {
    unsigned* bar; unsigned x;
    volatile LAS unsigned* st;
};

__device__ __forceinline__ XcdBarrier xcd_barrier_post(unsigned* bar, volatile LAS unsigned* st) {
    XcdBarrier b; b.bar = bar; b.x = xb_xcc_id(); b.st = st;
    if (threadIdx.x == 0) (void)xb_add(&bar[XB_XCNT(b.x)], 1u);
    return b;
}
__device__ __forceinline__ void xcd_barrier_complete(unsigned* bar, unsigned x, unsigned& nloc, unsigned& nx) {
    const unsigned G = gridDim.x * gridDim.y * gridDim.z;
    unsigned sum, cnt, mine, sp = 0u;
    for (;;) {
        sum = 0u; cnt = 0u; mine = 0u;
#pragma unroll
        for (unsigned j = 0; j < 16; ++j) { const unsigned c = xb_ld(&bar[XB_XCNT(j)]); sum += c; cnt += (c > 0u) ? 1u : 0u; mine = (j == x) ? c : mine; }
        if (sum == G) break;
        __builtin_amdgcn_s_sleep(1);
        if ((++sp & 255u) == 0u) { if (xb_ld(&bar[XB_TMO])) break; if (sp > XB_SPIN_CAP) { atomicAdd(&bar[XB_TMO], 1u); break; } }
    }
    nloc = mine > 0u ? mine : 1u; nx = cnt > 0u ? cnt : 1u;
}

__device__ __forceinline__ void xcd_barrier(const XcdBarrier& b) {
    asm volatile("s_waitcnt vmcnt(0)" ::: "memory");
    __syncthreads();
    if (threadIdx.x == 0) {
        unsigned* bar = b.bar;
        __builtin_amdgcn_s_waitcnt(0);
        unsigned nloc = b.st[0], nx = b.st[1];
        if (nloc == 0u) { xcd_barrier_complete(bar, b.x, nloc, nx); b.st[0] = nloc; b.st[1] = nx; }
        const unsigned old = xb_add(&bar[XB_XSUB(b.x)], 1u);
        const unsigned gen = old / nloc;
        if (old + 1u == (gen + 1u) * nloc) {
            __builtin_amdgcn_fence(__ATOMIC_RELEASE, "agent");
            asm volatile("s_waitcnt vmcnt(0)" ::: "memory");
            const unsigned og = xb_add(&bar[XB_TOP], 1u);
            const unsigned tg = og / nx;
            if (og + 1u == (tg + 1u) * nx) xb_add(&bar[XB_TOPGEN], 1u);
            else XB_SPIN(xb_ld(&bar[XB_TOPGEN]) == tg, bar);
            __builtin_amdgcn_fence(__ATOMIC_ACQUIRE, "agent");
            xb_add(&bar[XB_XGEN(b.x)], 1u);
            asm volatile("s_waitcnt vmcnt(0)" ::: "memory");
        } else {
            XB_SPIN(xb_ld(&bar[XB_XGEN(b.x)]) == gen, bar);
            __builtin_amdgcn_fence(__ATOMIC_ACQUIRE, "agent");
            asm volatile("s_waitcnt vmcnt(0)" ::: "memory");
        }
    }
    __syncthreads();
}


constexpr int BATCH = 32, SEQ = 2048, D = 1024, M = BATCH * SEQ, DEPTH = 2;
constexpr int NIN = 7448, NMAIN = 4608, NMG = 3072, NINP = NMAIN + NMG;
constexpr float EPS = 1e-6f;
constexpr int PA_LD = 1280, PG_LD = 1536, PS_LD = 1536, PX_LD = 32;
constexpr int PC_AQ = 0, PC_AK = 512, PC_AV = 640, PC_AG = 768, PC_GQ = 0, PC_GK = 256, PC_GV = 512, PC_GG = 1024, PC_XBC = 0, PC_SZ = 1024, PC_GD = 0, PC_DT = 16;
__host__ __device__ __forceinline__ int src_col(int d) {
    if (d < 2816) return d;
    if (d < 3840) return d + 16;
    if (d < 4352) return d + 24;
    if (d < 4368) return 2816 + (d - 4352);
    if (d < 4376) return 3856 + (d - 4368);
    if (d < NMAIN) return -1;
    const int e = d - NMAIN, t = e >> 8, w = e & 255;
    return 4376 + (t < 8 ? (w >> 7) * 1024 + 128 * t + (w & 127) : e);
}
constexpr size_t MiB = 1u << 20;
constexpr size_t WS_CTL = 0, CTL_ZERO_BYTES = 1 * MiB;
constexpr size_t WS_WIN = 1 * MiB;
constexpr size_t WS_WB = 31 * MiB;
constexpr size_t WS_WO = 37 * MiB;
constexpr size_t WS_PAR = 41 * MiB;
constexpr int PG_NORM = 0, PG_QN = 1024, PG_KN = 1088, PG_SINK = 1152, PG_GWG = 1160, PG_GBG = 5256, PG_GON = 5512, PG_CW = 5640, PG_CB = 9736, PG_DTB = 10760, PG_ALOG = 10768, PG_DSK = 10776, PG_SON = 10784, PSTRIDE = 11296;
constexpr size_t WS_RPART = 42 * MiB;
constexpr size_t WS_RINV = 46 * MiB;
constexpr size_t WS_XN = 48 * MiB;
constexpr size_t WS_Y = 176 * MiB;
constexpr size_t WS_PA = 368 * MiB, WS_PG = 528 * MiB, WS_SPARE = 720 * MiB, WS_PS = 752 * MiB, WS_PX = 960 * MiB;
constexpr size_t WS_MG = 368 * MiB;
constexpr size_t WS_MERGED = 752 * MiB;
constexpr size_t WS_CS = 944 * MiB;
constexpr size_t WS_END = 1024 * MiB;
static_assert(WS_PA + (size_t)M * PA_LD * 2 == WS_PG && WS_PG + (size_t)M * PG_LD * 2 == WS_SPARE && WS_MG + (size_t)M * NMG * 2 == WS_PS && WS_PS + (size_t)M * PS_LD * 2 == WS_CS && WS_MERGED + (size_t)M * D * 2 <= WS_CS && WS_PX + (size_t)M * PX_LD * 2 <= WS_END, "ws map");
constexpr int CW_TMO = 0, CW_CODE = 1;
constexpr int CW_Q = 64;
constexpr int CW_DONE = 256;
constexpr int N_AG_UNITS = 128 + 1024;
constexpr int CW_BAR = 4096;
constexpr int NPHASE = 14, MAX_LAUNCH = 16;
constexpr int RING_OFF = 0, RING_BYTES = 131072;
constexpr int LDS_BYTES = 163840;
constexpr int LDSCTL_OFF = LDS_BYTES - 1024, MISC_OFF = LDSCTL_OFF + 320;
constexpr int NWAVES = 8, NTHR = 512;

struct Args { const void* in[18]; float* out; unsigned char* ws; int ph_lo, ph_hi, li, pad; };

template <int CTRL, int ROWMASK = 0xF> __device__ __forceinline__ float dpp_f(float x) { return __builtin_bit_cast(float, __builtin_amdgcn_update_dpp(0, __builtin_bit_cast(int, x), CTRL, ROWMASK, 0xF, ROWMASK == 0xF)); }
__device__ __forceinline__ float quad_sum(float x) { x += dpp_f<0xB1>(x); x += dpp_f<0x4E>(x); return x; }
__device__ __forceinline__ float row16_sum(float x) { x = quad_sum(x); x += dpp_f<0x141>(x); x += dpp_f<0x140>(x); return x; }
typedef unsigned u32x2p __attribute__((ext_vector_type(2)));
__device__ __forceinline__ void swap16(unsigned& a, unsigned& b) { asm volatile("s_nop 1\n\tv_permlane16_swap_b32 %0, %1" : "+v"(a), "+v"(b)); }
__device__ __forceinline__ void swap32(unsigned& a, unsigned& b) { asm volatile("s_nop 1\n\tv_permlane32_swap_b32 %0, %1" : "+v"(a), "+v"(b)); }
__device__ __forceinline__ float xrow_sum(float x) { unsigned a = __builtin_bit_cast(unsigned, x), b = a; swap16(a, b); const float y = __builtin_bit_cast(float, a) + __builtin_bit_cast(float, b);
    unsigned c = __builtin_bit_cast(unsigned, y), d = c; swap32(c, d); return __builtin_bit_cast(float, c) + __builtin_bit_cast(float, d); }
__device__ __forceinline__ float xrow_max(float x) { unsigned a = __builtin_bit_cast(unsigned, x), b = a; swap16(a, b); const float y = fmaxf(__builtin_bit_cast(float, a), __builtin_bit_cast(float, b));
    unsigned c = __builtin_bit_cast(unsigned, y), d = c; swap32(c, d); return fmaxf(__builtin_bit_cast(float, c), __builtin_bit_cast(float, d)); }
__device__ __forceinline__ float wave_sum(float v) {
    v = row16_sum(v);
    return ((__builtin_bit_cast(float, __builtin_amdgcn_readlane(__builtin_bit_cast(int, v), 0)) + __builtin_bit_cast(float, __builtin_amdgcn_readlane(__builtin_bit_cast(int, v), 16)))
         + (__builtin_bit_cast(float, __builtin_amdgcn_readlane(__builtin_bit_cast(int, v), 32)) + __builtin_bit_cast(float, __builtin_amdgcn_readlane(__builtin_bit_cast(int, v), 48))));
}
__device__ __forceinline__ float bf2f(bf16 b) { return __builtin_bit_cast(float, ((unsigned)b) << 16); }
__device__ __forceinline__ float siluf(float x) { return x * __builtin_amdgcn_rcpf(1.f + __builtin_amdgcn_exp2f(-1.44269504f * x)); }
__device__ __forceinline__ float softplusf(float x) { return x > 20.f ? x : __logf(1.f + __expf(x)); }
__device__ __forceinline__ float logsigmoidf(float x) { return fminf(x, 0.f) - __logf(1.f + __expf(-fabsf(x))); }
__device__ __forceinline__ float rsqf(float x) { return __builtin_amdgcn_rsqf(x); }

template <bool MAPPED>
__device__ __forceinline__ void transpose_item(const float* W, int K, int N, bf16* WT, LAS float* scr, int item, int nblk, int lane, const float* gk = nullptr) {
    const int kb = item / nblk, nb = item % nblk, k0 = 64 * kb, n0 = 32 * nb;
    const int nd = n0 + (lane & 31); const int sc = MAPPED ? src_col(nd) : nd;
    const float wmul = (MAPPED && nd >= NMAIN) ? -1.44269504f : 1.f;
#pragma unroll 8
    for (int i = 0; i < 32; ++i) { const int kk = 2 * i + (lane >> 5); scr[kk * 33 + (lane & 31)] = sc >= 0 ? W[(size_t)(k0 + kk) * N + sc] * (gk ? wmul * gk[k0 + kk] : wmul) : 0.f; }
    LDS_WAIT(); asm volatile("" ::: "memory");
    const int c = lane & 7;
#pragma unroll
    for (int j = 0; j < 4; ++j) { const int n = (lane >> 3) + 8 * j; const LAS float* s = scr + (8 * c) * 33 + n;
        v4u o; o.x = pk2(s[0 * 33], s[1 * 33]); o.y = pk2(s[2 * 33], s[3 * 33]); o.z = pk2(s[4 * 33], s[5 * 33]); o.w = pk2(s[6 * 33], s[7 * 33]);
        *(GAS v4u*)(WT + (size_t)(n0 + n) * K + k0 + 8 * c) = o; }
    LDS_WAIT(); asm volatile("" ::: "memory");
}
__device__ __forceinline__ void rms_rows2_to_bf16(const float* xrow0, const float* xrow1, const float* g, bf16* orow0, bf16* orow1, int lane) {
    const GAS f32x4* xr0 = (const GAS f32x4*)xrow0 + lane; const GAS f32x4* xr1 = (const GAS f32x4*)xrow1 + lane; const GAS f32x4* gr = (const GAS f32x4*)g + lane;
    f32x4 v[4], w[4]; float s = 0.f, t = 0.f;
#pragma unroll
    for (int j = 0; j < 4; ++j) { v[j] = xr0[64 * j]; w[j] = xr1[64 * j]; }
#pragma unroll
    for (int j = 0; j < 4; ++j) { s += (v[j].x * v[j].x + v[j].y * v[j].y) + (v[j].z * v[j].z + v[j].w * v[j].w); t += (w[j].x * w[j].x + w[j].y * w[j].y) + (w[j].z * w[j].z + w[j].w * w[j].w); }
    const float r = 1.f / sqrtf(wave_sum(s) * (1.f / D) + EPS), q = 1.f / sqrtf(wave_sum(t) * (1.f / D) + EPS);
    GAS unsigned long long* o0 = (GAS unsigned long long*)orow0 + lane; GAS unsigned long long* o1 = (GAS unsigned long long*)orow1 + lane;
#pragma unroll
    for (int j = 0; j < 4; ++j) { const f32x4 gg = gr[64 * j];
        o0[64 * j] = (unsigned long long)pk2(v[j].x * r * gg.x, v[j].y * r * gg.y) | ((unsigned long long)pk2(v[j].z * r * gg.z, v[j].w * r * gg.w) << 32);
        o1[64 * j] = (unsigned long long)pk2(w[j].x * q * gg.x, w[j].y * q * gg.y) | ((unsigned long long)pk2(w[j].z * q * gg.z, w[j].w * q * gg.w) << 32); }
}

typedef unsigned long long u64;
typedef unsigned u32x2 __attribute__((ext_vector_type(2)));
#define LBAR() do { asm volatile("s_waitcnt lgkmcnt(0)" ::: "memory"); __builtin_amdgcn_s_barrier(); asm volatile("" ::: "memory"); } while (0)
#define GLD(T, base, off) (*(const GAS T*)((const GAS unsigned char*)(base) + (size_t)(unsigned)(off)))
#define GST(T, base, off) (*(GAS T*)((GAS unsigned char*)(base) + (size_t)(unsigned)(off)))
#define MFMA16(a, b, c) __builtin_amdgcn_mfma_f32_16x16x32_bf16((a), (b), (c), 0, 0, 0)
__device__ __forceinline__ unsigned pk2c(float lo, float hi) { return pg8::cvt_pk_bf16(lo, hi); }
__device__ __forceinline__ bf16x8 mk8(unsigned a, unsigned b, unsigned c, unsigned d) { const v4u t = {a, b, c, d}; return __builtin_bit_cast(bf16x8, t); }
__device__ __forceinline__ bf16x8 mk8(u32x2 lo, u32x2 hi) { const v4u t = {lo.x, lo.y, hi.x, hi.y}; return __builtin_bit_cast(bf16x8, t); }
__device__ __forceinline__ float ex2(float x) { return __builtin_amdgcn_exp2f(x); }

constexpr int AT_KS = 0, AT_KSTR = 144, AT_VT = 36864, AT_VSTR = 528;
__device__ __forceinline__ void attn_unit(int unit, const bf16* PROJ, const float2* CS, const float* par_g, bf16* YA, LAS unsigned char* lds, int tid) {
    const GAS float* par = (const GAS float*)par_g;
    const int lane = tid & 63, wave = __builtin_amdgcn_readfirstlane(tid >> 6);
    const int jb = unit & 15, kvh = (unit >> 4) & 1, b = unit >> 5;
    const long mq0 = (long)b * SEQ + jb * 128, mk0 = mq0 - 128;
    LAS unsigned char* Ks = lds + AT_KS; LAS unsigned char* Vt = lds + AT_VT;
    const GAS float* kn = par + PG_KN; const GAS float* qn = par + PG_QN;
    const int g = wave >> 1, hq = 4 * kvh + g, i16 = lane & 15, quad = lane >> 4;
    v4u qr0, qr1; f32x4 qcs[4];
#define AT_QLOAD(itn) do { const int qrel_ = 16 * ((wave & 1) * 4 + (itn)) + i16; const unsigned qo_ = (unsigned)(qrel_ * PA_LD + PC_AQ + 64 * hq + 8 * quad) * 2u, cso_ = (unsigned)(qrel_ * 32 + 8 * quad) * 8u; \
        qr0 = GLD(v4u, PROJ + mq0 * PA_LD, qo_); qr1 = GLD(v4u, PROJ + mq0 * PA_LD, qo_ + 64u); \
        _Pragma("unroll") for (int j2 = 0; j2 < 4; ++j2) qcs[j2] = GLD(f32x4, CS + mq0 * 32, cso_ + 16u * j2); } while (0)
    AT_QLOAD(0);
#pragma unroll
    for (int it = 0; it < 2; ++it) {
        const int task = tid + it * NTHR, kk = task >> 2, c = task & 3;
        v4u w0 = {0u, 0u, 0u, 0u}, w1 = {0u, 0u, 0u, 0u};
        if (jb > 0 || kk >= 128) {
            const unsigned ko = (unsigned)(kk * PA_LD + PC_AK + 64 * kvh + 8 * c) * 2u;
            const v4u r0 = GLD(v4u, PROJ + mk0 * PA_LD, ko), r1 = GLD(v4u, PROJ + mk0 * PA_LD, ko + 64u);
            float x0[8], x1[8]; float ss = 0.f;
#pragma unroll
            for (int j = 0; j < 4; ++j) { x0[2 * j] = pg8::bf_lo(r0[j]); x0[2 * j + 1] = pg8::bf_hi(r0[j]); x1[2 * j] = pg8::bf_lo(r1[j]); x1[2 * j + 1] = pg8::bf_hi(r1[j]); }
#pragma unroll
            for (int j = 0; j < 8; ++j) ss += x0[j] * x0[j] + x1[j] * x1[j];
            ss = quad_sum(ss);
            const float r = rsqf(ss * (1.f / 64.f) + EPS);
            const unsigned cso = (unsigned)(kk * 32 + 8 * c) * 8u;
            float o0[8], o1[8];
#pragma unroll
            for (int j2 = 0; j2 < 4; ++j2) { const f32x4 cs = GLD(f32x4, CS + mk0 * 32, cso + 16u * j2);
#pragma unroll
                for (int e = 0; e < 2; ++e) { const int j = 2 * j2 + e; const float cn = e ? cs.z : cs.x, sn = e ? cs.w : cs.y;
                    const float y0 = x0[j] * r * kn[8 * c + j], y1 = x1[j] * r * kn[32 + 8 * c + j];
                    o0[j] = y0 * cn - y1 * sn; o1[j] = y1 * cn + y0 * sn; } }
            w0 = (v4u){pk2c(o0[0], o0[1]), pk2c(o0[2], o0[3]), pk2c(o0[4], o0[5]), pk2c(o0[6], o0[7])};
            w1 = (v4u){pk2c(o1[0], o1[1]), pk2c(o1[2], o1[3]), pk2c(o1[4], o1[5]), pk2c(o1[6], o1[7])};
        }
        *(LAS v4u*)(Ks + kk * AT_KSTR + c * 16) = w0; *(LAS v4u*)(Ks + kk * AT_KSTR + 64 + c * 16) = w1;
    }
    {
        const int kk = tid & 255, dh = tid >> 8;
        v4u r[4] = {{0u, 0u, 0u, 0u}, {0u, 0u, 0u, 0u}, {0u, 0u, 0u, 0u}, {0u, 0u, 0u, 0u}};
        if (jb > 0 || kk >= 128) { const unsigned vo = (unsigned)(kk * PA_LD + PC_AV + 64 * kvh + 32 * dh) * 2u;
#pragma unroll
            for (int j = 0; j < 4; ++j) r[j] = GLD(v4u, PROJ + mk0 * PA_LD, vo + 16u * j); }
#pragma unroll
        for (int j = 0; j < 4; ++j)
#pragma unroll
            for (int e = 0; e < 4; ++e) { const unsigned w = r[j][e]; const int d = 32 * dh + 8 * j + 2 * e;
                *(LAS unsigned short*)(Vt + d * AT_VSTR + kk * 2) = (unsigned short)(w & 0xffffu);
                *(LAS unsigned short*)(Vt + (d + 1) * AT_VSTR + kk * 2) = (unsigned short)(w >> 16); }
    }
    LBAR();
    const float sinkl = par[PG_SINK + hq] * 1.44269504f;
    for (int it = 0; it < 4; ++it) {
        const int qt = (wave & 1) * 4 + it, qrel = 16 * qt + i16;
        bf16x8 qf0, qf1;
        {
            const v4u r0 = qr0, r1 = qr1;
            float x0[8], x1[8]; float ss = 0.f;
#pragma unroll
            for (int j = 0; j < 4; ++j) { x0[2 * j] = pg8::bf_lo(r0[j]); x0[2 * j + 1] = pg8::bf_hi(r0[j]); x1[2 * j] = pg8::bf_lo(r1[j]); x1[2 * j + 1] = pg8::bf_hi(r1[j]); }
#pragma unroll
            for (int j = 0; j < 8; ++j) ss += x0[j] * x0[j] + x1[j] * x1[j];
            ss = xrow_sum(ss);
            const float r = (0.125f * 1.44269504f) * rsqf(ss * (1.f / 64.f) + EPS);
            float o0[8], o1[8];
#pragma unroll
            for (int j2 = 0; j2 < 4; ++j2) { const f32x4 cs = qcs[j2];
#pragma unroll
                for (int e = 0; e < 2; ++e) { const int j = 2 * j2 + e; const float cn = e ? cs.z : cs.x, sn = e ? cs.w : cs.y;
                    const float y0 = x0[j] * r * qn[8 * quad + j], y1 = x1[j] * r * qn[32 + 8 * quad + j];
                    o0[j] = y0 * cn - y1 * sn; o1[j] = y1 * cn + y0 * sn; } }
            qf0 = mk8(pk2c(o0[0], o0[1]), pk2c(o0[2], o0[3]), pk2c(o0[4], o0[5]), pk2c(o0[6], o0[7]));
            qf1 = mk8(pk2c(o1[0], o1[1]), pk2c(o1[2], o1[3]), pk2c(o1[4], o1[5]), pk2c(o1[6], o1[7]));
        }
        if (it < 3) AT_QLOAD(it + 1);
        u32x2 gwv[4];
#pragma unroll
        for (int dt = 0; dt < 4; ++dt) gwv[dt] = GLD(u32x2, PROJ + mq0 * PA_LD, (unsigned)(qrel * PA_LD + PC_AG + 64 * hq + 16 * dt + 4 * quad) * 2u);
        f32x4 s[9];
#pragma unroll
        for (int t = 0; t < 9; ++t) { const LAS unsigned char* kp = Ks + (16 * (qt + t) + i16) * AT_KSTR + quad * 16;
            const bf16x8 a0 = *(const LAS bf16x8*)kp, a1 = *(const LAS bf16x8*)(kp + 64);
            f32x4 z = {0.f, 0.f, 0.f, 0.f}; z = MFMA16(a0, qf0, z); s[t] = MFMA16(a1, qf1, z); }
        float mx = sinkl;
        if (jb > 0) {
#pragma unroll
            for (int r = 0; r < 4; ++r) { s[0][r] = (4 * quad + r > i16) ? s[0][r] : -1.0e30f; s[8][r] = (4 * quad + r <= i16) ? s[8][r] : -1.0e30f; }
        } else {
#pragma unroll
            for (int t = 0; t < 9; ++t)
#pragma unroll
                for (int r = 0; r < 4; ++r) { const int kk = 16 * (qt + t) + 4 * quad + r;
                    const bool valid = (kk > qrel) && (kk <= qrel + 128) && (kk >= 128);
                    s[t][r] = valid ? s[t][r] : -1.0e30f; }
        }
#pragma unroll
        for (int t = 0; t < 9; ++t) mx = fmaxf(mx, fmaxf(fmaxf(s[t][0], s[t][1]), fmaxf(s[t][2], s[t][3])));
        mx = xrow_max(mx);
        float lsum = 0.f;
#pragma unroll
        for (int t = 0; t < 9; ++t)
#pragma unroll
            for (int r = 0; r < 4; ++r) { const float p = ex2(s[t][r] - mx); s[t][r] = p; lsum += p; }
        lsum = xrow_sum(lsum) + ex2(sinkl - mx);
        f32x4 o[4];
#pragma unroll
        for (int dt = 0; dt < 4; ++dt) o[dt] = (f32x4){0.f, 0.f, 0.f, 0.f};
#pragma unroll
        for (int st = 0; st < 5; ++st) { const int t0 = 2 * st, t1 = 2 * st + 1;
            bf16x8 pb;
            if (t1 < 9) pb = mk8(pk2c(s[t0][0], s[t0][1]), pk2c(s[t0][2], s[t0][3]), pk2c(s[t1][0], s[t1][1]), pk2c(s[t1][2], s[t1][3]));
            else pb = mk8(pk2c(s[t0][0], s[t0][1]), pk2c(s[t0][2], s[t0][3]), 0u, 0u);
            const int k0 = 16 * (qt + t0) + 4 * quad, k1 = t1 < 9 ? 16 * (qt + t1) + 4 * quad : k0;
#pragma unroll
            for (int dt = 0; dt < 4; ++dt) { const LAS unsigned char* vp = Vt + (16 * dt + i16) * AT_VSTR;
                const u32x2 lo = *(const LAS u32x2*)(vp + k0 * 2), hi = *(const LAS u32x2*)(vp + k1 * 2);
                o[dt] = MFMA16(mk8(lo, hi), pb, o[dt]); } }
        const float inv = __builtin_amdgcn_rcpf(lsum);
#pragma unroll
        for (int dt = 0; dt < 4; ++dt) { const int d0 = 16 * dt + 4 * quad;
            const u32x2 gw = gwv[dt];
            const float g0 = pg8::bf_lo(gw.x), g1 = pg8::bf_hi(gw.x), g2 = pg8::bf_lo(gw.y), g3 = pg8::bf_hi(gw.y);
            u32x2 ow; ow.x = pk2c(o[dt][0] * inv * siluf(g0), o[dt][1] * inv * siluf(g1)); ow.y = pk2c(o[dt][2] * inv * siluf(g2), o[dt][3] * inv * siluf(g3));
            GST(u32x2, YA + mq0 * 512, (unsigned)(qrel * 512 + 64 * hq + d0) * 2u) = ow; }
    }
    LBAR();
}


#undef AT_QLOAD
constexpr int GL_STR = 144;
constexpr int GL_QD = 0, GL_KI = 9216, GL_KET = 18432, GL_VT = 27648, GL_SEG = 46080, GL_BL = 48128, GL_PART = 48384, GL_TB = 51200;
__device__ __forceinline__ void gla_unit(int unit, const bf16* PROJ, const bf16* PX, const float* par_g, bf16* YB, LAS unsigned char* lds, int tid) {
    const GAS float* par = (const GAS float*)par_g;
    const int lane = tid & 63, wave = __builtin_amdgcn_readfirstlane(tid >> 6);
    const int b = unit >> 2, h = unit & 3, i16 = lane & 15, quad = lane >> 4;
    const int d = lane, tseg = wave, vA = tid & 127, q4 = wave >> 1, v0 = 16 * wave;
    LAS unsigned char* Qd = lds + GL_QD; LAS unsigned char* Ki = lds + GL_KI; LAS unsigned char* KeT = lds + GL_KET; LAS unsigned char* Vt = lds + GL_VT;
    LAS float* seg = (LAS float*)(lds + GL_SEG); LAS float* bl = (LAS float*)(lds + GL_BL); LAS float* part = (LAS float*)(lds + GL_PART); LAS float* tb = (LAS float*)(lds + GL_TB + wave * 5120);
    float Wg[16];
#pragma unroll
    for (int r = 0; r < 16; ++r) Wg[r] = par[PG_GWG + r * 256 + 64 * h + d];
    const float bgd = par[PG_GBG + 64 * h + d];
    const float gon = par[PG_GON + v0 + i16];
    f32x4 S[4];
#pragma unroll
    for (int i = 0; i < 4; ++i) S[i] = (f32x4){0.f, 0.f, 0.f, 0.f};
    unsigned gdw; unsigned short qs[8], ks[8], vv[16];
#define GLA_LOADS(mm) do { const bf16* ub_ = PROJ + ((mm) + 8 * tseg) * PG_LD; const bf16* uv_ = PROJ + ((mm) + 16 * q4) * PG_LD; \
        gdw = GLD(unsigned, PX + ((mm) + 8 * tseg) * PX_LD, (unsigned)((lane >> 3) * PX_LD + PC_GD + 2 * (lane & 7)) * 2u); \
        _Pragma("unroll") for (int i = 0; i < 8; ++i) { qs[i] = GLD(unsigned short, ub_ + i * PG_LD, (unsigned)(PC_GQ + 64 * h + d) * 2u); ks[i] = GLD(unsigned short, ub_ + i * PG_LD, (unsigned)(PC_GK + 64 * h + d) * 2u); } \
        _Pragma("unroll") for (int i = 0; i < 16; ++i) vv[i] = GLD(unsigned short, uv_ + i * PG_LD, (unsigned)(PC_GV + 128 * h + vA) * 2u); } while (0)
    GLA_LOADS((size_t)b * SEQ);
    for (int ch = 0; ch < SEQ / 64; ++ch) {
        const size_t m0 = (size_t)b * SEQ + ch * 64;
        float la[8], qv[8], kv[8];
#pragma unroll
        for (int i = 0; i < 8; ++i) { float lg = bgd;
#pragma unroll
            for (int j = 0; j < 8; ++j) { const unsigned w = (unsigned)__builtin_amdgcn_readlane((int)gdw, i * 8 + j); lg += pg8::bf_lo(w) * Wg[2 * j] + pg8::bf_hi(w) * Wg[2 * j + 1]; }
            la[i] = logsigmoidf(lg) * (1.f / 16.f); qv[i] = bf2f(qs[i]); kv[i] = bf2f(ks[i]); }
#pragma unroll
        for (int i = 1; i < 8; ++i) la[i] += la[i - 1];
        seg[tseg * 64 + d] = la[7];
        LBAR();
        float off = 0.f, tot = 0.f;
#pragma unroll
        for (int s = 0; s < 8; ++s) { const float x = seg[s * 64 + d]; tot += x; off += (s < tseg) ? x : 0.f; }
        if (tseg == 0) bl[d] = __expf(tot);
        {
            float ke[8];
#pragma unroll
            for (int i = 0; i < 8; ++i) { const float bc = off + la[i]; const int t = 8 * tseg + i;
                const float qd = qv[i] * 0.125f * __expf(bc), ki = kv[i] * __expf(-bc); ke[i] = kv[i] * __expf(tot - bc);
                *(LAS unsigned short*)(Qd + t * GL_STR + d * 2) = (unsigned short)f2bf(qd);
                *(LAS unsigned short*)(Ki + t * GL_STR + d * 2) = (unsigned short)f2bf(ki); }
            *(LAS v4u*)(KeT + d * GL_STR + 16 * tseg) = (v4u){pk2c(ke[0], ke[1]), pk2c(ke[2], ke[3]), pk2c(ke[4], ke[5]), pk2c(ke[6], ke[7])};
            v4u w0, w1;
#pragma unroll
            for (int j = 0; j < 4; ++j) { w0[j] = (unsigned)vv[2 * j] | ((unsigned)vv[2 * j + 1] << 16); w1[j] = (unsigned)vv[8 + 2 * j] | ((unsigned)vv[8 + 2 * j + 1] << 16); }
            *(LAS v4u*)(Vt + vA * GL_STR + 32 * q4) = w0; *(LAS v4u*)(Vt + vA * GL_STR + 32 * q4 + 16) = w1;
        }
        if (ch + 1 < SEQ / 64) GLA_LOADS(m0 + 64);
        LBAR();
        const v4u gq0 = GLD(v4u, PROJ + m0 * PG_LD, (unsigned)(lane * PG_LD + PC_GG + 128 * h + v0) * 2u), gq1 = GLD(v4u, PROJ + m0 * PG_LD, (unsigned)(lane * PG_LD + PC_GG + 128 * h + v0 + 8) * 2u);
        f32x4 oacc[4];
        {
            bf16x8 kiA[4][2], qdB[4][2];
#pragma unroll
            for (int J = 0; J < 4; ++J)
#pragma unroll
                for (int s = 0; s < 2; ++s) { kiA[J][s] = *(const LAS bf16x8*)(Ki + (16 * J + i16) * GL_STR + quad * 16 + 64 * s); qdB[J][s] = *(const LAS bf16x8*)(Qd + (16 * J + i16) * GL_STR + quad * 16 + 64 * s); }
            f32x4 at[4][4];
#pragma unroll
            for (int I = 0; I < 4; ++I)
#pragma unroll
                for (int J = 0; J <= I; ++J) { f32x4 z = {0.f, 0.f, 0.f, 0.f}; z = MFMA16(kiA[J][0], qdB[I][0], z); z = MFMA16(kiA[J][1], qdB[I][1], z);
                    if (J == I) {
#pragma unroll
                        for (int r = 0; r < 4; ++r) z[r] = (4 * quad + r <= i16) ? z[r] : 0.f; }
                    at[J][I] = z; }
            const LAS unsigned char* vrow = Vt + (v0 + i16) * GL_STR;
            const bf16x8 vB01 = mk8(*(const LAS u32x2*)(vrow + (0 + 4 * quad) * 2), *(const LAS u32x2*)(vrow + (16 + 4 * quad) * 2));
            const bf16x8 vB23 = mk8(*(const LAS u32x2*)(vrow + (32 + 4 * quad) * 2), *(const LAS u32x2*)(vrow + (48 + 4 * quad) * 2));
#define PK4(x, y) mk8(pk2c((x)[0], (x)[1]), pk2c((x)[2], (x)[3]), pk2c((y)[0], (y)[1]), pk2c((y)[2], (y)[3]))
#define PK4Z(x) mk8(pk2c((x)[0], (x)[1]), pk2c((x)[2], (x)[3]), 0u, 0u)
            const f32x4 zz = {0.f, 0.f, 0.f, 0.f};
            oacc[0] = MFMA16(PK4Z(at[0][0]), vB01, zz);
            oacc[1] = MFMA16(PK4(at[0][1], at[1][1]), vB01, zz);
            oacc[2] = MFMA16(PK4(at[0][2], at[1][2]), vB01, zz); oacc[2] = MFMA16(PK4Z(at[2][2]), vB23, oacc[2]);
            oacc[3] = MFMA16(PK4(at[0][3], at[1][3]), vB01, zz); oacc[3] = MFMA16(PK4(at[2][3], at[3][3]), vB23, oacc[3]);
        }
        {
            const bf16x8 sB0 = PK4(S[0], S[1]), sB1 = PK4(S[2], S[3]);
#pragma unroll
            for (int I = 0; I < 4; ++I) { const LAS unsigned char* qrow = Qd + (16 * I + i16) * GL_STR;
                const bf16x8 a0 = mk8(*(const LAS u32x2*)(qrow + (0 + 4 * quad) * 2), *(const LAS u32x2*)(qrow + (16 + 4 * quad) * 2));
                const bf16x8 a1 = mk8(*(const LAS u32x2*)(qrow + (32 + 4 * quad) * 2), *(const LAS u32x2*)(qrow + (48 + 4 * quad) * 2));
                oacc[I] = MFMA16(a0, sB0, oacc[I]); oacc[I] = MFMA16(a1, sB1, oacc[I]); }
        }
        {
            const LAS unsigned char* vrow = Vt + (v0 + i16) * GL_STR + quad * 16;
            const bf16x8 vb0 = *(const LAS bf16x8*)vrow, vb1 = *(const LAS bf16x8*)(vrow + 64);
#pragma unroll
            for (int dt = 0; dt < 4; ++dt) { const f32x4 e = *(const LAS f32x4*)(bl + 16 * dt + 4 * quad); const LAS unsigned char* krow = KeT + (16 * dt + i16) * GL_STR + quad * 16;
                f32x4 z = S[dt] * e; z = MFMA16(*(const LAS bf16x8*)krow, vb0, z); S[dt] = MFMA16(*(const LAS bf16x8*)(krow + 64), vb1, z); }
        }
#pragma unroll
        for (int I = 0; I < 4; ++I) { f32x4 q = oacc[I] * oacc[I];
#pragma unroll
            for (int r = 0; r < 4; ++r) q[r] = row16_sum(q[r]);
            if (i16 == 0) *(LAS f32x4*)(part + wave * 64 + 16 * I + 4 * quad) = q;
#pragma unroll
            for (int r = 0; r < 4; ++r) tb[(16 * I + 4 * quad + r) * 20 + i16] = oacc[I][r] * gon; }
        LBAR();
        {
            float tot = 0.f;
#pragma unroll
            for (int w = 0; w < 8; ++w) tot += part[w * 64 + lane];
            const float rs = rsqf(tot * (1.f / 128.f) + EPS);
            const f32x4 o0 = *(const LAS f32x4*)(tb + lane * 20), o1 = *(const LAS f32x4*)(tb + lane * 20 + 4), o2 = *(const LAS f32x4*)(tb + lane * 20 + 8), o3 = *(const LAS f32x4*)(tb + lane * 20 + 12);
            v4u w0, w1;
            w0.x = pk2c(o0[0] * rs * siluf(pg8::bf_lo(gq0.x)), o0[1] * rs * siluf(pg8::bf_hi(gq0.x))); w0.y = pk2c(o0[2] * rs * siluf(pg8::bf_lo(gq0.y)), o0[3] * rs * siluf(pg8::bf_hi(gq0.y)));
            w0.z = pk2c(o1[0] * rs * siluf(pg8::bf_lo(gq0.z)), o1[1] * rs * siluf(pg8::bf_hi(gq0.z))); w0.w = pk2c(o1[2] * rs * siluf(pg8::bf_lo(gq0.w)), o1[3] * rs * siluf(pg8::bf_hi(gq0.w)));
            w1.x = pk2c(o2[0] * rs * siluf(pg8::bf_lo(gq1.x)), o2[1] * rs * siluf(pg8::bf_hi(gq1.x))); w1.y = pk2c(o2[2] * rs * siluf(pg8::bf_lo(gq1.y)), o2[3] * rs * siluf(pg8::bf_hi(gq1.y)));
            w1.z = pk2c(o3[0] * rs * siluf(pg8::bf_lo(gq1.z)), o3[1] * rs * siluf(pg8::bf_hi(gq1.z))); w1.w = pk2c(o3[2] * rs * siluf(pg8::bf_lo(gq1.w)), o3[3] * rs * siluf(pg8::bf_hi(gq1.w)));
            GST(v4u, YB + m0 * 512, (unsigned)(lane * 512 + 128 * h + v0) * 2u) = w0; GST(v4u, YB + m0 * 512, (unsigned)(lane * 512 + 128 * h + v0 + 8) * 2u) = w1;
        }
    }
    LBAR();
#undef PK4
#undef PK4Z
#undef GLA_LOADS
}

constexpr int SD_XT = 0, SD_XW = 36864, SD_BN = 73728, SD_BT = 91136, SD_CN = 109568, SD_GS = 126976, SD_SM = 144384, SD_PART = 148544;
constexpr int SD_XSTR = 144, SD_NSTR = 272;
typedef float f32x2s __attribute__((ext_vector_type(2)));
__device__ __forceinline__ void ssd_unit(int unit, const bf16* PROJ, const bf16* PX, const float* par_g, bf16* YC, LAS unsigned char* lds, int tid) {
    const GAS float* par = (const GAS float*)par_g;
    const int lane = tid & 63, wave = __builtin_amdgcn_readfirstlane(tid >> 6);
    const int b = unit >> 1, g = unit & 1, i16 = lane & 15, quad = lane >> 4;
    const int hl = wave >> 1, ph = wave & 1;
    LAS unsigned char* XT = lds + SD_XT; LAS unsigned char* XW = lds + SD_XW; LAS unsigned char* BN = lds + SD_BN; LAS unsigned char* BT = lds + SD_BT; LAS unsigned char* CN = lds + SD_CN;
    LAS float* GS = (LAS float*)(lds + SD_GS); LAS float* SDT = (LAS float*)(lds + SD_SM); LAS float* SACS = SDT + 256; LAS float* SW = SACS + 256; LAS float* SEA = SW + 256; LAS float* EAL = SEA + 256;
    LAS float* PART = (LAS float*)(lds + SD_PART);
    const int th = wave >> 2, lc0_ = 2 * (tid & 255);
#define SSD_CIDX(lc) ((lc) < 256 ? 256 * g + (lc) : ((lc) < 384 ? 512 + 128 * g + ((lc) - 256) : 768 + 128 * g + ((lc) - 384)))
    const int chb0 = 64 * hl + 32 * ph;
    f32x4 H[8][2];
#pragma unroll
    for (int i = 0; i < 8; ++i) { H[i][0] = (f32x4){0.f, 0.f, 0.f, 0.f}; H[i][1] = (f32x4){0.f, 0.f, 0.f, 0.f}; }
    const float dtb = __builtin_bit_cast(float, __builtin_amdgcn_readfirstlane(__builtin_bit_cast(int, par[PG_DTB + 4 * g + (wave & 3)]))), negA = __builtin_bit_cast(float, __builtin_amdgcn_readfirstlane(__builtin_bit_cast(int, -__expf(par[PG_ALOG + 4 * g + (wave & 3)]))));
    unsigned raw[35]; unsigned short dtr;
#define SSD_LOADS(mm, first) do { const bf16* ub_ = PROJ + ((long)(mm) + 32 * th - 3) * PS_LD; \
        _Pragma("unroll") for (int i = 0; i < 35; ++i) { raw[i] = 0u; if (!(first) || th > 0 || i >= 3) raw[i] = GLD(unsigned, ub_ + i * PS_LD, (unsigned)(PC_XBC + cidx) * 2u); } \
        dtr = GLD(unsigned short, PX + (mm) * PX_LD, (unsigned)(lane * PX_LD + PC_DT + 4 * g + (wave & 3)) * 2u); } while (0)
    { const int cidx = SSD_CIDX(lc0_); SSD_LOADS((size_t)b * SEQ, true); }
    for (int ch = 0; ch < SEQ / 64; ++ch) {
        const size_t m0 = (size_t)b * SEQ + ch * 64;
        int lc0 = lc0_; asm volatile("" : "+v"(lc0));
        const int cidx = SSD_CIDX(lc0);
        const f32x2s cw0 = *(const GAS f32x2s*)(par + PG_CW + 0 * 1024 + cidx), cw1 = *(const GAS f32x2s*)(par + PG_CW + 1 * 1024 + cidx), cw2 = *(const GAS f32x2s*)(par + PG_CW + 2 * 1024 + cidx),
                      cw3 = *(const GAS f32x2s*)(par + PG_CW + 3 * 1024 + cidx), cbv = *(const GAS f32x2s*)(par + PG_CB + cidx);
        const float wa0 = cw0.x, wb0 = cw0.y, wa1 = cw1.x, wb1 = cw1.y, wa2 = cw2.x, wb2 = cw2.y, wa3 = cw3.x, wb3 = cw3.y, cba = cbv.x, cbb = cbv.y;
        if (wave < 4) {
            const float dt = softplusf(bf2f(dtr) + dtb); float acs = dt * negA;
            acs += dpp_f<0x111>(acs); acs += dpp_f<0x112>(acs); acs += dpp_f<0x114>(acs); acs += dpp_f<0x118>(acs);
            acs += dpp_f<0x142, 0xA>(acs);
            acs += dpp_f<0x143, 0xC>(acs);
            const float alast = __builtin_bit_cast(float, __builtin_amdgcn_readlane(__builtin_bit_cast(int, acs), 63));
            SDT[wave * 64 + lane] = dt; SACS[wave * 64 + lane] = acs; SW[wave * 64 + lane] = dt * __expf(alast - acs); SEA[wave * 64 + lane] = __expf(acs);
            if (lane == 0) EAL[wave] = __expf(alast);
        }
        LBAR();
        {
            float ua0 = pg8::bf_lo(raw[0]), ua1 = pg8::bf_lo(raw[1]), ua2 = pg8::bf_lo(raw[2]), ub0 = pg8::bf_hi(raw[0]), ub1 = pg8::bf_hi(raw[1]), ub2 = pg8::bf_hi(raw[2]);
#pragma unroll
            for (int grp = 0; grp < 4; ++grp) {
                float xa[8], xb[8];
#pragma unroll
                for (int i = 0; i < 8; ++i) { const unsigned wv = raw[3 + 8 * grp + i]; const float ua3 = pg8::bf_lo(wv), ub3 = pg8::bf_hi(wv);
                    const float pa = cba + wa0 * ua0 + wa1 * ua1 + wa2 * ua2 + wa3 * ua3, pb = cbb + wb0 * ub0 + wb1 * ub1 + wb2 * ub2 + wb3 * ub3;
                    xa[i] = pa * __builtin_amdgcn_rcpf(1.f + __expf(-pa)); xb[i] = pb * __builtin_amdgcn_rcpf(1.f + __expf(-pb));
                    ua0 = ua1; ua1 = ua2; ua2 = ua3; ub0 = ub1; ub1 = ub2; ub2 = ub3; }
                const int t0 = 32 * th + 8 * grp;
                const v4u pka = {pk2c(xa[0], xa[1]), pk2c(xa[2], xa[3]), pk2c(xa[4], xa[5]), pk2c(xa[6], xa[7])}, pkb = {pk2c(xb[0], xb[1]), pk2c(xb[2], xb[3]), pk2c(xb[4], xb[5]), pk2c(xb[6], xb[7])};
                if (lc0 < 256) {
                    *(LAS v4u*)(XT + lc0 * SD_XSTR + t0 * 2) = pka; *(LAS v4u*)(XT + (lc0 + 1) * SD_XSTR + t0 * 2) = pkb;
                    const f32x4 wa = *(const LAS f32x4*)(SW + (lc0 >> 6) * 64 + t0), wb = *(const LAS f32x4*)(SW + (lc0 >> 6) * 64 + t0 + 4);
                    *(LAS v4u*)(XW + lc0 * SD_XSTR + t0 * 2) = (v4u){pk2c(xa[0] * wa[0], xa[1] * wa[1]), pk2c(xa[2] * wa[2], xa[3] * wa[3]), pk2c(xa[4] * wb[0], xa[5] * wb[1]), pk2c(xa[6] * wb[2], xa[7] * wb[3])};
                    *(LAS v4u*)(XW + (lc0 + 1) * SD_XSTR + t0 * 2) = (v4u){pk2c(xb[0] * wa[0], xb[1] * wa[1]), pk2c(xb[2] * wa[2], xb[3] * wa[3]), pk2c(xb[4] * wb[0], xb[5] * wb[1]), pk2c(xb[6] * wb[2], xb[7] * wb[3])};
                } else if (lc0 < 384) { const int n = lc0 - 256;
                    *(LAS v4u*)(BT + n * SD_XSTR + t0 * 2) = pka; *(LAS v4u*)(BT + (n + 1) * SD_XSTR + t0 * 2) = pkb;
#pragma unroll
                    for (int i = 0; i < 8; ++i) *(LAS unsigned*)(BN + (t0 + i) * SD_NSTR + n * 2) = pk2c(xa[i], xb[i]);
                } else { const int n = lc0 - 384;
#pragma unroll
                    for (int i = 0; i < 8; ++i) *(LAS unsigned*)(CN + (t0 + i) * SD_NSTR + n * 2) = pk2c(xa[i], xb[i]);
                }
            }
        }
        if (ch + 1 < SEQ / 64) SSD_LOADS(m0 + 64, false);
        LBAR();
        {
#pragma unroll
            for (int rep = 0; rep < 2; ++rep) { const int ti = wave + 8 * rep;
                if (ti < 10) { const int S_ = ti < 4 ? 0 : (ti < 7 ? 1 : (ti < 9 ? 2 : 3)); const int L_ = ti < 4 ? ti : (ti < 7 ? ti - 3 : (ti < 9 ? ti - 5 : 3));
                    f32x4 z = {0.f, 0.f, 0.f, 0.f};
#pragma unroll
                    for (int ks = 0; ks < 4; ++ks) z = MFMA16(*(const LAS bf16x8*)(BN + (16 * S_ + i16) * SD_NSTR + quad * 16 + 64 * ks), *(const LAS bf16x8*)(CN + (16 * L_ + i16) * SD_NSTR + quad * 16 + 64 * ks), z);
#pragma unroll
                    for (int r = 0; r < 4; ++r) GS[(16 * S_ + 4 * quad + r) * 68 + 16 * L_ + i16] = z[r]; } }
        }
        LBAR();
        unsigned zg[4][4];
#pragma unroll
        for (int L = 0; L < 4; ++L)
#pragma unroll
            for (int r = 0; r < 4; ++r) zg[L][r] = GLD(unsigned, PROJ + (m0 + 16 * L + r) * PS_LD, (unsigned)(4 * quad * PS_LD + PC_SZ + 256 * g + chb0 + 2 * i16) * 2u);
        const float Dk = par[PG_DSK + 4 * g + hl]; const f32x2s onv = *(const GAS f32x2s*)(par + PG_SON + 256 * g + chb0 + 2 * i16);
        f32x4 yd[4][2];
#define PK4(x, y) mk8(pk2c((x)[0], (x)[1]), pk2c((x)[2], (x)[3]), pk2c((y)[0], (y)[1]), pk2c((y)[2], (y)[3]))
#define PK4Z(x) mk8(pk2c((x)[0], (x)[1]), pk2c((x)[2], (x)[3]), 0u, 0u)
        {
            const f32x4 zz = {0.f, 0.f, 0.f, 0.f};
#pragma unroll
            for (int L = 0; L < 4; ++L) { yd[L][0] = zz; yd[L][1] = zz; }
#pragma unroll
            for (int ks = 0; ks < 4; ++ks) { __builtin_amdgcn_sched_barrier(0); const bf16x8 hB0 = PK4(H[2 * ks][0], H[2 * ks + 1][0]), hB1 = PK4(H[2 * ks][1], H[2 * ks + 1][1]);
#pragma unroll
                for (int L = 0; L < 4; ++L) { const LAS unsigned char* cr = CN + (16 * L + i16) * SD_NSTR + (32 * ks + 4 * quad) * 2;
                    const bf16x8 ca = mk8(*(const LAS u32x2*)cr, *(const LAS u32x2*)(cr + 32));
                    yd[L][0] = MFMA16(ca, hB0, yd[L][0]); yd[L][1] = MFMA16(ca, hB1, yd[L][1]); } }
#pragma unroll
            for (int L = 0; L < 4; ++L) { const f32x4 ea = *(const LAS f32x4*)(SEA + hl * 64 + 16 * L + 4 * quad); yd[L][0] *= ea; yd[L][1] *= ea; }
        }
        __builtin_amdgcn_sched_barrier(0);
        {
            bf16x8 xB01[2], xB23[2];
#pragma unroll
            for (int pt = 0; pt < 2; ++pt) { const LAS unsigned char* xr = XT + (chb0 + 2 * i16 + pt) * SD_XSTR;
                xB01[pt] = mk8(*(const LAS u32x2*)(xr + (0 + 4 * quad) * 2), *(const LAS u32x2*)(xr + (16 + 4 * quad) * 2));
                xB23[pt] = mk8(*(const LAS u32x2*)(xr + (32 + 4 * quad) * 2), *(const LAS u32x2*)(xr + (48 + 4 * quad) * 2)); }
#pragma unroll
            for (int L = 0; L < 4; ++L) { __builtin_amdgcn_sched_barrier(0); const float acs_l = SACS[hl * 64 + 16 * L + i16];
                f32x4 mt[4];
#pragma unroll
                for (int S_ = 0; S_ <= L; ++S_) { const f32x4 acs_s = *(const LAS f32x4*)(SACS + hl * 64 + 16 * S_ + 4 * quad), dt_s = *(const LAS f32x4*)(SDT + hl * 64 + 16 * S_ + 4 * quad);
#pragma unroll
                    for (int r = 0; r < 4; ++r) { const float gv = GS[(16 * S_ + 4 * quad + r) * 68 + 16 * L + i16]; const float v = gv * __expf(acs_l - acs_s[r]) * dt_s[r];
                        mt[S_][r] = (S_ < L || 4 * quad + r <= i16) ? v : 0.f; } }
#pragma unroll
                for (int pt = 0; pt < 2; ++pt) {
                    if (L == 0) yd[L][pt] = MFMA16(PK4Z(mt[0]), xB01[pt], yd[L][pt]);
                    else if (L == 1) yd[L][pt] = MFMA16(PK4(mt[0], mt[1]), xB01[pt], yd[L][pt]);
                    else if (L == 2) { yd[L][pt] = MFMA16(PK4(mt[0], mt[1]), xB01[pt], yd[L][pt]); yd[L][pt] = MFMA16(PK4Z(mt[2]), xB23[pt], yd[L][pt]); }
                    else { yd[L][pt] = MFMA16(PK4(mt[0], mt[1]), xB01[pt], yd[L][pt]); yd[L][pt] = MFMA16(PK4(mt[2], mt[3]), xB23[pt], yd[L][pt]); } } }
        }
        __builtin_amdgcn_sched_barrier(0);
        {
            const float eal = EAL[hl];
            bf16x8 xw[2][2];
#pragma unroll
            for (int pt = 0; pt < 2; ++pt)
#pragma unroll
                for (int k2 = 0; k2 < 2; ++k2) xw[pt][k2] = *(const LAS bf16x8*)(XW + (chb0 + 2 * i16 + pt) * SD_XSTR + quad * 16 + 64 * k2);
#pragma unroll
            for (int nt = 0; nt < 8; ++nt) { if ((nt & 1) == 0) __builtin_amdgcn_sched_barrier(0); const LAS unsigned char* br = BT + (16 * nt + i16) * SD_XSTR + quad * 16;
                const bf16x8 b0 = *(const LAS bf16x8*)br, b1 = *(const LAS bf16x8*)(br + 64);
#pragma unroll
                for (int pt = 0; pt < 2; ++pt) { f32x4 z = H[nt][pt] * eal; z = MFMA16(b0, xw[pt][0], z); H[nt][pt] = MFMA16(b1, xw[pt][1], z); } }
        }
        __builtin_amdgcn_sched_barrier(0);
        const float on0 = onv.x, on1 = onv.y;
#pragma unroll
        for (int L = 0; L < 4; ++L) { f32x4 q = {0.f, 0.f, 0.f, 0.f};
#pragma unroll
            for (int pt = 0; pt < 2; ++pt) { const u32x2 xw2 = *(const LAS u32x2*)(XT + (chb0 + 2 * i16 + pt) * SD_XSTR + (16 * L + 4 * quad) * 2);
                const float xv[4] = {pg8::bf_lo(xw2.x), pg8::bf_hi(xw2.x), pg8::bf_lo(xw2.y), pg8::bf_hi(xw2.y)};
#pragma unroll
                for (int r = 0; r < 4; ++r) { const float y = yd[L][pt][r] + Dk * xv[r]; const float u = y * siluf(pt ? pg8::bf_hi(zg[L][r]) : pg8::bf_lo(zg[L][r])); yd[L][pt][r] = u; q[r] += u * u; } }
#pragma unroll
            for (int r = 0; r < 4; ++r) q[r] = row16_sum(q[r]);
            if (i16 == 0) *(LAS f32x4*)(PART + wave * 64 + 16 * L + 4 * quad) = q; }
        LBAR();
#pragma unroll
        for (int L = 0; L < 4; ++L) { f32x4 tot4 = {0.f, 0.f, 0.f, 0.f};
#pragma unroll
            for (int w = 0; w < 8; ++w) tot4 += *(const LAS f32x4*)(PART + w * 64 + 16 * L + 4 * quad);
#pragma unroll
            for (int r = 0; r < 4; ++r) { const float rs = rsqf(tot4[r] * (1.f / 256.f) + EPS); GST(unsigned, YC + (m0 + 16 * L + r) * 512, (unsigned)(4 * quad * 512 + 256 * g + chb0 + 2 * i16) * 2u) = pk2c(yd[L][0][r] * rs * on0, yd[L][1][r] * rs * on1); } }
    }
    LBAR();
#undef PK4
#undef PK4Z
#undef SSD_LOADS
#undef SSD_CIDX
}


struct MgOrder {
    int xcd, nloc, first, stride;
    __device__ __forceinline__ void init(int bx) { xcd = bx & 7; if (bx < 64) { nloc = 9; first = 312 + (bx >> 3); stride = 8; } else { nloc = 13; first = (bx - 64) >> 3; stride = 24; } }
    __device__ __forceinline__ bool next(int i, pg8::Unit& u) const { if (i >= nloc) return false; const int off = first + i * stride, grp = off / 96, w = off % 96; u.pm = (xcd * 4 + grp) * 8 + (w & 7); u.pn = w >> 3; return true; }
    __device__ __forceinline__ void a_ready(const pg8::Unit&) const {}
    __device__ __forceinline__ void done(const pg8::Unit&) const {}
};

struct Merge3Order {
    pg8::StaticOrder S;
    __device__ __forceinline__ bool next(int i, pg8::Unit& u) const { const int j = i / 3, br = i - 3 * j; const int R = S.nwg / S.G; if (!S.next((S.nwg == R * S.G && j < R) ? R - 1 - j : j, u)) return false;
        u.pm += br * 256; u.pn += br * 4; return true; }
    __device__ __forceinline__ void a_ready(const pg8::Unit&) const {}
    __device__ __forceinline__ void done(const pg8::Unit&) const {}
};

__global__ void __launch_bounds__(NTHR, 2) mega_fwd(Args args) {
    extern __shared__ __attribute__((aligned(16))) unsigned char lds_raw[];
    LAS unsigned char* lds = (LAS unsigned char*)lds_raw;
    volatile LAS unsigned* MISC = (volatile LAS unsigned*)(lds + MISC_OFF);
    const int tid = threadIdx.x, lane = tid & 63, wave = __builtin_amdgcn_readfirstlane(tid >> 6);
    const int G = gridDim.x, bx = blockIdx.x;
    unsigned char* ws = args.ws;
    gu32* ctl = (gu32*)(ws + WS_CTL);
    const float* x_in = (const float*)args.in[0];
    float* out = args.out;

    for (int u = tid; u < (LDS_BYTES - LDSCTL_OFF) / 4; u += NTHR) ((LAS unsigned*)(lds + LDSCTL_OFF))[u] = 0u;
    __syncthreads();
    XcdBarrier bar = xcd_barrier_post((unsigned*)(ctl + CW_BAR) + args.li * XCD_BAR_WORDS, MISC + 8);
    const int lo = args.ph_lo, hi = args.ph_hi; (void)lo; (void)hi;
#define IN(k) (lo <= (k) && (k) < hi)
#define OWS() ({ unsigned char* w_ = ws; asm volatile("" : "+s"(w_)); w_; })
#define WIN ((bf16*)(OWS() + WS_WIN))
#define WB ((bf16*)(OWS() + WS_WB))
#define WO ((bf16*)(OWS() + WS_WO))
#define XN ((bf16*)(OWS() + WS_XN))
#define Y ((bf16*)(OWS() + WS_Y))
#define PA ((bf16*)(OWS() + WS_PA))
#define PG ((bf16*)(OWS() + WS_PG))
#define PS ((bf16*)(OWS() + WS_PS))
#define PX ((bf16*)(OWS() + WS_PX))
#define MG ((bf16*)(OWS() + WS_MG))
#define MERGED ((bf16*)(OWS() + WS_MERGED))
#define CS ((float2*)(OWS() + WS_CS))
#define KR ((float*)(OWS() + WS_KR))
#define PAR ((float*)(OWS() + WS_PAR))
#define otid() ({ int t_ = tid; asm volatile("" : "+v"(t_)); t_; })
#define SEAM(k) do { if (IN(k) && IN((k) + 1)) xcd_barrier(bar); } while (0)
    const int gw = bx * NWAVES + wave, NGW = G * NWAVES;

    if (IN(0)) {
        LAS float* scr = (LAS float*)(lds + RING_OFF + wave * 16384);
        constexpr int I_IN = (D / 64) * (NINP / 32), I_B = (512 / 64) * (D / 32), I_O = (D / 64) * (D / 32);
        constexpr int NITEMS = DEPTH * (I_IN + 3 * I_B + I_O);
        for (int it = gw; it < NITEMS; it += NGW) {
            int r = it; const int l = r / (I_IN + 3 * I_B + I_O); r -= l * (I_IN + 3 * I_B + I_O);
            if (r < I_IN) { transpose_item<true>((const float*)args.in[3] + (size_t)l * D * NIN, D, NIN, WIN + (size_t)l * NINP * D, scr, r, NINP / 32, lane, l > 0 ? (const float*)args.in[2] + (size_t)l * D : nullptr); continue; } r -= I_IN;
            if (r < 3 * I_B) { const int n = r / I_B; r -= n * I_B;
                transpose_item<false>((const float*)args.in[16] + (size_t)(l * 3 + n) * 512 * D, 512, D, WB + (size_t)(l * 3 + n) * D * 512, scr, r, D / 32, lane); continue; } r -= 3 * I_B;
            transpose_item<false>((const float*)args.in[17] + (size_t)l * D * D, D, D, WO + (size_t)l * D * D, scr, r, D / 32, lane);
        }
        for (int m = 2 * gw; m < M; m += 2 * NGW) rms_rows2_to_bf16(x_in + (size_t)m * D, x_in + (size_t)(m + 1) * D, (const float*)args.in[2], XN + (size_t)m * D, XN + (size_t)(m + 1) * D, lane);
        for (int e = bx * NTHR + tid; e < M * 32; e += G * NTHR) { const int m = e >> 5, i = e & 31;
            const float inv = exp2f(-(float)(2 * i) * (13.287712379549449f / 64.f)); const float ang = (float)((const int*)args.in[1])[m] * inv; const float rev = ang * 0.15915494309189535f; const float fr = rev - floorf(rev);
            *(GAS f32x2s*)(CS + e) = (f32x2s){__builtin_amdgcn_cosf(fr), __builtin_amdgcn_sinf(fr)}; }
        {
            const int gt = bx * NTHR + tid, GT = G * NTHR;
#define CPY(idx, off, n) for (int e = gt; e < DEPTH * (n); e += GT) *(GAS float*)(PAR + (e / (n)) * PSTRIDE + (off) + e % (n)) = ((const GAS float*)args.in[idx])[e]
            CPY(2, PG_NORM, 1024); CPY(4, PG_QN, 64); CPY(5, PG_KN, 64); CPY(6, PG_SINK, 8); CPY(7, PG_GWG, 4096); CPY(8, PG_GBG, 256); CPY(9, PG_GON, 128);
            CPY(10, PG_CW, 4096); CPY(11, PG_CB, 1024); CPY(12, PG_DTB, 8); CPY(13, PG_ALOG, 8); CPY(14, PG_DSK, 8); CPY(15, PG_SON, 512);
#undef CPY
        }
    }
    SEAM(0);

    for (int l = 0; l < DEPTH; ++l) {
        const int pb = 1 + 7 * l;
        const float* xin = l == 0 ? x_in : out;
        const float* par = PAR + l * PSTRIDE;
        if (IN(pb + 0)) {
            pg8::Gemm g{XN, WIN + (size_t)l * NINP * D, M, NMAIN, D}; pg8::StaticOrder S; S.init(M, NMAIN, G, bx);
            pg8::EpiProj E{PA, PG, PS, PX, l > 0 ? (const float*)(OWS() + WS_RINV) : nullptr};
            pg8::gemm_phase<pg8::EpiProj, pg8::StaticOrder, true, true>(lds + RING_OFF, g, S, E, otid());
        }
        SEAM(pb + 0);
        if (IN(pb + 2)) {
            for (int uu = bx; uu < 192; uu += G) {
            if (uu < 64) ssd_unit(uu, PS, PX, par, Y + (size_t)2 * M * 512, lds, otid());
            else { gla_unit(uu - 64, PG, PX, par, Y + (size_t)1 * M * 512, lds, otid()); if (otid() == 0) __hip_atomic_fetch_add((unsigned*)(ctl + CW_DONE + 64 * l), 1u, __ATOMIC_RELAXED, __HIP_MEMORY_SCOPE_AGENT); }
            }
            unsigned qn = 0; if (otid() == 0) qn = __hip_atomic_fetch_add((unsigned*)(ctl + CW_Q + 64 * l), 1u, __ATOMIC_RELAXED, __HIP_MEMORY_SCOPE_AGENT);
            for (;;) {
                __syncthreads();
                if (otid() == 0) MISC[0] = qn;
                __syncthreads();
                const unsigned item = (unsigned)__builtin_amdgcn_readfirstlane((int)MISC[0]);
                if (item >= 1024u) break;
                if (otid() == 0) qn = __hip_atomic_fetch_add((unsigned*)(ctl + CW_Q + 64 * l), 1u, __ATOMIC_RELAXED, __HIP_MEMORY_SCOPE_AGENT);
                attn_unit((int)item, PA, CS, par, Y, lds, otid());
                if (otid() == 0) __hip_atomic_fetch_add((unsigned*)(ctl + CW_DONE + 64 * l), 1u, __ATOMIC_RELAXED, __HIP_MEMORY_SCOPE_AGENT);
            }
        }
        const bool ovl = (G == 256) && IN(pb + 2) && IN(pb + 3);
        if (!ovl) SEAM(pb + 2);
        if (IN(pb + 3)) {
            pg8::Gemm g{XN, WIN + (size_t)l * NINP * D + (size_t)NMAIN * D, M, NMG, D};
            pg8::EpiGate E{MG, NMG, l > 0 ? (const float*)(OWS() + WS_RINV) : nullptr};
            if (ovl) {
                if (otid() == 0) { unsigned sp_ = 0; while (__hip_atomic_load((unsigned*)(ctl + CW_DONE + 64 * l), __ATOMIC_RELAXED, __HIP_MEMORY_SCOPE_AGENT) < (unsigned)N_AG_UNITS) { __builtin_amdgcn_s_sleep(8);
                        if (++sp_ > (1u << 22)) { __hip_atomic_store((unsigned*)(ctl + CW_TMO), 1u, __ATOMIC_RELAXED, __HIP_MEMORY_SCOPE_AGENT); break; } } }
                __syncthreads();
                MgOrder S; S.init(bx);
                pg8::gemm_phase<pg8::EpiGate, MgOrder, true, true>(lds + RING_OFF, g, S, E, otid());
            } else {
                pg8::StaticOrder S; S.init(M, NMG, G, bx);
                pg8::gemm_phase<pg8::EpiGate, pg8::StaticOrder, true, true>(lds + RING_OFF, g, S, E, otid());
            }
        }
        SEAM(pb + 3);
        if (IN(pb + 4)) {
            pg8::Gemm g{Y, WB + (size_t)(l * 3) * D * 512, M, D, 512}; Merge3Order S; S.S.init(M, D, G, bx);
            pg8::EpiMerge3 E{MG, MERGED};
            pg8::gemm_phase<pg8::EpiMerge3, Merge3Order, true, true>(lds + RING_OFF, g, S, E, otid());
        }
        SEAM(pb + 4);
        if (IN(pb + 5)) {
            pg8::Gemm g{MERGED, WO + (size_t)l * D * D, M, D, D}; pg8::StaticOrder S; S.init(M, D, G, bx);
            if (l + 1 < DEPTH) { pg8::EpiResidA E{xin, XN, (float*)(OWS() + WS_RPART)}; pg8::gemm_phase<pg8::EpiResidA, pg8::StaticOrder, true, true>(lds + RING_OFF, g, S, E, otid()); }
            else { pg8::EpiResidB E{XN, out}; pg8::gemm_phase<pg8::EpiResidB, pg8::StaticOrder, true, true>(lds + RING_OFF, g, S, E, otid()); }
        }
        SEAM(pb + 5);
        if (l + 1 < DEPTH) {
            if (IN(pb + 6)) { const float* rp = (const float*)(OWS() + WS_RPART); float* ri = (float*)(OWS() + WS_RINV);
                for (int r_ = bx * NTHR + otid(); r_ < M; r_ += G * NTHR) { const f32x4 a0 = GLD(f32x4, rp, (unsigned)r_ * 64u), a1 = GLD(f32x4, rp, (unsigned)r_ * 64u + 16u), a2 = GLD(f32x4, rp, (unsigned)r_ * 64u + 32u), a3 = GLD(f32x4, rp, (unsigned)r_ * 64u + 48u);
                    const f32x4 s4 = (a0 + a1) + (a2 + a3); *(GAS float*)(ri + r_) = rsqf(((s4[0] + s4[1]) + (s4[2] + s4[3])) * (1.f / D) + EPS); } }
            SEAM(pb + 6);
        }
    }
#undef IN
#undef WIN
#undef WB
#undef WO
#undef XN
#undef Y
#undef PA
#undef PG
#undef PS
#undef PX
#undef MG
#undef MERGED
#undef CS
#undef KR
#undef PAR
#undef SEAM
}

#ifndef MK_SPLIT
#define MK_SPLIT 1
#endif
extern "C" void kernel_launch(void* const* d_in, const int* in_sizes, int n_in, void* d_out, int out_size, void* d_ws, size_t ws_size, hipStream_t stream) {
    static int grid = 0;
    if (grid == 0) {
        if (n_in != 18 || in_sizes[0] != M * D || out_size != M * D || ws_size < WS_END) { fprintf(stderr, "kernel_launch: unexpected shapes/ws (n_in %d, ws %zu)\n", n_in, ws_size); grid = -1; return; }
        int dev = 0, cus = 0, per_cu = 0;
        if (hipGetDevice(&dev) != hipSuccess || hipDeviceGetAttribute(&cus, hipDeviceAttributeMultiprocessorCount, dev) != hipSuccess) { grid = -1; return; }
        if (hipFuncSetAttribute((const void*)mega_fwd, hipFuncAttributeMaxDynamicSharedMemorySize, LDS_BYTES) != hipSuccess) { grid = -1; return; }
        if (hipOccupancyMaxActiveBlocksPerMultiprocessor(&per_cu, (const void*)mega_fwd, NTHR, LDS_BYTES) != hipSuccess || per_cu < 1) { fprintf(stderr, "kernel_launch: occupancy query says %d\n", per_cu); }
        (void)hipGetLastError();
        grid = cus;
    }
    if (grid < 0) return;
    if (hipMemsetAsync((char*)d_ws + WS_CTL, 0, CTL_ZERO_BYTES, stream) != hipSuccess) return;
    Args a{};
    for (int i = 0; i < 18; ++i) a.in[i] = d_in[i];
    a.out = (float*)d_out; a.ws = (unsigned char*)d_ws;
#if MK_SPLIT
    int li = 0;
    for (int ph = 0; ph < NPHASE; ++ph) {
        a.ph_lo = ph; a.ph_hi = ph + 1; a.li = li++; a.pad = 0;
        hipLaunchKernelGGL(mega_fwd, dim3(grid), dim3(NTHR), LDS_BYTES, stream, a); }
#else
    a.ph_lo = 0; a.ph_hi = NPHASE; a.li = 0; a.pad = 0;
    hipLaunchKernelGGL(mega_fwd, dim3(grid), dim3(NTHR), LDS_BYTES, stream, a);
#endif
}
```

```cpp
#include <hip/hip_runtime.h>
#include <cstdio>
#include <cstdint>
#define MK_SPLIT 0
namespace pg8 {
#define PG8_LAS __attribute__((address_space(3)))
typedef unsigned short bf16_t;
typedef short bf16x8 __attribute__((ext_vector_type(8)));
typedef float f32x4 __attribute__((ext_vector_type(4)));
typedef unsigned u32x4 __attribute__((ext_vector_type(4)));
constexpr int BM = 256, BK = 64, HALF = 128, HTB = HALF * BK * 2  , STAGE_BYTES = 8 * HTB, NXCD = 8, WGM = 8;

__host__ __device__ __forceinline__ int lds_byte(int r, int c) { const int st = (r >> 4) * 2 + (c >> 5), rr = r & 15, cc = c & 31, ob = rr * 64 + cc * 2; return st * 1024 + (ob ^ (((ob >> 9) & 1) << 5)); }
__host__ __device__ __forceinline__ void stage_rc(int b, int& R, int& C) { const int st = b / 1024, sb = b % 1024, swz = sb ^ (((sb >> 9) & 1) << 5); R = (st >> 1) * 16 + swz / 64; C = (st & 1) * 32 + (swz % 64) / 2; }
__host__ __device__ __forceinline__ int perm32(int rho) { const int n = rho >> 4, i = rho & 15; return 8 * (i >> 2) + 4 * n + (i & 3); }

struct Unit { int pm, pn; };
struct Gemm { const bf16_t* A; const bf16_t* Bt; int M, N, K; };

struct StaticOrder {
    int nM, nN, nwg, G, c;
    __host__ __device__ void init(int M, int N, int G_, int c_) { nM = M / BM; nN = N / BM; nwg = nM * nN; G = G_; c = c_; }
    __host__ __device__ bool next(int i, Unit& u) const {
        const long L = (long)i * G + c; if (L >= nwg) return false;
        int wgid = (int)L; { const int q = nwg / NXCD, r = nwg % NXCD, xcd = wgid % NXCD, off = wgid / NXCD; wgid = (xcd < r ? xcd * (q + 1) : r * (q + 1) + (xcd - r) * q) + off; }
        const int nig = WGM * nN, gid = wgid / nig, fm = gid * WGM, gsz = (nM - fm) < WGM ? (nM - fm) : WGM;
        u.pm = fm + ((wgid % nig) % gsz); u.pn = (wgid % nig) / gsz; return true;
    }
    __device__ __forceinline__ void a_ready(const Unit&) const {}
    __device__ __forceinline__ void done(const Unit&) const {}
};

typedef float f32x2c __attribute__((ext_vector_type(2))); typedef __bf16 bf16x2c __attribute__((ext_vector_type(2)));
__device__ __forceinline__ unsigned cvt_pk_bf16(float lo, float hi) { const f32x2c v = {lo, hi}; const bf16x2c b = __builtin_convertvector(v, bf16x2c); return __builtin_bit_cast(unsigned, b); }
typedef float f32x2 __attribute__((ext_vector_type(2)));

#define PG8_GAS __attribute__((address_space(1)))
template <class T> __device__ __forceinline__ T gld_(const void* p) { return *(const PG8_GAS T*)p; }
template <class T> __device__ __forceinline__ void gst_(void* p, T v) { *(PG8_GAS T*)p = v; }
__device__ __forceinline__ float sigmoid_fast(float x) { return __builtin_amdgcn_rcpf(1.f + __builtin_amdgcn_exp2f(-1.44269504f * x)); }
__device__ __forceinline__ float bf_lo(unsigned w) { return __builtin_bit_cast(float, w << 16); }
__device__ __forceinline__ float bf_hi(unsigned w) { return __builtin_bit_cast(float, w & 0xffff0000u); }

__device__ __forceinline__ float xrow_sum_e(float x) { unsigned a = __builtin_bit_cast(unsigned, x), b = a; asm volatile("s_nop 1\n\tv_permlane16_swap_b32 %0, %1" : "+v"(a), "+v"(b));
    const float y = __builtin_bit_cast(float, a) + __builtin_bit_cast(float, b); unsigned c = __builtin_bit_cast(unsigned, y), d = c; asm volatile("s_nop 1\n\tv_permlane32_swap_b32 %0, %1" : "+v"(c), "+v"(d));
    return __builtin_bit_cast(float, c) + __builtin_bit_cast(float, d); }
template <int ACT> struct EpiBf16 {
    static constexpr bool PERM = true, AFTER_DRAIN = false, CHAIN = false, PRE = false;
    bf16_t* O; int ldc; const float* rinv;
    __device__ __forceinline__ void operator()(const f32x4 (&acc)[2][2][4][2], const Unit& u, int wr, int wc, int fr, int fq) const {
        const int row0 = u.pm * BM + wr * 64 + fr; const int col0 = u.pn * BM + wc * 32 + 8 * fq;
        float rs[2][4];
#pragma unroll
        for (int ai = 0; ai < 2; ++ai)
#pragma unroll
            for (int m = 0; m < 4; ++m) rs[ai][m] = rinv ? gld_<float>(rinv + row0 + ai * HALF + m * 16) : 1.f;
#pragma unroll
        for (int ai = 0; ai < 2; ++ai)
#pragma unroll
            for (int m = 0; m < 4; ++m) { bf16_t* rowp = O + (size_t)(row0 + ai * HALF + m * 16) * ldc + col0;
#pragma unroll
                for (int bj = 0; bj < 2; ++bj) { f32x4 v0 = acc[ai][bj][m][0] * rs[ai][m], v1 = acc[ai][bj][m][1] * rs[ai][m];
                    if (ACT == 1) {
#pragma unroll
                        for (int j = 0; j < 4; ++j) { v0[j] = __builtin_amdgcn_rcpf(1.f + __builtin_amdgcn_exp2f(fminf(v0[j], 60.f))); v1[j] = __builtin_amdgcn_rcpf(1.f + __builtin_amdgcn_exp2f(fminf(v1[j], 60.f))); } }
                    u32x4 w; w.x = cvt_pk_bf16(v0[0], v0[1]); w.y = cvt_pk_bf16(v0[2], v0[3]); w.z = cvt_pk_bf16(v1[0], v1[1]); w.w = cvt_pk_bf16(v1[2], v1[3]);
                    gst_<u32x4>(rowp + bj * HALF, w); } }
    }
};
struct EpiGate {
    static constexpr bool PERM = true, AFTER_DRAIN = false, CHAIN = false, PRE = true;
    bf16_t* O; int ldc; const float* rinv;
    __device__ __forceinline__ void pre(const Unit& u, int wr, int fr, PG8_LAS unsigned char* slot) const {
        if (!rinv) return;
        int f_ = fr; asm volatile("" : "+v"(f_));
        const int row0 = u.pm * BM + wr * 64 + f_;
#pragma unroll
        for (int k = 0; k < 8; ++k) __builtin_amdgcn_global_load_lds((const PG8_GAS unsigned*)(rinv + row0 + (k >> 2) * HALF + (k & 3) * 16), (PG8_LAS unsigned*)(slot + k * 256), 4, 0, 0);
    }
    __device__ __forceinline__ void operator()(const f32x4 (&acc)[2][2][4][2], const Unit& u, int wr, int wc, int fr, int fq, const PG8_LAS unsigned char* slot) const {
        float rs[2][4];
        if (rinv) { asm volatile("s_waitcnt vmcnt(0)" ::: "memory");
#pragma unroll
            for (int k = 0; k < 8; ++k) rs[k >> 2][k & 3] = *(const PG8_LAS float*)(slot + k * 256 + (fr + 16 * fq) * 4); }
        else {
#pragma unroll
            for (int k = 0; k < 8; ++k) rs[k >> 2][k & 3] = 1.f; }
        const int row0 = u.pm * BM + wr * 64 + fr;
        if (u.pn < 8) {
            const int colq = u.pn * HALF + wc * 32 + 8 * fq;
#pragma unroll
            for (int ai = 0; ai < 2; ++ai)
#pragma unroll
                for (int m = 0; m < 4; ++m) { bf16_t* rowp = O + (size_t)(row0 + ai * HALF + m * 16) * ldc + colq;
                    float r[8], g[8];
#pragma unroll
                    for (int n = 0; n < 2; ++n)
#pragma unroll
                        for (int j = 0; j < 4; ++j) { const float d0 = 1.f + __builtin_amdgcn_exp2f(fminf(acc[ai][0][m][n][j] * rs[ai][m], 60.f)), d1 = 1.f + __builtin_amdgcn_exp2f(fminf(acc[ai][1][m][n][j] * rs[ai][m], 60.f));
                            g[4 * n + j] = __builtin_amdgcn_rcpf(d1); r[4 * n + j] = d1 * __builtin_amdgcn_rcpf(d0); }
                    u32x4 w; w.x = cvt_pk_bf16(r[0], r[1]); w.y = cvt_pk_bf16(r[2], r[3]); w.z = cvt_pk_bf16(r[4], r[5]); w.w = cvt_pk_bf16(r[6], r[7]);
                    gst_<u32x4>(rowp, w);
                    w.x = cvt_pk_bf16(g[0], g[1]); w.y = cvt_pk_bf16(g[2], g[3]); w.z = cvt_pk_bf16(g[4], g[5]); w.w = cvt_pk_bf16(g[6], g[7]);
                    gst_<u32x4>(rowp + 1024, w); }
        } else {
            const int col0 = u.pn * BM + wc * 32 + 8 * fq;
#pragma unroll
            for (int ai = 0; ai < 2; ++ai)
#pragma unroll
                for (int m = 0; m < 4; ++m) { bf16_t* rowp = O + (size_t)(row0 + ai * HALF + m * 16) * ldc + col0;
#pragma unroll
                    for (int bj = 0; bj < 2; ++bj) { f32x4 v0 = acc[ai][bj][m][0] * rs[ai][m], v1 = acc[ai][bj][m][1] * rs[ai][m];
#pragma unroll
                        for (int j = 0; j < 4; ++j) { v0[j] = __builtin_amdgcn_rcpf(1.f + __builtin_amdgcn_exp2f(fminf(v0[j], 60.f))); v1[j] = __builtin_amdgcn_rcpf(1.f + __builtin_amdgcn_exp2f(fminf(v1[j], 60.f))); }
                        u32x4 w; w.x = cvt_pk_bf16(v0[0], v0[1]); w.y = cvt_pk_bf16(v0[2], v0[3]); w.z = cvt_pk_bf16(v1[0], v1[1]); w.w = cvt_pk_bf16(v1[2], v1[3]);
                        gst_<u32x4>(rowp + bj * HALF, w); } }
        }
    }
};
struct EpiProj {
    static constexpr bool PERM = true, AFTER_DRAIN = false, CHAIN = false, PRE = true;
    bf16_t *pa, *pg, *ps, *px; const float* rinv;
    __device__ __forceinline__ void pre(const Unit& u, int wr, int fr, PG8_LAS unsigned char* slot) const {
        if (!rinv) return;
        int f_ = fr; asm volatile("" : "+v"(f_));
        const int row0 = u.pm * BM + wr * 64 + f_;
#pragma unroll
        for (int k = 0; k < 8; ++k) __builtin_amdgcn_global_load_lds((const PG8_GAS unsigned*)(rinv + row0 + (k >> 2) * HALF + (k & 3) * 16), (PG8_LAS unsigned*)(slot + k * 256), 4, 0, 0);
    }
    __device__ __forceinline__ void operator()(const f32x4 (&acc)[2][2][4][2], const Unit& u, int wr, int wc, int fr, int fq, const PG8_LAS unsigned char* slot) const {
        float rs[2][4];
        if (rinv) { asm volatile("s_waitcnt vmcnt(0)" ::: "memory");
#pragma unroll
            for (int k = 0; k < 8; ++k) rs[k >> 2][k & 3] = *(const PG8_LAS float*)(slot + k * 256 + (fr + 16 * fq) * 4); }
        else {
#pragma unroll
            for (int k = 0; k < 8; ++k) rs[k >> 2][k & 3] = 1.f; }
        bf16_t* O; int ldc, ct;
        if (u.pn < 5) { O = pa; ldc = 1280; ct = u.pn; } else if (u.pn < 11) { O = pg; ldc = 1536; ct = u.pn - 5; } else if (u.pn < 17) { O = ps; ldc = 1536; ct = u.pn - 11; } else { O = px; ldc = 32; ct = 0; }
        const int row0 = u.pm * BM + wr * 64 + fr; const int col0 = ct * BM + wc * 32 + 8 * fq;
#pragma unroll
        for (int ai = 0; ai < 2; ++ai)
#pragma unroll
            for (int m = 0; m < 4; ++m) { bf16_t* rowp = O + (size_t)(row0 + ai * HALF + m * 16) * ldc + col0;
#pragma unroll
                for (int bj = 0; bj < 2; ++bj) { const f32x4 v0 = acc[ai][bj][m][0] * rs[ai][m], v1 = acc[ai][bj][m][1] * rs[ai][m];
                    u32x4 w; w.x = cvt_pk_bf16(v0[0], v0[1]); w.y = cvt_pk_bf16(v0[2], v0[3]); w.z = cvt_pk_bf16(v1[0], v1[1]); w.w = cvt_pk_bf16(v1[2], v1[3]);
                    if (u.pn < 17 || (bj == 0 && wc == 0)) gst_<u32x4>(rowp + bj * HALF, w); } }
    }
};
struct EpiMerge {
    static constexpr bool PERM = true, AFTER_DRAIN = false, CHAIN = false, PRE = false;
    const bf16_t* Gt; int ldg; bf16_t* Mg; int ldm; int first;
    __device__ __forceinline__ void operator()(const f32x4 (&acc)[2][2][4][2], const Unit& u, int wr, int wc, int fr, int fq) const {
        const int row0 = u.pm * BM + wr * 64 + fr; const int col0 = u.pn * BM + wc * 32 + 8 * fq;
#pragma unroll
        for (int ai = 0; ai < 2; ++ai) {
            u32x4 g[4][2], p[4][2];
#pragma unroll
            for (int m = 0; m < 4; ++m) { const size_t row = (size_t)(row0 + ai * HALF + m * 16);
#pragma unroll
                for (int bj = 0; bj < 2; ++bj) { g[m][bj] = gld_<u32x4>(Gt + row * ldg + col0 + bj * HALF);
                    p[m][bj] = (u32x4){0u, 0u, 0u, 0u}; if (!first) p[m][bj] = gld_<u32x4>(Mg + row * ldm + col0 + bj * HALF); } }
#pragma unroll
            for (int m = 0; m < 4; ++m) { const size_t row = (size_t)(row0 + ai * HALF + m * 16);
#pragma unroll
                for (int bj = 0; bj < 2; ++bj) { const f32x4 a0 = acc[ai][bj][m][0], a1 = acc[ai][bj][m][1]; const u32x4 gg = g[m][bj], pp = p[m][bj];
                    u32x4 w;
                    w.x = cvt_pk_bf16(bf_lo(pp.x) + bf_lo(gg.x) * a0[0], bf_hi(pp.x) + bf_hi(gg.x) * a0[1]);
                    w.y = cvt_pk_bf16(bf_lo(pp.y) + bf_lo(gg.y) * a0[2], bf_hi(pp.y) + bf_hi(gg.y) * a0[3]);
                    w.z = cvt_pk_bf16(bf_lo(pp.z) + bf_lo(gg.z) * a1[0], bf_hi(pp.z) + bf_hi(gg.z) * a1[1]);
                    w.w = cvt_pk_bf16(bf_lo(pp.w) + bf_lo(gg.w) * a1[2], bf_hi(pp.w) + bf_hi(gg.w) * a1[3]);
                    gst_<u32x4>(Mg + row * ldm + col0 + bj * HALF, w); } }
        }
    }
};
struct EpiMerge3 {
    static constexpr bool PERM = true, AFTER_DRAIN = false, CHAIN = true, PRE = false;
    static constexpr int LDG = 3072, LDM = 1024;
    const bf16_t* Gt; bf16_t* Mg;
    template <class T> static __device__ __forceinline__ T ldo(const bf16_t* base, int cdisp, unsigned off) { return *(const PG8_GAS T*)((const PG8_GAS unsigned char*)(base + cdisp) + (size_t)off); }
    template <int BR> __device__ __forceinline__ void run(f32x4 (&acc)[2][2][4][2], const Unit& u, int wr, int wc, int fr, int fq) const {
        const int row0 = (u.pm & 255) * BM + wr * 64 + fr; const int col0 = (u.pn & 3) * BM + wc * 32 + 8 * fq;
        const unsigned og = ((unsigned)row0 * LDG + col0) * 2u, om = ((unsigned)row0 * LDM + col0) * 2u;
        if constexpr (BR == 0) {
            u32x4 a[2][4][2];
#pragma unroll
            for (int ai = 0; ai < 2; ++ai)
#pragma unroll
                for (int m = 0; m < 4; ++m)
#pragma unroll
                    for (int bj = 0; bj < 2; ++bj) a[ai][m][bj] = ldo<u32x4>(Gt, (ai * HALF + m * 16) * LDG + bj * HALF, og);
#pragma unroll
            for (int ai = 0; ai < 2; ++ai)
#pragma unroll
                for (int m = 0; m < 4; ++m)
#pragma unroll
                    for (int bj = 0; bj < 2; ++bj) { const u32x4 aa = a[ai][m][bj];
                        acc[ai][bj][m][0] *= (f32x4){bf_lo(aa.x), bf_hi(aa.x), bf_lo(aa.y), bf_hi(aa.y)}; acc[ai][bj][m][1] *= (f32x4){bf_lo(aa.z), bf_hi(aa.z), bf_lo(aa.w), bf_hi(aa.w)};
                        asm volatile("" : "+v"(acc[ai][bj][m][0]), "+v"(acc[ai][bj][m][1])); }
        } else if constexpr (BR == 1) {
#pragma unroll
            for (int ai = 0; ai < 2; ++ai) {
                __builtin_amdgcn_sched_barrier(0);
                u32x4 a[4][2], d[4][2];
#pragma unroll
                for (int m = 0; m < 4; ++m)
#pragma unroll
                    for (int bj = 0; bj < 2; ++bj) { a[m][bj] = ldo<u32x4>(Gt, 1024 + (ai * HALF + m * 16) * LDG + bj * HALF, og); d[m][bj] = ldo<u32x4>(Gt, 2048 + (ai * HALF + m * 16) * LDG + bj * HALF, og); }
#pragma unroll
                for (int m = 0; m < 4; ++m)
#pragma unroll
                    for (int bj = 0; bj < 2; ++bj) { const u32x4 aa = a[m][bj], dd = d[m][bj];
                        const f32x4 r0 = {bf_lo(aa.x) * __builtin_amdgcn_rcpf(bf_lo(dd.x)), bf_hi(aa.x) * __builtin_amdgcn_rcpf(bf_hi(dd.x)), bf_lo(aa.y) * __builtin_amdgcn_rcpf(bf_lo(dd.y)), bf_hi(aa.y) * __builtin_amdgcn_rcpf(bf_hi(dd.y))};
                        const f32x4 r1 = {bf_lo(aa.z) * __builtin_amdgcn_rcpf(bf_lo(dd.z)), bf_hi(aa.z) * __builtin_amdgcn_rcpf(bf_hi(dd.z)), bf_lo(aa.w) * __builtin_amdgcn_rcpf(bf_lo(dd.w)), bf_hi(aa.w) * __builtin_amdgcn_rcpf(bf_hi(dd.w))};
                        acc[ai][bj][m][0] *= r0; acc[ai][bj][m][1] *= r1; asm volatile("" : "+v"(acc[ai][bj][m][0]), "+v"(acc[ai][bj][m][1])); }
            }
        } else {
            u32x4 g[2][4][2];
#pragma unroll
            for (int ai = 0; ai < 2; ++ai)
#pragma unroll
                for (int m = 0; m < 4; ++m)
#pragma unroll
                    for (int bj = 0; bj < 2; ++bj) g[ai][m][bj] = ldo<u32x4>(Gt, 2048 + (ai * HALF + m * 16) * LDG + bj * HALF, og);
#pragma unroll
            for (int ai = 0; ai < 2; ++ai)
#pragma unroll
                for (int m = 0; m < 4; ++m)
#pragma unroll
                    for (int bj = 0; bj < 2; ++bj) { const f32x4 a0 = acc[ai][bj][m][0], a1 = acc[ai][bj][m][1]; const u32x4 gg = g[ai][m][bj];
                        u32x4 w;
                        w.x = cvt_pk_bf16(bf_lo(gg.x) * a0[0], bf_hi(gg.x) * a0[1]); w.y = cvt_pk_bf16(bf_lo(gg.y) * a0[2], bf_hi(gg.y) * a0[3]);
                        w.z = cvt_pk_bf16(bf_lo(gg.z) * a1[0], bf_hi(gg.z) * a1[1]); w.w = cvt_pk_bf16(bf_lo(gg.w) * a1[2], bf_hi(gg.w) * a1[3]);
                        *(PG8_GAS u32x4*)((PG8_GAS unsigned char*)(Mg + (ai * HALF + m * 16) * LDM + bj * HALF) + (size_t)om) = w; }
        }
    }
};
template <class T> __device__ __forceinline__ T ldo_(const void* base, unsigned off) { return *(const PG8_GAS T*)((const PG8_GAS unsigned char*)base + (size_t)off); }
template <class T> __device__ __forceinline__ void sto_(void* base, unsigned off, T v) { *(PG8_GAS T*)((PG8_GAS unsigned char*)base + (size_t)off) = v; }
struct EpiResidA {
    static constexpr bool PERM = true, AFTER_DRAIN = false, CHAIN = false, PRE = false;
    static constexpr int LD = 1024;
    const float* base; bf16_t* xb; float* rpart;
    __device__ __forceinline__ void operator()(const f32x4 (&acc)[2][2][4][2], const Unit& u, int wr, int wc, int fr, int fq) const {
        const int row0 = u.pm * BM + wr * 64 + fr, col0 = u.pn * BM + wc * 32 + 8 * fq;
        const unsigned o4 = ((unsigned)row0 * LD + col0) * 4u, o2 = ((unsigned)row0 * LD + col0) * 2u;
#pragma unroll
        for (int ai = 0; ai < 2; ++ai) {
            __builtin_amdgcn_sched_barrier(0);
            f32x4 bs[4][2][2];
#pragma unroll
            for (int m = 0; m < 4; ++m)
#pragma unroll
                for (int bj = 0; bj < 2; ++bj)
#pragma unroll
                    for (int n = 0; n < 2; ++n) bs[m][bj][n] = ldo_<f32x4>(base + (ai * HALF + m * 16) * LD + bj * HALF + 4 * n, o4);
#pragma unroll
            for (int m = 0; m < 4; ++m) { float ss = 0.f;
#pragma unroll
                for (int bj = 0; bj < 2; ++bj) { const f32x4 p0 = bs[m][bj][0] + acc[ai][bj][m][0], p1 = bs[m][bj][1] + acc[ai][bj][m][1];
                    ss += ((p0[0] * p0[0] + p0[1] * p0[1]) + (p0[2] * p0[2] + p0[3] * p0[3])) + ((p1[0] * p1[0] + p1[1] * p1[1]) + (p1[2] * p1[2] + p1[3] * p1[3]));
                    u32x4 w; w.x = cvt_pk_bf16(p0[0], p0[1]); w.y = cvt_pk_bf16(p0[2], p0[3]); w.z = cvt_pk_bf16(p1[0], p1[1]); w.w = cvt_pk_bf16(p1[2], p1[3]);
                    sto_<u32x4>(xb + (ai * HALF + m * 16) * LD + bj * HALF, o2, w); }
                ss = xrow_sum_e(ss); if (fq == 0) gst_<float>(rpart + (size_t)(row0 + ai * HALF + m * 16) * 16 + u.pn * 4 + wc, ss); }
        }
    }
};
struct EpiResidB {
    static constexpr bool PERM = true, AFTER_DRAIN = false, CHAIN = false, PRE = false;
    static constexpr int LD = 1024;
    const bf16_t* xb; float* out;
    __device__ __forceinline__ void operator()(const f32x4 (&acc)[2][2][4][2], const Unit& u, int wr, int wc, int fr, int fq) const {
        const int row0 = u.pm * BM + wr * 64 + fr, col0 = u.pn * BM + wc * 32 + 8 * fq;
        const unsigned o4 = ((unsigned)row0 * LD + col0) * 4u, o2 = ((unsigned)row0 * LD + col0) * 2u;
        u32x4 b[2][4][2];
#pragma unroll
        for (int ai = 0; ai < 2; ++ai)
#pragma unroll
            for (int m = 0; m < 4; ++m)
#pragma unroll
                for (int bj = 0; bj < 2; ++bj) b[ai][m][bj] = ldo_<u32x4>(xb + (ai * HALF + m * 16) * LD + bj * HALF, o2);
#pragma unroll
        for (int ai = 0; ai < 2; ++ai)
#pragma unroll
            for (int m = 0; m < 4; ++m)
#pragma unroll
                for (int bj = 0; bj < 2; ++bj) { const u32x4 bb = b[ai][m][bj];
                    sto_<f32x4>(out + (ai * HALF + m * 16) * LD + bj * HALF, o4, (f32x4){bf_lo(bb.x), bf_hi(bb.x), bf_lo(bb.y), bf_hi(bb.y)} + acc[ai][bj][m][0]);
                    sto_<f32x4>(out + (ai * HALF + m * 16) * LD + bj * HALF + 4, o4, (f32x4){bf_lo(bb.z), bf_hi(bb.z), bf_lo(bb.w), bf_hi(bb.w)} + acc[ai][bj][m][1]); }
    }
};


template <int V> struct IC { static constexpr int value = V; };
template <class Epi, class Sched, bool ALIGN_EPI = false, bool SP2 = false>
__device__ __forceinline__ void gemm_phase(PG8_LAS unsigned char* lds, const Gemm g, const Sched& S, const Epi& E, const int tid) {
    const int wid = __builtin_amdgcn_readfirstlane(tid >> 6), lane = tid & 63, wr = wid >> 2, wc = wid & 3, fr = lane & 15, fq = lane >> 4;
    const int K = g.K, nt = K / BK;
    unsigned voffA[2], voffB[2];
#pragma unroll
    for (int i = 0; i < 2; ++i) { int R, C; stage_rc(tid * 16 + i * 8192, R, C); const int Rb = Epi::PERM ? ((R & ~31) + perm32(R & 31)) : R;
        voffA[i] = (unsigned)(R * K + C) * 2u; voffB[i] = (unsigned)(Rb * K + C) * 2u; }
    const size_t kstep = (size_t)(BK * 2);
    const size_t hstep = (size_t)HALF * K * 2;
    const size_t tstep = 2 * hstep;
    const unsigned ldsw = (unsigned)wid * 1024u;
    const int aoff = lds_byte(wr * 64 + fr, fq * 8), boff = lds_byte(wc * 32 + fr, fq * 8);
#define PG8_SA(b, h) (((b) * 2 + (h)) * HTB)
#define PG8_SB(b, h) ((4 + (b) * 2 + (h)) * HTB)
#define PG8_STAGE(bufoff, gbase, voff) do { _Pragma("unroll") for (int _i = 0; _i < 2; ++_i) \
        __builtin_amdgcn_global_load_lds((const unsigned*)((const char*)(gbase) + (voff)[_i]), (PG8_LAS unsigned*)(lds + (bufoff) + ldsw + _i * 8192), 16, 0, 0); } while (0)
#define PG8_LDA(dst, b, h) do { _Pragma("unroll") for (int m = 0; m < 4; ++m) _Pragma("unroll") for (int k = 0; k < 2; ++k) dst[m][k] = *(const PG8_LAS bf16x8*)(lds + PG8_SA(b, h) + aoff + m * 2048 + k * 1024); } while (0)
#define PG8_LDB(dst, b, h) do { _Pragma("unroll") for (int n = 0; n < 2; ++n) _Pragma("unroll") for (int k = 0; k < 2; ++k) dst[n][k] = *(const PG8_LAS bf16x8*)(lds + PG8_SB(b, h) + boff + n * 2048 + k * 1024); } while (0)
#define PG8_MMA(ai, bj, At, Bt) do { __builtin_amdgcn_s_setprio(1); _Pragma("unroll") for (int m = 0; m < 4; ++m) _Pragma("unroll") for (int n = 0; n < 2; ++n) _Pragma("unroll") for (int k = 0; k < 2; ++k) \
        acc[ai][bj][m][n] = __builtin_amdgcn_mfma_f32_16x16x32_bf16(Bt[n][k], At[m][k], acc[ai][bj][m][n], 0, 0, 0); __builtin_amdgcn_s_setprio(0); } while (0)
#define PG8_WAIT_V(n) asm volatile("s_waitcnt vmcnt(" #n ")" ::: "memory")
#define PG8_WAIT_L(n) asm volatile("s_waitcnt lgkmcnt(" #n ")" ::: "memory")
#define PG8_BAR __builtin_amdgcn_s_barrier()
#define PG8_SCHED __builtin_amdgcn_sched_barrier(0)
    Unit cur, nxt; int ui = 0;
    if (!S.next(0, cur)) return;
    f32x4 acc[2][2][4][2];
#pragma unroll
    for (int a = 0; a < 2; ++a)
#pragma unroll
        for (int b = 0; b < 2; ++b)
#pragma unroll
            for (int m = 0; m < 4; ++m)
#pragma unroll
                for (int n = 0; n < 2; ++n) acc[a][b][m][n] = (f32x4){0.f, 0.f, 0.f, 0.f};
    bf16x8 At[4][2], B0[2][2], B1[2][2];
    const char* cA = (const char*)g.A + (size_t)cur.pm * tstep; const char* cB = (const char*)g.Bt + (size_t)cur.pn * tstep;
    S.a_ready(cur);
    if constexpr (SP2) {
        PG8_STAGE(PG8_SB(0, 0), cB, voffB); PG8_STAGE(PG8_SB(0, 1), cB + hstep, voffB); PG8_STAGE(PG8_SA(0, 0), cA, voffA); PG8_STAGE(PG8_SA(0, 1), cA + hstep, voffA);
        if (wr == 1) PG8_BAR;
        PG8_WAIT_V(2); PG8_BAR;
        PG8_STAGE(PG8_SB(1, 0), cB + kstep, voffB); PG8_STAGE(PG8_SA(1, 0), cA + kstep, voffA); PG8_STAGE(PG8_SB(1, 1), cB + hstep + kstep, voffB);
        PG8_WAIT_V(6); PG8_BAR;
    } else {
        PG8_STAGE(PG8_SB(0, 0), cB, voffB); PG8_STAGE(PG8_SA(0, 0), cA, voffA); PG8_STAGE(PG8_SB(0, 1), cB + hstep, voffB); PG8_STAGE(PG8_SA(0, 1), cA + hstep, voffA);
        if (wr == 1) PG8_BAR;
        PG8_WAIT_V(4); PG8_BAR;
        PG8_STAGE(PG8_SB(1, 0), cB + kstep, voffB); PG8_STAGE(PG8_SA(1, 0), cA + kstep, voffA); PG8_STAGE(PG8_SB(1, 1), cB + hstep + kstep, voffB);
        PG8_WAIT_V(6); PG8_BAR;
    }
    auto unit = [&](auto BRC) __attribute__((always_inline)) -> bool {
        constexpr int BR = decltype(BRC)::value;
        const bool has_next = S.next(ui + 1, nxt);
        const char* nA = has_next ? (const char*)g.A + (size_t)nxt.pm * tstep : cA; const char* nB = has_next ? (const char*)g.Bt + (size_t)nxt.pn * tstep : cB;
        asm volatile("" : "+s"(nA), "+s"(nB));
        for (int t = 0; t < nt; t += 2) {
            const bool last = (t == nt - 2);
            const char* a1 = cA + (size_t)(t + 1) * kstep;
            const char* a2 = last ? nA : cA + (size_t)(t + 2) * kstep; const char* b2 = last ? nB : cB + (size_t)(t + 2) * kstep;
            const char* a3 = a2 + kstep; const char* b3 = b2 + kstep;
            if (last && has_next) S.a_ready(nxt);
            if constexpr (SP2) {
            PG8_LDB(B0, 0, 0); PG8_LDB(B1, 0, 1); PG8_SCHED; PG8_LDA(At, 0, 0); PG8_STAGE(PG8_SA(1, 1), a1 + hstep, voffA);
            PG8_WAIT_V(8); PG8_WAIT_L(0); PG8_BAR; PG8_MMA(0, 0, At, B0); PG8_MMA(0, 1, At, B1); PG8_BAR; PG8_SCHED;
            PG8_LDA(At, 0, 1); PG8_STAGE(PG8_SB(0, 0), b2, voffB); PG8_STAGE(PG8_SB(0, 1), b2 + hstep, voffB); PG8_STAGE(PG8_SA(0, 0), a2, voffA);
            PG8_WAIT_V(8); PG8_WAIT_L(0); PG8_BAR; PG8_MMA(1, 0, At, B0); PG8_MMA(1, 1, At, B1); PG8_BAR; PG8_SCHED;
            PG8_LDB(B0, 1, 0); PG8_LDB(B1, 1, 1); PG8_SCHED; PG8_LDA(At, 1, 0); PG8_STAGE(PG8_SA(0, 1), a2 + hstep, voffA);
            PG8_WAIT_V(8); PG8_WAIT_L(0); PG8_BAR; PG8_MMA(0, 0, At, B0); PG8_MMA(0, 1, At, B1); PG8_BAR; PG8_SCHED;
            PG8_LDA(At, 1, 1); PG8_STAGE(PG8_SB(1, 0), b3, voffB); PG8_STAGE(PG8_SB(1, 1), b3 + hstep, voffB); PG8_STAGE(PG8_SA(1, 0), a3, voffA);
            PG8_WAIT_V(8);
            if constexpr (Epi::PRE) { if (last) E.pre(cur, wr, fr, lds + STAGE_BYTES + wid * 2048); }
            PG8_WAIT_L(0); PG8_BAR; PG8_MMA(1, 0, At, B0); PG8_MMA(1, 1, At, B1); PG8_BAR; PG8_SCHED;
            } else {
            PG8_LDB(B0, 0, 0); PG8_SCHED; PG8_LDA(At, 0, 0); PG8_STAGE(PG8_SA(1, 1), a1 + hstep, voffA);
            PG8_WAIT_L(8); PG8_BAR; PG8_WAIT_L(0); PG8_MMA(0, 0, At, B0); PG8_BAR; PG8_SCHED;
            PG8_LDB(B1, 0, 1); PG8_STAGE(PG8_SB(0, 0), b2, voffB);
            PG8_BAR; PG8_WAIT_L(0); PG8_MMA(0, 1, At, B1); PG8_BAR;
            PG8_LDA(At, 0, 1); PG8_STAGE(PG8_SA(0, 0), a2, voffA);
            PG8_BAR; PG8_WAIT_L(0); PG8_MMA(1, 0, At, B0); PG8_BAR; PG8_SCHED;
            PG8_STAGE(PG8_SB(0, 1), b2 + hstep, voffB);
            PG8_WAIT_V(6); PG8_BAR; PG8_MMA(1, 1, At, B1); PG8_BAR;
            PG8_LDB(B0, 1, 0); PG8_SCHED; PG8_LDA(At, 1, 0); PG8_STAGE(PG8_SA(0, 1), a2 + hstep, voffA);
            PG8_WAIT_L(8); PG8_BAR; PG8_WAIT_L(0); PG8_MMA(0, 0, At, B0); PG8_BAR; PG8_SCHED;
            PG8_LDB(B1, 1, 1); PG8_STAGE(PG8_SB(1, 0), b3, voffB);
            PG8_BAR; PG8_WAIT_L(0); PG8_MMA(0, 1, At, B1); PG8_BAR;
            PG8_LDA(At, 1, 1); PG8_STAGE(PG8_SA(1, 0), a3, voffA);
            PG8_BAR; PG8_WAIT_L(0); PG8_MMA(1, 0, At, B0); PG8_BAR; PG8_SCHED;
            PG8_STAGE(PG8_SB(1, 1), b3 + hstep, voffB);
            PG8_WAIT_V(6); PG8_BAR; PG8_MMA(1, 1, At, B1); PG8_BAR;
            }
        }
        if constexpr (ALIGN_EPI) { if (wr == 0) PG8_BAR; }
        if constexpr (Epi::CHAIN) { E.template run<BR>(acc, cur, wr, wc, fr, fq); S.done(cur); }
        else if constexpr (Epi::PRE) { E(acc, cur, wr, wc, fr, fq, lds + STAGE_BYTES + wid * 2048); S.done(cur); }
        else if constexpr (!Epi::AFTER_DRAIN) { E(acc, cur, wr, wc, fr, fq); S.done(cur); }
        if (!has_next) return false;
        if constexpr (!Epi::CHAIN || BR == 2) {
#pragma unroll
        for (int a = 0; a < 2; ++a)
#pragma unroll
            for (int b = 0; b < 2; ++b)
#pragma unroll
                for (int m = 0; m < 4; ++m)
#pragma unroll
                    for (int n = 0; n < 2; ++n) acc[a][b][m][n] = (f32x4){0.f, 0.f, 0.f, 0.f};
        }
        cur = nxt; cA = nA; cB = nB; ++ui;
        if constexpr (ALIGN_EPI) { if (wr == 1) PG8_BAR; }
        return true;
    };
    if constexpr (Epi::CHAIN) { for (;;) { if (!unit(IC<0>{})) break; if (!unit(IC<1>{})) break; if (!unit(IC<2>{})) break; } }
    else { for (;;) if (!unit(IC<0>{})) break; }
    PG8_WAIT_V(0);
    if constexpr (!ALIGN_EPI) { if (wr == 0) PG8_BAR; }
    PG8_BAR;
    if constexpr (Epi::AFTER_DRAIN) { E.fused(acc, cur, wr, wc, fr, fq, lds, wid, lane); S.done(cur); }
#undef PG8_SA
#undef PG8_SB
#undef PG8_STAGE
#undef PG8_LDA
#undef PG8_LDB
#undef PG8_MMA
#undef PG8_WAIT_V
#undef PG8_WAIT_L
#undef PG8_BAR
#undef PG8_SCHED
}
}
#define GAS __attribute__((address_space(1)))
#define LAS __attribute__((address_space(3)))
typedef unsigned short bf16;
typedef unsigned v4u __attribute__((ext_vector_type(4)));
typedef float f32x4 __attribute__((ext_vector_type(4)));
typedef short bf16x8 __attribute__((ext_vector_type(8)));
typedef GAS unsigned gu32;
typedef GAS unsigned long long gu64;
#define RLX_AGENT __ATOMIC_RELAXED, __HIP_MEMORY_SCOPE_AGENT
#define LDS_WAIT() asm volatile("s_waitcnt lgkmcnt(0)" ::: "memory")
#define VM_WAIT() asm volatile("s_waitcnt vmcnt(0)" ::: "memory")
__device__ __forceinline__ unsigned long long rt() { return __builtin_amdgcn_s_memrealtime(); }
__device__ __forceinline__ unsigned f2bf(float f) { unsigned u = __builtin_bit_cast(unsigned, f); return (u + 0x7fffu + ((u >> 16) & 1u)) >> 16; }
__device__ __forceinline__ unsigned pk2(float lo, float hi) { return f2bf(lo) | (f2bf(hi) << 16); }

#define XB_TMO      128
#define XB_XCNT(j)  (256  + 64 * (j))
#define XB_XSUB(j)  (1280 + 64 * (j))
#define XB_XGEN(j)  (2304 + 64 * (j))
#define XB_TOP      3328
#define XB_TOPGEN   3392
#define XCD_BAR_WORDS 3456
#define XB_SPIN_CAP (1u << 18)

__device__ __forceinline__ unsigned xb_ld(unsigned* p)              { return __hip_atomic_load(p, __ATOMIC_RELAXED, __HIP_MEMORY_SCOPE_AGENT); }
__device__ __forceinline__ unsigned xb_add(unsigned* p, unsigned v) { return __hip_atomic_fetch_add(p, v, __ATOMIC_RELAXED, __HIP_MEMORY_SCOPE_AGENT); }
__device__ __forceinline__ unsigned xb_xcc_id() { return (unsigned)__builtin_amdgcn_s_getreg((3 << 11) | 20) & 0xFu; }
#define XB_SPIN(cond, bar) do { unsigned _sp = 0; while (cond) { __builtin_amdgcn_s_sleep(1); \
    if ((++_sp & 255u) == 0u) { if (xb_ld(&(bar)[XB_TMO])) break; if (_sp > XB_SPIN_CAP) { atomicAdd(&(bar)[XB_TMO], 1u); break; } } } } while (0)

struct XcdBarrier {
    unsigned* bar; unsigned x;
    volatile LAS unsigned* st;
};

__device__ __forceinline__ XcdBarrier xcd_barrier_post(unsigned* bar, volatile LAS unsigned* st) {
    XcdBarrier b; b.bar = bar; b.x = xb_xcc_id(); b.st = st;
    if (threadIdx.x == 0) (void)xb_add(&bar[XB_XCNT(b.x)], 1u);
    return b;
}
__device__ __forceinline__ void xcd_barrier_complete(unsigned* bar, unsigned x, unsigned& nloc, unsigned& nx) {
    const unsigned G = gridDim.x * gridDim.y * gridDim.z;
    unsigned sum, cnt, mine, sp = 0u;
    for (;;) {
        sum = 0u; cnt = 0u; mine = 0u;
#pragma unroll
        for (unsigned j = 0; j < 16; ++j) { const unsigned c = xb_ld(&bar[XB_XCNT(j)]); sum += c; cnt += (c > 0u) ? 1u : 0u; mine = (j == x) ? c : mine; }
        if (sum == G) break;
        __builtin_amdgcn_s_sleep(1);
        if ((++sp & 255u) == 0u) { if (xb_ld(&bar[XB_TMO])) break; if (sp > XB_SPIN_CAP) { atomicAdd(&bar[XB_TMO], 1u); break; } }
    }
    nloc = mine > 0u ? mine : 1u; nx = cnt > 0u ? cnt : 1u;
}

__device__ __forceinline__ void xcd_barrier(const XcdBarrier& b) {
    asm volatile("s_waitcnt vmcnt(0)" ::: "memory");
    __syncthreads();
    if (threadIdx.x == 0) {
        unsigned* bar = b.bar;
        __builtin_amdgcn_s_waitcnt(0);
        unsigned nloc = b.st[0], nx = b.st[1];
        if (nloc == 0u) { xcd_barrier_complete(bar, b.x, nloc, nx); b.st[0] = nloc; b.st[1] = nx; }
        const unsigned old = xb_add(&bar[XB_XSUB(b.x)], 1u);
        const unsigned gen = old / nloc;
        if (old + 1u == (gen + 1u) * nloc) {
            __builtin_amdgcn_fence(__ATOMIC_RELEASE, "agent");
            asm volatile("s_waitcnt vmcnt(0)" ::: "memory");
            const unsigned og = xb_add(&bar[XB_TOP], 1u);
            const unsigned tg = og / nx;
            if (og + 1u == (tg + 1u) * nx) xb_add(&bar[XB_TOPGEN], 1u);
            else XB_SPIN(xb_ld(&bar[XB_TOPGEN]) == tg, bar);
            __builtin_amdgcn_fence(__ATOMIC_ACQUIRE, "agent");
            xb_add(&bar[XB_XGEN(b.x)], 1u);
            asm volatile("s_waitcnt vmcnt(0)" ::: "memory");
        } else {
            XB_SPIN(xb_ld(&bar[XB_XGEN(b.x)]) == gen, bar);
            __builtin_amdgcn_fence(__ATOMIC_ACQUIRE, "agent");
            asm volatile("s_waitcnt vmcnt(0)" ::: "memory");
        }
    }
    __syncthreads();
}


constexpr int BATCH = 32, SEQ = 2048, D = 1024, M = BATCH * SEQ, DEPTH = 2;
constexpr int NIN = 7448, NMAIN = 4608, NMG = 3072, NINP = NMAIN + NMG;
constexpr float EPS = 1e-6f;
constexpr int PA_LD = 1280, PG_LD = 1536, PS_LD = 1536, PX_LD = 32;
constexpr int PC_AQ = 0, PC_AK = 512, PC_AV = 640, PC_AG = 768, PC_GQ = 0, PC_GK = 256, PC_GV = 512, PC_GG = 1024, PC_XBC = 0, PC_SZ = 1024, PC_GD = 0, PC_DT = 16;
__host__ __device__ __forceinline__ int src_col(int d) {
    if (d < 2816) return d;
    if (d < 3840) return d + 16;
    if (d < 4352) return d + 24;
    if (d < 4368) return 2816 + (d - 4352);
    if (d < 4376) return 3856 + (d - 4368);
    if (d < NMAIN) return -1;
    const int e = d - NMAIN, t = e >> 8, w = e & 255;
    return 4376 + (t < 8 ? (w >> 7) * 1024 + 128 * t + (w & 127) : e);
}
constexpr size_t MiB = 1u << 20;
constexpr size_t WS_CTL = 0, CTL_ZERO_BYTES = 1 * MiB;
constexpr size_t WS_WIN = 1 * MiB;
constexpr size_t WS_WB = 31 * MiB;
constexpr size_t WS_WO = 37 * MiB;
constexpr size_t WS_PAR = 41 * MiB;
constexpr int PG_NORM = 0, PG_QN = 1024, PG_KN = 1088, PG_SINK = 1152, PG_GWG = 1160, PG_GBG = 5256, PG_GON = 5512, PG_CW = 5640, PG_CB = 9736, PG_DTB = 10760, PG_ALOG = 10768, PG_DSK = 10776, PG_SON = 10784, PSTRIDE = 11296;
constexpr size_t WS_RPART = 42 * MiB;
constexpr size_t WS_RINV = 46 * MiB;
constexpr size_t WS_XN = 48 * MiB;
constexpr size_t WS_Y = 176 * MiB;
constexpr size_t WS_PA = 368 * MiB, WS_PG = 528 * MiB, WS_SPARE = 720 * MiB, WS_PS = 752 * MiB, WS_PX = 960 * MiB;
constexpr size_t WS_MG = 368 * MiB;
constexpr size_t WS_MERGED = 752 * MiB;
constexpr size_t WS_CS = 944 * MiB;
constexpr size_t WS_END = 1024 * MiB;
static_assert(WS_PA + (size_t)M * PA_LD * 2 == WS_PG && WS_PG + (size_t)M * PG_LD * 2 == WS_SPARE && WS_MG + (size_t)M * NMG * 2 == WS_PS && WS_PS + (size_t)M * PS_LD * 2 == WS_CS && WS_MERGED + (size_t)M * D * 2 <= WS_CS && WS_PX + (size_t)M * PX_LD * 2 <= WS_END, "ws map");
constexpr int CW_TMO = 0, CW_CODE = 1;
constexpr int CW_Q = 64;
constexpr int CW_DONE = 256;
constexpr int N_AG_UNITS = 128 + 1024;
constexpr int CW_BAR = 4096;
constexpr int NPHASE = 14, MAX_LAUNCH = 16;
constexpr int RING_OFF = 0, RING_BYTES = 131072;
constexpr int LDS_BYTES = 163840;
constexpr int LDSCTL_OFF = LDS_BYTES - 1024, MISC_OFF = LDSCTL_OFF + 320;
constexpr int NWAVES = 8, NTHR = 512;

struct Args { const void* in[18]; float* out; unsigned char* ws; int ph_lo, ph_hi, li, pad; };

template <int CTRL, int ROWMASK = 0xF> __device__ __forceinline__ float dpp_f(float x) { return __builtin_bit_cast(float, __builtin_amdgcn_update_dpp(0, __builtin_bit_cast(int, x), CTRL, ROWMASK, 0xF, ROWMASK == 0xF)); }
__device__ __forceinline__ float quad_sum(float x) { x += dpp_f<0xB1>(x); x += dpp_f<0x4E>(x); return x; }
__device__ __forceinline__ float row16_sum(float x) { x = quad_sum(x); x += dpp_f<0x141>(x); x += dpp_f<0x140>(x); return x; }
typedef unsigned u32x2p __attribute__((ext_vector_type(2)));
__device__ __forceinline__ void swap16(unsigned& a, unsigned& b) { asm volatile("s_nop 1\n\tv_permlane16_swap_b32 %0, %1" : "+v"(a), "+v"(b)); }
__device__ __forceinline__ void swap32(unsigned& a, unsigned& b) { asm volatile("s_nop 1\n\tv_permlane32_swap_b32 %0, %1" : "+v"(a), "+v"(b)); }
__device__ __forceinline__ float xrow_sum(float x) { unsigned a = __builtin_bit_cast(unsigned, x), b = a; swap16(a, b); const float y = __builtin_bit_cast(float, a) + __builtin_bit_cast(float, b);
    unsigned c = __builtin_bit_cast(unsigned, y), d = c; swap32(c, d); return __builtin_bit_cast(float, c) + __builtin_bit_cast(float, d); }
__device__ __forceinline__ float xrow_max(float x) { unsigned a = __builtin_bit_cast(unsigned, x), b = a; swap16(a, b); const float y = fmaxf(__builtin_bit_cast(float, a), __builtin_bit_cast(float, b));
    unsigned c = __builtin_bit_cast(unsigned, y), d = c; swap32(c, d); return fmaxf(__builtin_bit_cast(float, c), __builtin_bit_cast(float, d)); }
__device__ __forceinline__ float wave_sum(float v) {
    v = row16_sum(v);
    return ((__builtin_bit_cast(float, __builtin_amdgcn_readlane(__builtin_bit_cast(int, v), 0)) + __builtin_bit_cast(float, __builtin_amdgcn_readlane(__builtin_bit_cast(int, v), 16)))
         + (__builtin_bit_cast(float, __builtin_amdgcn_readlane(__builtin_bit_cast(int, v), 32)) + __builtin_bit_cast(float, __builtin_amdgcn_readlane(__builtin_bit_cast(int, v), 48))));
}
__device__ __forceinline__ float bf2f(bf16 b) { return __builtin_bit_cast(float, ((unsigned)b) << 16); }
__device__ __forceinline__ float siluf(float x) { return x * __builtin_amdgcn_rcpf(1.f + __builtin_amdgcn_exp2f(-1.44269504f * x)); }
__device__ __forceinline__ float softplusf(float x) { return x > 20.f ? x : __logf(1.f + __expf(x)); }
__device__ __forceinline__ float logsigmoidf(float x) { return fminf(x, 0.f) - __logf(1.f + __expf(-fabsf(x))); }
__device__ __forceinline__ float rsqf(float x) { return __builtin_amdgcn_rsqf(x); }

template <bool MAPPED>
__device__ __forceinline__ void transpose_item(const float* W, int K, int N, bf16* WT, LAS float* scr, int item, int nblk, int lane, const float* gk = nullptr) {
    const int kb = item / nblk, nb = item % nblk, k0 = 64 * kb, n0 = 32 * nb;
    const int nd = n0 + (lane & 31); const int sc = MAPPED ? src_col(nd) : nd;
    const float wmul = (MAPPED && nd >= NMAIN) ? -1.44269504f : 1.f;
#pragma unroll 8
    for (int i = 0; i < 32; ++i) { const int kk = 2 * i + (lane >> 5); scr[kk * 33 + (lane & 31)] = sc >= 0 ? W[(size_t)(k0 + kk) * N + sc] * (gk ? wmul * gk[k0 + kk] : wmul) : 0.f; }
    LDS_WAIT(); asm volatile("" ::: "memory");
    const int c = lane & 7;
#pragma unroll
    for (int j = 0; j < 4; ++j) { const int n = (lane >> 3) + 8 * j; const LAS float* s = scr + (8 * c) * 33 + n;
        v4u o; o.x = pk2(s[0 * 33], s[1 * 33]); o.y = pk2(s[2 * 33], s[3 * 33]); o.z = pk2(s[4 * 33], s[5 * 33]); o.w = pk2(s[6 * 33], s[7 * 33]);
        *(GAS v4u*)(WT + (size_t)(n0 + n) * K + k0 + 8 * c) = o; }
    LDS_WAIT(); asm volatile("" ::: "memory");
}
__device__ __forceinline__ void rms_rows2_to_bf16(const float* xrow0, const float* xrow1, const float* g, bf16* orow0, bf16* orow1, int lane) {
    const GAS f32x4* xr0 = (const GAS f32x4*)xrow0 + lane; const GAS f32x4* xr1 = (const GAS f32x4*)xrow1 + lane; const GAS f32x4* gr = (const GAS f32x4*)g + lane;
    f32x4 v[4], w[4]; float s = 0.f, t = 0.f;
#pragma unroll
    for (int j = 0; j < 4; ++j) { v[j] = xr0[64 * j]; w[j] = xr1[64 * j]; }
#pragma unroll
    for (int j = 0; j < 4; ++j) { s += (v[j].x * v[j].x + v[j].y * v[j].y) + (v[j].z * v[j].z + v[j].w * v[j].w); t += (w[j].x * w[j].x + w[j].y * w[j].y) + (w[j].z * w[j].z + w[j].w * w[j].w); }
    const float r = 1.f / sqrtf(wave_sum(s) * (1.f / D) + EPS), q = 1.f / sqrtf(wave_sum(t) * (1.f / D) + EPS);
    GAS unsigned long long* o0 = (GAS unsigned long long*)orow0 + lane; GAS unsigned long long* o1 = (GAS unsigned long long*)orow1 + lane;
#pragma unroll
    for (int j = 0; j < 4; ++j) { const f32x4 gg = gr[64 * j];
        o0[64 * j] = (unsigned long long)pk2(v[j].x * r * gg.x, v[j].y * r * gg.y) | ((unsigned long long)pk2(v[j].z * r * gg.z, v[j].w * r * gg.w) << 32);
        o1[64 * j] = (unsigned long long)pk2(w[j].x * q * gg.x, w[j].y * q * gg.y) | ((unsigned long long)pk2(w[j].z * q * gg.z, w[j].w * q * gg.w) << 32); }
}

typedef unsigned long long u64;
typedef unsigned u32x2 __attribute__((ext_vector_type(2)));
#define LBAR() do { asm volatile("s_waitcnt lgkmcnt(0)" ::: "memory"); __builtin_amdgcn_s_barrier(); asm volatile("" ::: "memory"); } while (0)
#define GLD(T, base, off) (*(const GAS T*)((const GAS unsigned char*)(base) + (size_t)(unsigned)(off)))
#define GST(T, base, off) (*(GAS T*)((GAS unsigned char*)(base) + (size_t)(unsigned)(off)))
#define MFMA16(a, b, c) __builtin_amdgcn_mfma_f32_16x16x32_bf16((a), (b), (c), 0, 0, 0)
__device__ __forceinline__ unsigned pk2c(float lo, float hi) { return pg8::cvt_pk_bf16(lo, hi); }
__device__ __forceinline__ bf16x8 mk8(unsigned a, unsigned b, unsigned c, unsigned d) { const v4u t = {a, b, c, d}; return __builtin_bit_cast(bf16x8, t); }
__device__ __forceinline__ bf16x8 mk8(u32x2 lo, u32x2 hi) { const v4u t = {lo.x, lo.y, hi.x, hi.y}; return __builtin_bit_cast(bf16x8, t); }
__device__ __forceinline__ float ex2(float x) { return __builtin_amdgcn_exp2f(x); }

constexpr int AT_KS = 0, AT_KSTR = 144, AT_VT = 36864, AT_VSTR = 528;
__device__ __forceinline__ void attn_unit(int unit, const bf16* PROJ, const float2* CS, const float* par_g, bf16* YA, LAS unsigned char* lds, int tid) {
    const GAS float* par = (const GAS float*)par_g;
    const int lane = tid & 63, wave = __builtin_amdgcn_readfirstlane(tid >> 6);
    const int jb = unit & 15, kvh = (unit >> 4) & 1, b = unit >> 5;
    const long mq0 = (long)b * SEQ + jb * 128, mk0 = mq0 - 128;
    LAS unsigned char* Ks = lds + AT_KS; LAS unsigned char* Vt = lds + AT_VT;
    const GAS float* kn = par + PG_KN; const GAS float* qn = par + PG_QN;
    const int g = wave >> 1, hq = 4 * kvh + g, i16 = lane & 15, quad = lane >> 4;
    v4u qr0, qr1; f32x4 qcs[4];
#define AT_QLOAD(itn) do { const int qrel_ = 16 * ((wave & 1) * 4 + (itn)) + i16; const unsigned qo_ = (unsigned)(qrel_ * PA_LD + PC_AQ + 64 * hq + 8 * quad) * 2u, cso_ = (unsigned)(qrel_ * 32 + 8 * quad) * 8u; \
        qr0 = GLD(v4u, PROJ + mq0 * PA_LD, qo_); qr1 = GLD(v4u, PROJ + mq0 * PA_LD, qo_ + 64u); \
        _Pragma("unroll") for (int j2 = 0; j2 < 4; ++j2) qcs[j2] = GLD(f32x4, CS + mq0 * 32, cso_ + 16u * j2); } while (0)
    AT_QLOAD(0);
#pragma unroll
    for (int it = 0; it < 2; ++it) {
        const int task = tid + it * NTHR, kk = task >> 2, c = task & 3;
        v4u w0 = {0u, 0u, 0u, 0u}, w1 = {0u, 0u, 0u, 0u};
        if (jb > 0 || kk >= 128) {
            const unsigned ko = (unsigned)(kk * PA_LD + PC_AK + 64 * kvh + 8 * c) * 2u;
            const v4u r0 = GLD(v4u, PROJ + mk0 * PA_LD, ko), r1 = GLD(v4u, PROJ + mk0 * PA_LD, ko + 64u);
            float x0[8], x1[8]; float ss = 0.f;
#pragma unroll
            for (int j = 0; j < 4; ++j) { x0[2 * j] = pg8::bf_lo(r0[j]); x0[2 * j + 1] = pg8::bf_hi(r0[j]); x1[2 * j] = pg8::bf_lo(r1[j]); x1[2 * j + 1] = pg8::bf_hi(r1[j]); }
#pragma unroll
            for (int j = 0; j < 8; ++j) ss += x0[j] * x0[j] + x1[j] * x1[j];
            ss = quad_sum(ss);
            const float r = rsqf(ss * (1.f / 64.f) + EPS);
            const unsigned cso = (unsigned)(kk * 32 + 8 * c) * 8u;
            float o0[8], o1[8];
#pragma unroll
            for (int j2 = 0; j2 < 4; ++j2) { const f32x4 cs = GLD(f32x4, CS + mk0 * 32, cso + 16u * j2);
#pragma unroll
                for (int e = 0; e < 2; ++e) { const int j = 2 * j2 + e; const float cn = e ? cs.z : cs.x, sn = e ? cs.w : cs.y;
                    const float y0 = x0[j] * r * kn[8 * c + j], y1 = x1[j] * r * kn[32 + 8 * c + j];
                    o0[j] = y0 * cn - y1 * sn; o1[j] = y1 * cn + y0 * sn; } }
            w0 = (v4u){pk2c(o0[0], o0[1]), pk2c(o0[2], o0[3]), pk2c(o0[4], o0[5]), pk2c(o0[6], o0[7])};
            w1 = (v4u){pk2c(o1[0], o1[1]), pk2c(o1[2], o1[3]), pk2c(o1[4], o1[5]), pk2c(o1[6], o1[7])};
        }
        *(LAS v4u*)(Ks + kk * AT_KSTR + c * 16) = w0; *(LAS v4u*)(Ks + kk * AT_KSTR + 64 + c * 16) = w1;
    }
    {
        const int kk = tid & 255, dh = tid >> 8;
        v4u r[4] = {{0u, 0u, 0u, 0u}, {0u, 0u, 0u, 0u}, {0u, 0u, 0u, 0u}, {0u, 0u, 0u, 0u}};
        if (jb > 0 || kk >= 128) { const unsigned vo = (unsigned)(kk * PA_LD + PC_AV + 64 * kvh + 32 * dh) * 2u;
#pragma unroll
            for (int j = 0; j < 4; ++j) r[j] = GLD(v4u, PROJ + mk0 * PA_LD, vo + 16u * j); }
#pragma unroll
        for (int j = 0; j < 4; ++j)
#pragma unroll
            for (int e = 0; e < 4; ++e) { const unsigned w = r[j][e]; const int d = 32 * dh + 8 * j + 2 * e;
                *(LAS unsigned short*)(Vt + d * AT_VSTR + kk * 2) = (unsigned short)(w & 0xffffu);
                *(LAS unsigned short*)(Vt + (d + 1) * AT_VSTR + kk * 2) = (unsigned short)(w >> 16); }
    }
    LBAR();
    const float sinkl = par[PG_SINK + hq] * 1.44269504f;
    for (int it = 0; it < 4; ++it) {
        const int qt = (wave & 1) * 4 + it, qrel = 16 * qt + i16;
        bf16x8 qf0, qf1;
        {
            const v4u r0 = qr0, r1 = qr1;
            float x0[8], x1[8]; float ss = 0.f;
#pragma unroll
            for (int j = 0; j < 4; ++j) { x0[2 * j] = pg8::bf_lo(r0[j]); x0[2 * j + 1] = pg8::bf_hi(r0[j]); x1[2 * j] = pg8::bf_lo(r1[j]); x1[2 * j + 1] = pg8::bf_hi(r1[j]); }
#pragma unroll
            for (int j = 0; j < 8; ++j) ss += x0[j] * x0[j] + x1[j] * x1[j];
            ss = xrow_sum(ss);
            const float r = (0.125f * 1.44269504f) * rsqf(ss * (1.f / 64.f) + EPS);
            float o0[8], o1[8];
#pragma unroll
            for (int j2 = 0; j2 < 4; ++j2) { const f32x4 cs = qcs[j2];
#pragma unroll
                for (int e = 0; e < 2; ++e) { const int j = 2 * j2 + e; const float cn = e ? cs.z : cs.x, sn = e ? cs.w : cs.y;
                    const float y0 = x0[j] * r * qn[8 * quad + j], y1 = x1[j] * r * qn[32 + 8 * quad + j];
                    o0[j] = y0 * cn - y1 * sn; o1[j] = y1 * cn + y0 * sn; } }
            qf0 = mk8(pk2c(o0[0], o0[1]), pk2c(o0[2], o0[3]), pk2c(o0[4], o0[5]), pk2c(o0[6], o0[7]));
            qf1 = mk8(pk2c(o1[0], o1[1]), pk2c(o1[2], o1[3]), pk2c(o1[4], o1[5]), pk2c(o1[6], o1[7]));
        }
        if (it < 3) AT_QLOAD(it + 1);
        u32x2 gwv[4];
#pragma unroll
        for (int dt = 0; dt < 4; ++dt) gwv[dt] = GLD(u32x2, PROJ + mq0 * PA_LD, (unsigned)(qrel * PA_LD + PC_AG + 64 * hq + 16 * dt + 4 * quad) * 2u);
        f32x4 s[9];
#pragma unroll
        for (int t = 0; t < 9; ++t) { const LAS unsigned char* kp = Ks + (16 * (qt + t) + i16) * AT_KSTR + quad * 16;
            const bf16x8 a0 = *(const LAS bf16x8*)kp, a1 = *(const LAS bf16x8*)(kp + 64);
            f32x4 z = {0.f, 0.f, 0.f, 0.f}; z = MFMA16(a0, qf0, z); s[t] = MFMA16(a1, qf1, z); }
        float mx = sinkl;
        if (jb > 0) {
#pragma unroll
            for (int r = 0; r < 4; ++r) { s[0][r] = (4 * quad + r > i16) ? s[0][r] : -1.0e30f; s[8][r] = (4 * quad + r <= i16) ? s[8][r] : -1.0e30f; }
        } else {
#pragma unroll
            for (int t = 0; t < 9; ++t)
#pragma unroll
                for (int r = 0; r < 4; ++r) { const int kk = 16 * (qt + t) + 4 * quad + r;
                    const bool valid = (kk > qrel) && (kk <= qrel + 128) && (kk >= 128);
                    s[t][r] = valid ? s[t][r] : -1.0e30f; }
        }
#pragma unroll
        for (int t = 0; t < 9; ++t) mx = fmaxf(mx, fmaxf(fmaxf(s[t][0], s[t][1]), fmaxf(s[t][2], s[t][3])));
        mx = xrow_max(mx);
        float lsum = 0.f;
#pragma unroll
        for (int t = 0; t < 9; ++t)
#pragma unroll
            for (int r = 0; r < 4; ++r) { const float p = ex2(s[t][r] - mx); s[t][r] = p; lsum += p; }
        lsum = xrow_sum(lsum) + ex2(sinkl - mx);
        f32x4 o[4];
#pragma unroll
        for (int dt = 0; dt < 4; ++dt) o[dt] = (f32x4){0.f, 0.f, 0.f, 0.f};
#pragma unroll
        for (int st = 0; st < 5; ++st) { const int t0 = 2 * st, t1 = 2 * st + 1;
            bf16x8 pb;
            if (t1 < 9) pb = mk8(pk2c(s[t0][0], s[t0][1]), pk2c(s[t0][2], s[t0][3]), pk2c(s[t1][0], s[t1][1]), pk2c(s[t1][2], s[t1][3]));
            else pb = mk8(pk2c(s[t0][0], s[t0][1]), pk2c(s[t0][2], s[t0][3]), 0u, 0u);
            const int k0 = 16 * (qt + t0) + 4 * quad, k1 = t1 < 9 ? 16 * (qt + t1) + 4 * quad : k0;
#pragma unroll
            for (int dt = 0; dt < 4; ++dt) { const LAS unsigned char* vp = Vt + (16 * dt + i16) * AT_VSTR;
                const u32x2 lo = *(const LAS u32x2*)(vp + k0 * 2), hi = *(const LAS u32x2*)(vp + k1 * 2);
                o[dt] = MFMA16(mk8(lo, hi), pb, o[dt]); } }
        const float inv = __builtin_amdgcn_rcpf(lsum);
#pragma unroll
        for (int dt = 0; dt < 4; ++dt) { const int d0 = 16 * dt + 4 * quad;
            const u32x2 gw = gwv[dt];
            const float g0 = pg8::bf_lo(gw.x), g1 = pg8::bf_hi(gw.x), g2 = pg8::bf_lo(gw.y), g3 = pg8::bf_hi(gw.y);
            u32x2 ow; ow.x = pk2c(o[dt][0] * inv * siluf(g0), o[dt][1] * inv * siluf(g1)); ow.y = pk2c(o[dt][2] * inv * siluf(g2), o[dt][3] * inv * siluf(g3));
            GST(u32x2, YA + mq0 * 512, (unsigned)(qrel * 512 + 64 * hq + d0) * 2u) = ow; }
    }
    LBAR();
}


#undef AT_QLOAD
constexpr int GL_STR = 144;
constexpr int GL_QD = 0, GL_KI = 9216, GL_KET = 18432, GL_VT = 27648, GL_SEG = 46080, GL_BL = 48128, GL_PART = 48384, GL_TB = 51200;
__device__ __forceinline__ void gla_unit(int unit, const bf16* PROJ, const bf16* PX, const float* par_g, bf16* YB, LAS unsigned char* lds, int tid) {
    const GAS float* par = (const GAS float*)par_g;
    const int lane = tid & 63, wave = __builtin_amdgcn_readfirstlane(tid >> 6);
    const int b = unit >> 2, h = unit & 3, i16 = lane & 15, quad = lane >> 4;
    const int d = lane, tseg = wave, vA = tid & 127, q4 = wave >> 1, v0 = 16 * wave;
    LAS unsigned char* Qd = lds + GL_QD; LAS unsigned char* Ki = lds + GL_KI; LAS unsigned char* KeT = lds + GL_KET; LAS unsigned char* Vt = lds + GL_VT;
    LAS float* seg = (LAS float*)(lds + GL_SEG); LAS float* bl = (LAS float*)(lds + GL_BL); LAS float* part = (LAS float*)(lds + GL_PART); LAS float* tb = (LAS float*)(lds + GL_TB + wave * 5120);
    float Wg[16];
#pragma unroll
    for (int r = 0; r < 16; ++r) Wg[r] = par[PG_GWG + r * 256 + 64 * h + d];
    const float bgd = par[PG_GBG + 64 * h + d];
    const float gon = par[PG_GON + v0 + i16];
    f32x4 S[4];
#pragma unroll
    for (int i = 0; i < 4; ++i) S[i] = (f32x4){0.f, 0.f, 0.f, 0.f};
    unsigned gdw; unsigned short qs[8], ks[8]; v4u vq[2];
#define GLA_LOADS(mm) do { const bf16* ub_ = PROJ + ((mm) + 8 * tseg) * PG_LD; \
        gdw = GLD(unsigned, PX + ((mm) + 8 * tseg) * PX_LD, (unsigned)((lane >> 3) * PX_LD + PC_GD + 2 * (lane & 7)) * 2u); \
        _Pragma("unroll") for (int i = 0; i < 8; ++i) { qs[i] = GLD(unsigned short, ub_ + i * PG_LD, (unsigned)(PC_GQ + 64 * h + d) * 2u); ks[i] = GLD(unsigned short, ub_ + i * PG_LD, (unsigned)(PC_GK + 64 * h + d) * 2u); } \
        _Pragma("unroll") for (int j = 0; j < 2; ++j) vq[j] = GLD(v4u, PROJ + (mm) * PG_LD, (unsigned)(lane * PG_LD + PC_GV + 128 * h + 8 * (tseg + 8 * j)) * 2u); } while (0)
    GLA_LOADS((size_t)b * SEQ);
    for (int ch = 0; ch < SEQ / 64; ++ch) {
        const size_t m0 = (size_t)b * SEQ + ch * 64;
        float la[8], qv[8], kv[8];
#pragma unroll
        for (int i = 0; i < 8; ++i) { float lg = bgd;
#pragma unroll
            for (int j = 0; j < 8; ++j) { const unsigned w = (unsigned)__builtin_amdgcn_readlane((int)gdw, i * 8 + j); lg += pg8::bf_lo(w) * Wg[2 * j] + pg8::bf_hi(w) * Wg[2 * j + 1]; }
            la[i] = logsigmoidf(lg) * (1.f / 16.f); qv[i] = bf2f(qs[i]); kv[i] = bf2f(ks[i]); }
#pragma unroll
        for (int i = 1; i < 8; ++i) la[i] += la[i - 1];
        seg[tseg * 64 + d] = la[7];
        LBAR();
        float off = 0.f, tot = 0.f;
#pragma unroll
        for (int s = 0; s < 8; ++s) { const float x = seg[s * 64 + d]; tot += x; off += (s < tseg) ? x : 0.f; }
        if (tseg == 0) bl[d] = __expf(tot);
        {
            float ke[8];
#pragma unroll
            for (int i = 0; i < 8; ++i) { const float bc = off + la[i]; const int t = 8 * tseg + i;
                const float qd = qv[i] * 0.125f * __expf(bc), ki = kv[i] * __expf(-bc); ke[i] = kv[i] * __expf(tot - bc);
                *(LAS unsigned short*)(Qd + t * GL_STR + d * 2) = (unsigned short)f2bf(qd);
                *(LAS unsigned short*)(Ki + t * GL_STR + d * 2) = (unsigned short)f2bf(ki); }
            *(LAS v4u*)(KeT + d * GL_STR + 16 * tseg) = (v4u){pk2c(ke[0], ke[1]), pk2c(ke[2], ke[3]), pk2c(ke[4], ke[5]), pk2c(ke[6], ke[7])};
#pragma unroll
            for (int j = 0; j < 2; ++j)
#pragma unroll
                for (int e = 0; e < 4; ++e) { const unsigned w = vq[j][e]; LAS unsigned char* vr = Vt + (8 * (tseg + 8 * j) + 2 * e) * GL_STR + lane * 2;
                    *(LAS unsigned short*)vr = (unsigned short)(w & 0xffffu); *(LAS unsigned short*)(vr + GL_STR) = (unsigned short)(w >> 16); }
        }
        if (ch + 1 < SEQ / 64) GLA_LOADS(m0 + 64);
        LBAR();
        const v4u gq0 = GLD(v4u, PROJ + m0 * PG_LD, (unsigned)(lane * PG_LD + PC_GG + 128 * h + v0) * 2u), gq1 = GLD(v4u, PROJ + m0 * PG_LD, (unsigned)(lane * PG_LD + PC_GG + 128 * h + v0 + 8) * 2u);
        f32x4 oacc[4];
        {
            bf16x8 kiA[4][2], qdB[4][2];
#pragma unroll
            for (int J = 0; J < 4; ++J)
#pragma unroll
                for (int s = 0; s < 2; ++s) { kiA[J][s] = *(const LAS bf16x8*)(Ki + (16 * J + i16) * GL_STR + quad * 16 + 64 * s); qdB[J][s] = *(const LAS bf16x8*)(Qd + (16 * J + i16) * GL_STR + quad * 16 + 64 * s); }
            f32x4 at[4][4];
#pragma unroll
            for (int I = 0; I < 4; ++I)
#pragma unroll
                for (int J = 0; J <= I; ++J) { f32x4 z = {0.f, 0.f, 0.f, 0.f}; z = MFMA16(kiA[J][0], qdB[I][0], z); z = MFMA16(kiA[J][1], qdB[I][1], z);
                    if (J == I) {
#pragma unroll
                        for (int r = 0; r < 4; ++r) z[r] = (4 * quad + r <= i16) ? z[r] : 0.f; }
                    at[J][I] = z; }
            const LAS unsigned char* vrow = Vt + (v0 + i16) * GL_STR;
            const bf16x8 vB01 = mk8(*(const LAS u32x2*)(vrow + (0 + 4 * quad) * 2), *(const LAS u32x2*)(vrow + (16 + 4 * quad) * 2));
            const bf16x8 vB23 = mk8(*(const LAS u32x2*)(vrow + (32 + 4 * quad) * 2), *(const LAS u32x2*)(vrow + (48 + 4 * quad) * 2));
#define PK4(x, y) mk8(pk2c((x)[0], (x)[1]), pk2c((x)[2], (x)[3]), pk2c((y)[0], (y)[1]), pk2c((y)[2], (y)[3]))
#define PK4Z(x) mk8(pk2c((x)[0], (x)[1]), pk2c((x)[2], (x)[3]), 0u, 0u)
            const f32x4 zz = {0.f, 0.f, 0.f, 0.f};
            oacc[0] = MFMA16(PK4Z(at[0][0]), vB01, zz);
            oacc[1] = MFMA16(PK4(at[0][1], at[1][1]), vB01, zz);
            oacc[2] = MFMA16(PK4(at[0][2], at[1][2]), vB01, zz); oacc[2] = MFMA16(PK4Z(at[2][2]), vB23, oacc[2]);
            oacc[3] = MFMA16(PK4(at[0][3], at[1][3]), vB01, zz); oacc[3] = MFMA16(PK4(at[2][3], at[3][3]), vB23, oacc[3]);
        }
        {
            const bf16x8 sB0 = PK4(S[0], S[1]), sB1 = PK4(S[2], S[3]);
#pragma unroll
            for (int I = 0; I < 4; ++I) { const LAS unsigned char* qrow = Qd + (16 * I + i16) * GL_STR;
                const bf16x8 a0 = mk8(*(const LAS u32x2*)(qrow + (0 + 4 * quad) * 2), *(const LAS u32x2*)(qrow + (16 + 4 * quad) * 2));
                const bf16x8 a1 = mk8(*(const LAS u32x2*)(qrow + (32 + 4 * quad) * 2), *(const LAS u32x2*)(qrow + (48 + 4 * quad) * 2));
                oacc[I] = MFMA16(a0, sB0, oacc[I]); oacc[I] = MFMA16(a1, sB1, oacc[I]); }
        }
        {
            const LAS unsigned char* vrow = Vt + (v0 + i16) * GL_STR + quad * 16;
            const bf16x8 vb0 = *(const LAS bf16x8*)vrow, vb1 = *(const LAS bf16x8*)(vrow + 64);
#pragma unroll
            for (int dt = 0; dt < 4; ++dt) { const f32x4 e = *(const LAS f32x4*)(bl + 16 * dt + 4 * quad); const LAS unsigned char* krow = KeT + (16 * dt + i16) * GL_STR + quad * 16;
                f32x4 z = S[dt] * e; z = MFMA16(*(const LAS bf16x8*)krow, vb0, z); S[dt] = MFMA16(*(const LAS bf16x8*)(krow + 64), vb1, z); }
        }
#pragma unroll
        for (int I = 0; I < 4; ++I) { f32x4 q = oacc[I] * oacc[I];
#pragma unroll
            for (int r = 0; r < 4; ++r) q[r] = row16_sum(q[r]);
            if (i16 == 0) *(LAS f32x4*)(part + wave * 64 + 16 * I + 4 * quad) = q;
#pragma unroll
            for (int r = 0; r < 4; ++r) tb[(16 * I + 4 * quad + r) * 20 + i16] = oacc[I][r] * gon; }
        LBAR();
        {
            float tot = 0.f;
#pragma unroll
            for (int w = 0; w < 8; ++w) tot += part[w * 64 + lane];
            const float rs = rsqf(tot * (1.f / 128.f) + EPS);
            const f32x4 o0 = *(const LAS f32x4*)(tb + lane * 20), o1 = *(const LAS f32x4*)(tb + lane * 20 + 4), o2 = *(const LAS f32x4*)(tb + lane * 20 + 8), o3 = *(const LAS f32x4*)(tb + lane * 20 + 12);
            v4u w0, w1;
            w0.x = pk2c(o0[0] * rs * siluf(pg8::bf_lo(gq0.x)), o0[1] * rs * siluf(pg8::bf_hi(gq0.x))); w0.y = pk2c(o0[2] * rs * siluf(pg8::bf_lo(gq0.y)), o0[3] * rs * siluf(pg8::bf_hi(gq0.y)));
            w0.z = pk2c(o1[0] * rs * siluf(pg8::bf_lo(gq0.z)), o1[1] * rs * siluf(pg8::bf_hi(gq0.z))); w0.w = pk2c(o1[2] * rs * siluf(pg8::bf_lo(gq0.w)), o1[3] * rs * siluf(pg8::bf_hi(gq0.w)));
            w1.x = pk2c(o2[0] * rs * siluf(pg8::bf_lo(gq1.x)), o2[1] * rs * siluf(pg8::bf_hi(gq1.x))); w1.y = pk2c(o2[2] * rs * siluf(pg8::bf_lo(gq1.y)), o2[3] * rs * siluf(pg8::bf_hi(gq1.y)));
            w1.z = pk2c(o3[0] * rs * siluf(pg8::bf_lo(gq1.z)), o3[1] * rs * siluf(pg8::bf_hi(gq1.z))); w1.w = pk2c(o3[2] * rs * siluf(pg8::bf_lo(gq1.w)), o3[3] * rs * siluf(pg8::bf_hi(gq1.w)));
            GST(v4u, YB + m0 * 512, (unsigned)(lane * 512 + 128 * h + v0) * 2u) = w0; GST(v4u, YB + m0 * 512, (unsigned)(lane * 512 + 128 * h + v0 + 8) * 2u) = w1;
        }
    }
    LBAR();
#undef PK4
#undef PK4Z
#undef GLA_LOADS
}

constexpr int SD_XT = 0, SD_XW = 36864, SD_BN = 73728, SD_BT = 91136, SD_CN = 109568, SD_GS = 126976, SD_SM = 144384, SD_PART = 148544;
constexpr int SD_XSTR = 144, SD_NSTR = 272;
typedef float f32x2s __attribute__((ext_vector_type(2)));
__device__ __forceinline__ void ssd_unit(int unit, const bf16* PROJ, const bf16* PX, const float* par_g, bf16* YC, LAS unsigned char* lds, int tid) {
    const GAS float* par = (const GAS float*)par_g;
    const int lane = tid & 63, wave = __builtin_amdgcn_readfirstlane(tid >> 6);
    const int b = unit >> 1, g = unit & 1, i16 = lane & 15, quad = lane >> 4;
    const int hl = wave >> 1, ph = wave & 1;
    LAS unsigned char* XT = lds + SD_XT; LAS unsigned char* XW = lds + SD_XW; LAS unsigned char* BN = lds + SD_BN; LAS unsigned char* BT = lds + SD_BT; LAS unsigned char* CN = lds + SD_CN;
    LAS float* GS = (LAS float*)(lds + SD_GS); LAS float* SDT = (LAS float*)(lds + SD_SM); LAS float* SACS = SDT + 256; LAS float* SW = SACS + 256; LAS float* SEA = SW + 256; LAS float* EAL = SEA + 256;
    LAS float* PART = (LAS float*)(lds + SD_PART);
    const int th = wave >> 2, lc0_ = 2 * (tid & 255);
#define SSD_CIDX(lc) ((lc) < 256 ? 256 * g + (lc) : ((lc) < 384 ? 512 + 128 * g + ((lc) - 256) : 768 + 128 * g + ((lc) - 384)))
    const int chb0 = 64 * hl + 32 * ph;
    f32x4 H[8][2];
#pragma unroll
    for (int i = 0; i < 8; ++i) { H[i][0] = (f32x4){0.f, 0.f, 0.f, 0.f}; H[i][1] = (f32x4){0.f, 0.f, 0.f, 0.f}; }
    const float dtb = __builtin_bit_cast(float, __builtin_amdgcn_readfirstlane(__builtin_bit_cast(int, par[PG_DTB + 4 * g + (wave & 3)]))), negA = __builtin_bit_cast(float, __builtin_amdgcn_readfirstlane(__builtin_bit_cast(int, -__expf(par[PG_ALOG + 4 * g + (wave & 3)]))));
    unsigned raw[35]; unsigned short dtr;
#define SSD_LOADS(mm, first) do { const bf16* ub_ = PROJ + ((long)(mm) + 32 * th - 3) * PS_LD; \
        _Pragma("unroll") for (int i = 0; i < 35; ++i) { raw[i] = 0u; if (!(first) || th > 0 || i >= 3) raw[i] = GLD(unsigned, ub_ + i * PS_LD, (unsigned)(PC_XBC + cidx) * 2u); } \
        dtr = GLD(unsigned short, PX + (mm) * PX_LD, (unsigned)(lane * PX_LD + PC_DT + 4 * g + (wave & 3)) * 2u); } while (0)
    { const int cidx = SSD_CIDX(lc0_); SSD_LOADS((size_t)b * SEQ, true); }
    for (int ch = 0; ch < SEQ / 64; ++ch) {
        const size_t m0 = (size_t)b * SEQ + ch * 64;
        int lc0 = lc0_; asm volatile("" : "+v"(lc0));
        const int cidx = SSD_CIDX(lc0);
        const f32x2s cw0 = *(const GAS f32x2s*)(par + PG_CW + 0 * 1024 + cidx), cw1 = *(const GAS f32x2s*)(par + PG_CW + 1 * 1024 + cidx), cw2 = *(const GAS f32x2s*)(par + PG_CW + 2 * 1024 + cidx),
                      cw3 = *(const GAS f32x2s*)(par + PG_CW + 3 * 1024 + cidx), cbv = *(const GAS f32x2s*)(par + PG_CB + cidx);
        const float wa0 = cw0.x, wb0 = cw0.y, wa1 = cw1.x, wb1 = cw1.y, wa2 = cw2.x, wb2 = cw2.y, wa3 = cw3.x, wb3 = cw3.y, cba = cbv.x, cbb = cbv.y;
        if (wave < 4) {
            const float dt = softplusf(bf2f(dtr) + dtb); float acs = dt * negA;
            acs += dpp_f<0x111>(acs); acs += dpp_f<0x112>(acs); acs += dpp_f<0x114>(acs); acs += dpp_f<0x118>(acs);
            acs += dpp_f<0x142, 0xA>(acs);
            acs += dpp_f<0x143, 0xC>(acs);
            const float alast = __builtin_bit_cast(float, __builtin_amdgcn_readlane(__builtin_bit_cast(int, acs), 63));
            SDT[wave * 64 + lane] = dt; SACS[wave * 64 + lane] = acs; SW[wave * 64 + lane] = dt * __expf(alast - acs); SEA[wave * 64 + lane] = __expf(acs);
            if (lane == 0) EAL[wave] = __expf(alast);
        }
        LBAR();
        {
            float ua0 = pg8::bf_lo(raw[0]), ua1 = pg8::bf_lo(raw[1]), ua2 = pg8::bf_lo(raw[2]), ub0 = pg8::bf_hi(raw[0]), ub1 = pg8::bf_hi(raw[1]), ub2 = pg8::bf_hi(raw[2]);
#pragma unroll
            for (int grp = 0; grp < 4; ++grp) {
                float xa[8], xb[8];
#pragma unroll
                for (int i = 0; i < 8; ++i) { const unsigned wv = raw[3 + 8 * grp + i]; const float ua3 = pg8::bf_lo(wv), ub3 = pg8::bf_hi(wv);
                    const float pa = cba + wa0 * ua0 + wa1 * ua1 + wa2 * ua2 + wa3 * ua3, pb = cbb + wb0 * ub0 + wb1 * ub1 + wb2 * ub2 + wb3 * ub3;
                    xa[i] = pa * __builtin_amdgcn_rcpf(1.f + __expf(-pa)); xb[i] = pb * __builtin_amdgcn_rcpf(1.f + __expf(-pb));
                    ua0 = ua1; ua1 = ua2; ua2 = ua3; ub0 = ub1; ub1 = ub2; ub2 = ub3; }
                const int t0 = 32 * th + 8 * grp;
                const v4u pka = {pk2c(xa[0], xa[1]), pk2c(xa[2], xa[3]), pk2c(xa[4], xa[5]), pk2c(xa[6], xa[7])}, pkb = {pk2c(xb[0], xb[1]), pk2c(xb[2], xb[3]), pk2c(xb[4], xb[5]), pk2c(xb[6], xb[7])};
                if (lc0 < 256) {
                    *(LAS v4u*)(XT + lc0 * SD_XSTR + t0 * 2) = pka; *(LAS v4u*)(XT + (lc0 + 1) * SD_XSTR + t0 * 2) = pkb;
                    const f32x4 wa = *(const LAS f32x4*)(SW + (lc0 >> 6) * 64 + t0), wb = *(const LAS f32x4*)(SW + (lc0 >> 6) * 64 + t0 + 4);
                    *(LAS v4u*)(XW + lc0 * SD_XSTR + t0 * 2) = (v4u){pk2c(xa[0] * wa[0], xa[1] * wa[1]), pk2c(xa[2] * wa[2], xa[3] * wa[3]), pk2c(xa[4] * wb[0], xa[5] * wb[1]), pk2c(xa[6] * wb[2], xa[7] * wb[3])};
                    *(LAS v4u*)(XW + (lc0 + 1) * SD_XSTR + t0 * 2) = (v4u){pk2c(xb[0] * wa[0], xb[1] * wa[1]), pk2c(xb[2] * wa[2], xb[3] * wa[3]), pk2c(xb[4] * wb[0], xb[5] * wb[1]), pk2c(xb[6] * wb[2], xb[7] * wb[3])};
                } else if (lc0 < 384) { const int n = lc0 - 256;
                    *(LAS v4u*)(BT + n * SD_XSTR + t0 * 2) = pka; *(LAS v4u*)(BT + (n + 1) * SD_XSTR + t0 * 2) = pkb;
#pragma unroll
                    for (int i = 0; i < 8; ++i) *(LAS unsigned*)(BN + (t0 + i) * SD_NSTR + n * 2) = pk2c(xa[i], xb[i]);
                } else { const int n = lc0 - 384;
#pragma unroll
                    for (int i = 0; i < 8; ++i) *(LAS unsigned*)(CN + (t0 + i) * SD_NSTR + n * 2) = pk2c(xa[i], xb[i]);
                }
            }
        }
        if (ch + 1 < SEQ / 64) SSD_LOADS(m0 + 64, false);
        LBAR();
        {
#pragma unroll
            for (int rep = 0; rep < 2; ++rep) { const int ti = wave + 8 * rep;
                if (ti < 10) { const int S_ = ti < 4 ? 0 : (ti < 7 ? 1 : (ti < 9 ? 2 : 3)); const int L_ = ti < 4 ? ti : (ti < 7 ? ti - 3 : (ti < 9 ? ti - 5 : 3));
                    f32x4 z = {0.f, 0.f, 0.f, 0.f};
#pragma unroll
                    for (int ks = 0; ks < 4; ++ks) z = MFMA16(*(const LAS bf16x8*)(BN + (16 * S_ + i16) * SD_NSTR + quad * 16 + 64 * ks), *(const LAS bf16x8*)(CN + (16 * L_ + i16) * SD_NSTR + quad * 16 + 64 * ks), z);
#pragma unroll
                    for (int r = 0; r < 4; ++r) GS[(16 * S_ + 4 * quad + r) * 68 + 16 * L_ + i16] = z[r]; } }
        }
        LBAR();
        unsigned zg[4][4];
#pragma unroll
        for (int L = 0; L < 4; ++L)
#pragma unroll
            for (int r = 0; r < 4; ++r) zg[L][r] = GLD(unsigned, PROJ + (m0 + 16 * L + r) * PS_LD, (unsigned)(4 * quad * PS_LD + PC_SZ + 256 * g + chb0 + 2 * i16) * 2u);
        const float Dk = par[PG_DSK + 4 * g + hl]; const f32x2s onv = *(const GAS f32x2s*)(par + PG_SON + 256 * g + chb0 + 2 * i16);
        f32x4 yd[4][2];
#define PK4(x, y) mk8(pk2c((x)[0], (x)[1]), pk2c((x)[2], (x)[3]), pk2c((y)[0], (y)[1]), pk2c((y)[2], (y)[3]))
#define PK4Z(x) mk8(pk2c((x)[0], (x)[1]), pk2c((x)[2], (x)[3]), 0u, 0u)
        {
            const f32x4 zz = {0.f, 0.f, 0.f, 0.f};
#pragma unroll
            for (int L = 0; L < 4; ++L) { yd[L][0] = zz; yd[L][1] = zz; }
#pragma unroll
            for (int ks = 0; ks < 4; ++ks) { __builtin_amdgcn_sched_barrier(0); const bf16x8 hB0 = PK4(H[2 * ks][0], H[2 * ks + 1][0]), hB1 = PK4(H[2 * ks][1], H[2 * ks + 1][1]);
#pragma unroll
                for (int L = 0; L < 4; ++L) { const LAS unsigned char* cr = CN + (16 * L + i16) * SD_NSTR + (32 * ks + 4 * quad) * 2;
                    const bf16x8 ca = mk8(*(const LAS u32x2*)cr, *(const LAS u32x2*)(cr + 32));
                    yd[L][0] = MFMA16(ca, hB0, yd[L][0]); yd[L][1] = MFMA16(ca, hB1, yd[L][1]); } }
#pragma unroll
            for (int L = 0; L < 4; ++L) { const f32x4 ea = *(const LAS f32x4*)(SEA + hl * 64 + 16 * L + 4 * quad); yd[L][0] *= ea; yd[L][1] *= ea; }
        }
        __builtin_amdgcn_sched_barrier(0);
        {
            bf16x8 xB01[2], xB23[2];
#pragma unroll
            for (int pt = 0; pt < 2; ++pt) { const LAS unsigned char* xr = XT + (chb0 + 2 * i16 + pt) * SD_XSTR;
                xB01[pt] = mk8(*(const LAS u32x2*)(xr + (0 + 4 * quad) * 2), *(const LAS u32x2*)(xr + (16 + 4 * quad) * 2));
                xB23[pt] = mk8(*(const LAS u32x2*)(xr + (32 + 4 * quad) * 2), *(const LAS u32x2*)(xr + (48 + 4 * quad) * 2)); }
#pragma unroll
            for (int L = 0; L < 4; ++L) { __builtin_amdgcn_sched_barrier(0); const float acs_l = SACS[hl * 64 + 16 * L + i16];
                f32x4 mt[4];
#pragma unroll
                for (int S_ = 0; S_ <= L; ++S_) { const f32x4 acs_s = *(const LAS f32x4*)(SACS + hl * 64 + 16 * S_ + 4 * quad), dt_s = *(const LAS f32x4*)(SDT + hl * 64 + 16 * S_ + 4 * quad);
#pragma unroll
                    for (int r = 0; r < 4; ++r) { const float gv = GS[(16 * S_ + 4 * quad + r) * 68 + 16 * L + i16]; const float v = gv * __expf(acs_l - acs_s[r]) * dt_s[r];
                        mt[S_][r] = (S_ < L || 4 * quad + r <= i16) ? v : 0.f; } }
#pragma unroll
                for (int pt = 0; pt < 2; ++pt) {
                    if (L == 0) yd[L][pt] = MFMA16(PK4Z(mt[0]), xB01[pt], yd[L][pt]);
                    else if (L == 1) yd[L][pt] = MFMA16(PK4(mt[0], mt[1]), xB01[pt], yd[L][pt]);
                    else if (L == 2) { yd[L][pt] = MFMA16(PK4(mt[0], mt[1]), xB01[pt], yd[L][pt]); yd[L][pt] = MFMA16(PK4Z(mt[2]), xB23[pt], yd[L][pt]); }
                    else { yd[L][pt] = MFMA16(PK4(mt[0], mt[1]), xB01[pt], yd[L][pt]); yd[L][pt] = MFMA16(PK4(mt[2], mt[3]), xB23[pt], yd[L][pt]); } } }
        }
        __builtin_amdgcn_sched_barrier(0);
        {
            const float eal = EAL[hl];
            bf16x8 xw[2][2];
#pragma unroll
            for (int pt = 0; pt < 2; ++pt)
#pragma unroll
                for (int k2 = 0; k2 < 2; ++k2) xw[pt][k2] = *(const LAS bf16x8*)(XW + (chb0 + 2 * i16 + pt) * SD_XSTR + quad * 16 + 64 * k2);
#pragma unroll
            for (int nt = 0; nt < 8; ++nt) { if ((nt & 1) == 0) __builtin_amdgcn_sched_barrier(0); const LAS unsigned char* br = BT + (16 * nt + i16) * SD_XSTR + quad * 16;
                const bf16x8 b0 = *(const LAS bf16x8*)br, b1 = *(const LAS bf16x8*)(br + 64);
#pragma unroll
                for (int pt = 0; pt < 2; ++pt) { f32x4 z = H[nt][pt] * eal; z = MFMA16(b0, xw[pt][0], z); H[nt][pt] = MFMA16(b1, xw[pt][1], z); } }
        }
        __builtin_amdgcn_sched_barrier(0);
        const float on0 = onv.x, on1 = onv.y;
#pragma unroll
        for (int L = 0; L < 4; ++L) { f32x4 q = {0.f, 0.f, 0.f, 0.f};
#pragma unroll
            for (int pt = 0; pt < 2; ++pt) { const u32x2 xw2 = *(const LAS u32x2*)(XT + (chb0 + 2 * i16 + pt) * SD_XSTR + (16 * L + 4 * quad) * 2);
                const float xv[4] = {pg8::bf_lo(xw2.x), pg8::bf_hi(xw2.x), pg8::bf_lo(xw2.y), pg8::bf_hi(xw2.y)};
#pragma unroll
                for (int r = 0; r < 4; ++r) { const float y = yd[L][pt][r] + Dk * xv[r]; const float u = y * siluf(pt ? pg8::bf_hi(zg[L][r]) : pg8::bf_lo(zg[L][r])); yd[L][pt][r] = u; q[r] += u * u; } }
#pragma unroll
            for (int r = 0; r < 4; ++r) q[r] = row16_sum(q[r]);
            if (i16 == 0) *(LAS f32x4*)(PART + wave * 64 + 16 * L + 4 * quad) = q; }
        LBAR();
#pragma unroll
        for (int L = 0; L < 4; ++L) { f32x4 tot4 = {0.f, 0.f, 0.f, 0.f};
#pragma unroll
            for (int w = 0; w < 8; ++w) tot4 += *(const LAS f32x4*)(PART + w * 64 + 16 * L + 4 * quad);
#pragma unroll
            for (int r = 0; r < 4; ++r) { const float rs = rsqf(tot4[r] * (1.f / 256.f) + EPS); GST(unsigned, YC + (m0 + 16 * L + r) * 512, (unsigned)(4 * quad * 512 + 256 * g + chb0 + 2 * i16) * 2u) = pk2c(yd[L][0][r] * rs * on0, yd[L][1][r] * rs * on1); } }
    }
    LBAR();
#undef PK4
#undef PK4Z
#undef SSD_LOADS
#undef SSD_CIDX
}


struct MgOrder {
    int xcd, nloc, first, stride;
    __device__ __forceinline__ void init(int bx) { xcd = bx & 7; if (bx < 64) { nloc = 9; first = 312 + (bx >> 3); stride = 8; } else { nloc = 13; first = (bx - 64) >> 3; stride = 24; } }
    __device__ __forceinline__ bool next(int i, pg8::Unit& u) const { if (i >= nloc) return false; const int off = first + i * stride, grp = off / 96, w = off % 96; u.pm = (xcd * 4 + grp) * 8 + (w & 7); u.pn = w >> 3; return true; }
    __device__ __forceinline__ void a_ready(const pg8::Unit&) const {}
    __device__ __forceinline__ void done(const pg8::Unit&) const {}
};

struct Merge3Order {
    pg8::StaticOrder S;
    __device__ __forceinline__ bool next(int i, pg8::Unit& u) const { const int j = i / 3, br = i - 3 * j; const int R = S.nwg / S.G; if (!S.next((S.nwg == R * S.G && j < R) ? R - 1 - j : j, u)) return false;
        u.pm += br * 256; u.pn += br * 4; return true; }
    __device__ __forceinline__ void a_ready(const pg8::Unit&) const {}
    __device__ __forceinline__ void done(const pg8::Unit&) const {}
};

__global__ void __launch_bounds__(NTHR, 2) mega_fwd(Args args) {
    extern __shared__ __attribute__((aligned(16))) unsigned char lds_raw[];
    LAS unsigned char* lds = (LAS unsigned char*)lds_raw;
    volatile LAS unsigned* MISC = (volatile LAS unsigned*)(lds + MISC_OFF);
    const int tid = threadIdx.x, lane = tid & 63, wave = __builtin_amdgcn_readfirstlane(tid >> 6);
    const int G = gridDim.x, bx = blockIdx.x;
    unsigned char* ws = args.ws;
    gu32* ctl = (gu32*)(ws + WS_CTL);
    const float* x_in = (const float*)args.in[0];
    float* out = args.out;

    for (int u = tid; u < (LDS_BYTES - LDSCTL_OFF) / 4; u += NTHR) ((LAS unsigned*)(lds + LDSCTL_OFF))[u] = 0u;
    __syncthreads();
    XcdBarrier bar = xcd_barrier_post((unsigned*)(ctl + CW_BAR) + args.li * XCD_BAR_WORDS, MISC + 8);
    const int lo = args.ph_lo, hi = args.ph_hi; (void)lo; (void)hi;
#define IN(k) (lo <= (k) && (k) < hi)
#define OWS() ({ unsigned char* w_ = ws; asm volatile("" : "+s"(w_)); w_; })
#define WIN ((bf16*)(OWS() + WS_WIN))
#define WB ((bf16*)(OWS() + WS_WB))
#define WO ((bf16*)(OWS() + WS_WO))
#define XN ((bf16*)(OWS() + WS_XN))
#define Y ((bf16*)(OWS() + WS_Y))
#define PA ((bf16*)(OWS() + WS_PA))
#define PG ((bf16*)(OWS() + WS_PG))
#define PS ((bf16*)(OWS() + WS_PS))
#define PX ((bf16*)(OWS() + WS_PX))
#define MG ((bf16*)(OWS() + WS_MG))
#define MERGED ((bf16*)(OWS() + WS_MERGED))
#define CS ((float2*)(OWS() + WS_CS))
#define KR ((float*)(OWS() + WS_KR))
#define PAR ((float*)(OWS() + WS_PAR))
#define otid() ({ int t_ = tid; asm volatile("" : "+v"(t_)); t_; })
#define SEAM(k) do { if (IN(k) && IN((k) + 1)) xcd_barrier(bar); } while (0)
    const int gw = bx * NWAVES + wave, NGW = G * NWAVES;

    if (IN(0)) {
        LAS float* scr = (LAS float*)(lds + RING_OFF + wave * 16384);
        constexpr int I_IN = (D / 64) * (NINP / 32), I_B = (512 / 64) * (D / 32), I_O = (D / 64) * (D / 32);
        constexpr int NITEMS = DEPTH * (I_IN + 3 * I_B + I_O);
        for (int it = gw; it < NITEMS; it += NGW) {
            int r = it; const int l = r / (I_IN + 3 * I_B + I_O); r -= l * (I_IN + 3 * I_B + I_O);
            if (r < I_IN) { transpose_item<true>((const float*)args.in[3] + (size_t)l * D * NIN, D, NIN, WIN + (size_t)l * NINP * D, scr, r, NINP / 32, lane, l > 0 ? (const float*)args.in[2] + (size_t)l * D : nullptr); continue; } r -= I_IN;
            if (r < 3 * I_B) { const int n = r / I_B; r -= n * I_B;
                transpose_item<false>((const float*)args.in[16] + (size_t)(l * 3 + n) * 512 * D, 512, D, WB + (size_t)(l * 3 + n) * D * 512, scr, r, D / 32, lane); continue; } r -= 3 * I_B;
            transpose_item<false>((const float*)args.in[17] + (size_t)l * D * D, D, D, WO + (size_t)l * D * D, scr, r, D / 32, lane);
        }
        for (int m = 2 * gw; m < M; m += 2 * NGW) rms_rows2_to_bf16(x_in + (size_t)m * D, x_in + (size_t)(m + 1) * D, (const float*)args.in[2], XN + (size_t)m * D, XN + (size_t)(m + 1) * D, lane);
        for (int e = bx * NTHR + tid; e < M * 32; e += G * NTHR) { const int m = e >> 5, i = e & 31;
            const float inv = exp2f(-(float)(2 * i) * (13.287712379549449f / 64.f)); const float ang = (float)((const int*)args.in[1])[m] * inv; const float rev = ang * 0.15915494309189535f; const float fr = rev - floorf(rev);
            *(GAS f32x2s*)(CS + e) = (f32x2s){__builtin_amdgcn_cosf(fr), __builtin_amdgcn_sinf(fr)}; }
        {
            const int gt = bx * NTHR + tid, GT = G * NTHR;
#define CPY(idx, off, n) for (int e = gt; e < DEPTH * (n); e += GT) *(GAS float*)(PAR + (e / (n)) * PSTRIDE + (off) + e % (n)) = ((const GAS float*)args.in[idx])[e]
            CPY(2, PG_NORM, 1024); CPY(4, PG_QN, 64); CPY(5, PG_KN, 64); CPY(6, PG_SINK, 8); CPY(7, PG_GWG, 4096); CPY(8, PG_GBG, 256); CPY(9, PG_GON, 128);
            CPY(10, PG_CW, 4096); CPY(11, PG_CB, 1024); CPY(12, PG_DTB, 8); CPY(13, PG_ALOG, 8); CPY(14, PG_DSK, 8); CPY(15, PG_SON, 512);
#undef CPY
        }
    }
    SEAM(0);

    for (int l = 0; l < DEPTH; ++l) {
        const int pb = 1 + 7 * l;
        const float* xin = l == 0 ? x_in : out;
        const float* par = PAR + l * PSTRIDE;
        if (IN(pb + 0)) {
            pg8::Gemm g{XN, WIN + (size_t)l * NINP * D, M, NMAIN, D}; pg8::StaticOrder S; S.init(M, NMAIN, G, bx);
            pg8::EpiProj E{PA, PG, PS, PX, l > 0 ? (const float*)(OWS() + WS_RINV) : nullptr};
            pg8::gemm_phase<pg8::EpiProj, pg8::StaticOrder, true, true>(lds + RING_OFF, g, S, E, otid());
        }
        SEAM(pb + 0);
        if (IN(pb + 2)) {
            for (int uu = bx; uu < 192; uu += G) {
            if (uu < 64) ssd_unit(uu, PS, PX, par, Y + (size_t)2 * M * 512, lds, otid());
            else { gla_unit(uu - 64, PG, PX, par, Y + (size_t)1 * M * 512, lds, otid()); if (otid() == 0) __hip_atomic_fetch_add((unsigned*)(ctl + CW_DONE + 64 * l), 1u, __ATOMIC_RELAXED, __HIP_MEMORY_SCOPE_AGENT); }
            }
            unsigned qn = 0; if (otid() == 0) qn = __hip_atomic_fetch_add((unsigned*)(ctl + CW_Q + 64 * l), 1u, __ATOMIC_RELAXED, __HIP_MEMORY_SCOPE_AGENT);
            for (;;) {
                __syncthreads();
                if (otid() == 0) MISC[0] = qn;
                __syncthreads();
                const unsigned item = (unsigned)__builtin_amdgcn_readfirstlane((int)MISC[0]);
                if (item >= 1024u) break;
                if (otid() == 0) qn = __hip_atomic_fetch_add((unsigned*)(ctl + CW_Q + 64 * l), 1u, __ATOMIC_RELAXED, __HIP_MEMORY_SCOPE_AGENT);
                attn_unit((int)item, PA, CS, par, Y, lds, otid());
                if (otid() == 0) __hip_atomic_fetch_add((unsigned*)(ctl + CW_DONE + 64 * l), 1u, __ATOMIC_RELAXED, __HIP_MEMORY_SCOPE_AGENT);
            }
        }
        const bool ovl = (G == 256) && IN(pb + 2) && IN(pb + 3);
        if (!ovl) SEAM(pb + 2);
        if (IN(pb + 3)) {
            pg8::Gemm g{XN, WIN + (size_t)l * NINP * D + (size_t)NMAIN * D, M, NMG, D};
            pg8::EpiGate E{MG, NMG, l > 0 ? (const float*)(OWS() + WS_RINV) : nullptr};
            if (ovl) {
                if (otid() == 0) { unsigned sp_ = 0; while (__hip_atomic_load((unsigned*)(ctl + CW_DONE + 64 * l), __ATOMIC_RELAXED, __HIP_MEMORY_SCOPE_AGENT) < (unsigned)N_AG_UNITS) { __builtin_amdgcn_s_sleep(8);
                        if (++sp_ > (1u << 22)) { __hip_atomic_store((unsigned*)(ctl + CW_TMO), 1u, __ATOMIC_RELAXED, __HIP_MEMORY_SCOPE_AGENT); break; } } }
                __syncthreads();
                MgOrder S; S.init(bx);
                pg8::gemm_phase<pg8::EpiGate, MgOrder, true, true>(lds + RING_OFF, g, S, E, otid());
            } else {
                pg8::StaticOrder S; S.init(M, NMG, G, bx);
                pg8::gemm_phase<pg8::EpiGate, pg8::StaticOrder, true, true>(lds + RING_OFF, g, S, E, otid());
            }
        }
        SEAM(pb + 3);
        if (IN(pb + 4)) {
            pg8::Gemm g{Y, WB + (size_t)(l * 3) * D * 512, M, D, 512}; Merge3Order S; S.S.init(M, D, G, bx);
            pg8::EpiMerge3 E{MG, MERGED};
            pg8::gemm_phase<pg8::EpiMerge3, Merge3Order, true, true>(lds + RING_OFF, g, S, E, otid());
        }
        SEAM(pb + 4);
        if (IN(pb + 5)) {
            pg8::Gemm g{MERGED, WO + (size_t)l * D * D, M, D, D}; pg8::StaticOrder S; S.init(M, D, G, bx);
            if (l + 1 < DEPTH) { pg8::EpiResidA E{xin, XN, (float*)(OWS() + WS_RPART)}; pg8::gemm_phase<pg8::EpiResidA, pg8::StaticOrder, true, true>(lds + RING_OFF, g, S, E, otid()); }
            else { pg8::EpiResidB E{XN, out}; pg8::gemm_phase<pg8::EpiResidB, pg8::StaticOrder, true, true>(lds + RING_OFF, g, S, E, otid()); }
        }
        SEAM(pb + 5);
        if (l + 1 < DEPTH) {
            if (IN(pb + 6)) { const float* rp = (const float*)(OWS() + WS_RPART); float* ri = (float*)(OWS() + WS_RINV);
                for (int r_ = bx * NTHR + otid(); r_ < M; r_ += G * NTHR) { const f32x4 a0 = GLD(f32x4, rp, (unsigned)r_ * 64u), a1 = GLD(f32x4, rp, (unsigned)r_ * 64u + 16u), a2 = GLD(f32x4, rp, (unsigned)r_ * 64u + 32u), a3 = GLD(f32x4, rp, (unsigned)r_ * 64u + 48u);
                    const f32x4 s4 = (a0 + a1) + (a2 + a3); *(GAS float*)(ri + r_) = rsqf(((s4[0] + s4[1]) + (s4[2] + s4[3])) * (1.f / D) + EPS); } }
            SEAM(pb + 6);
        }
    }
#undef IN
#undef WIN
#undef WB
#undef WO
#undef XN
#undef Y
#undef PA
#undef PG
#undef PS
#undef PX
#undef MG
#undef MERGED
#undef CS
#undef KR
#undef PAR
#undef SEAM
}

#ifndef MK_SPLIT
#define MK_SPLIT 1
#endif
extern "C" void kernel_launch(void* const* d_in, const int* in_sizes, int n_in, void* d_out, int out_size, void* d_ws, size_t ws_size, hipStream_t stream) {
    static int grid = 0;
    if (grid == 0) {
        if (n_in != 18 || in_sizes[0] != M * D || out_size != M * D || ws_size < WS_END) { fprintf(stderr, "kernel_launch: unexpected shapes/ws (n_in %d, ws %zu)\n", n_in, ws_size); grid = -1; return; }
        int dev = 0, cus = 0, per_cu = 0;
        if (hipGetDevice(&dev) != hipSuccess || hipDeviceGetAttribute(&cus, hipDeviceAttributeMultiprocessorCount, dev) != hipSuccess) { grid = -1; return; }
        if (hipFuncSetAttribute((const void*)mega_fwd, hipFuncAttributeMaxDynamicSharedMemorySize, LDS_BYTES) != hipSuccess) { grid = -1; return; }
        if (hipOccupancyMaxActiveBlocksPerMultiprocessor(&per_cu, (const void*)mega_fwd, NTHR, LDS_BYTES) != hipSuccess || per_cu < 1) { fprintf(stderr, "kernel_launch: occupancy query says %d\n", per_cu); }
        (void)hipGetLastError();
        grid = cus;
    }
    if (grid < 0) return;
    if (hipMemsetAsync((char*)d_ws + WS_CTL, 0, CTL_ZERO_BYTES, stream) != hipSuccess) return;
    Args a{};
    for (int i = 0; i < 18; ++i) a.in[i] = d_in[i];
    a.out = (float*)d_out; a.ws = (unsigned char*)d_ws;
#if MK_SPLIT
    int li = 0;
    for (int ph = 0; ph < NPHASE; ++ph) {
        a.ph_lo = ph; a.ph_hi = ph + 1; a.li = li++; a.pad = 0;
        hipLaunchKernelGGL(mega_fwd, dim3(grid), dim3(NTHR), LDS_BYTES, stream, a); }
#else
    a.ph_lo = 0; a.ph_hi = NPHASE; a.li = 0; a.pad = 0;
    hipLaunchKernelGGL(mega_fwd, dim3(grid), dim3(NTHR), LDS_BYTES, stream, a);
#endif
}
```
